# Optimizing an MI355X kernel written in HIP

```python
import math
import jax, jax.numpy as jnp
from jax import lax
import numpy as np

D_MODEL = 1024
BATCH = 8
SEQ = 4096
DEPTH = 4

HEAD_DIM = 64
SWA_HEADS = 8
SWA_KV_HEADS = 2
SWA_GROUP = SWA_HEADS // SWA_KV_HEADS
WINDOW = 128
ATTN_BLOCK = 128
HG_HEADS = 4
HG_DK = 64
HG_DV = 64
HG_CHUNK = 16
MEM_LEN = 256
MEM_HEADS = 4
N_BUCKETS = 32
MAX_DISTANCE = 128
N_EXPERTS = 16
N_GROUPS = 4
EXPERTS_PER_GROUP = N_EXPERTS // N_GROUPS
TOP_K = 2
D_EXPERT = 512
MOE_BLOCK = 256
LN_EPS = 1e-5
RMS_EPS = 1e-6
ALPHA = (2 * DEPTH) ** 0.25
BETA = (8 * DEPTH) ** -0.25
SPLITS = (SWA_HEADS * HEAD_DIM, SWA_KV_HEADS * HEAD_DIM, SWA_KV_HEADS * HEAD_DIM,
          HG_HEADS * HG_DK, HG_HEADS * HG_DK, HG_HEADS * HG_DV, HG_HEADS * HG_DV,
          MEM_HEADS * HEAD_DIM)
IN_WIDTH = sum(SPLITS)
MIX_WIDTH = SWA_HEADS * HEAD_DIM + HG_HEADS * HG_DV + MEM_HEADS * HEAD_DIM

kernel_name = "hybrid_swa_hgrn2_memory_moe_deepnorm"


def layer_norm(x, g, b):
    xf = x.astype(jnp.float32)
    mu = jnp.mean(xf, axis=-1, keepdims=True)
    var = jnp.mean(jnp.square(xf - mu), axis=-1, keepdims=True)
    return ((xf - mu) * lax.rsqrt(var + LN_EPS) * g.astype(jnp.float32) + b.astype(jnp.float32)).astype(x.dtype)


def t5_bucket(dist):
    max_exact = N_BUCKETS // 2
    d = jnp.maximum(dist, 0)
    large = max_exact + (jnp.log(jnp.maximum(d, 1).astype(jnp.float32) / max_exact)
                         / math.log(MAX_DISTANCE / max_exact) * (N_BUCKETS - max_exact)).astype(jnp.int32)
    large = jnp.minimum(large, N_BUCKETS - 1)
    return jnp.where(d < max_exact, d, large)


def banded_rel_bias(rel_bias):
    i = jnp.arange(ATTN_BLOCK)[:, None]
    j = jnp.arange(2 * ATTN_BLOCK)[None, :]
    bias = rel_bias[t5_bucket(i + ATTN_BLOCK - j)]
    return jnp.transpose(bias, (2, 0, 1)).astype(jnp.float32)


def swa_with_sinks(q, k, v, sinks, pos_bias):
    B, S, _ = q.shape
    nb = S // ATTN_BLOCK
    qb = q.reshape(B, nb, ATTN_BLOCK, SWA_KV_HEADS, SWA_GROUP, HEAD_DIM)

    def with_prev(t):
        tb = t.reshape(B, nb, ATTN_BLOCK, SWA_KV_HEADS, HEAD_DIM)
        prev = jnp.pad(tb, ((0, 0), (1, 0), (0, 0), (0, 0), (0, 0)))[:, :-1]
        return jnp.concatenate([prev, tb], axis=2)

    kb, vb = with_prev(k), with_prev(v)
    logits = jnp.einsum('bnqhgd,bnkhd->bnhgqk', qb, kb).astype(jnp.float32) * (HEAD_DIM ** -0.5)
    logits = logits + pos_bias.reshape(SWA_KV_HEADS, SWA_GROUP, ATTN_BLOCK, 2 * ATTN_BLOCK)
    i = jnp.arange(ATTN_BLOCK)[:, None]
    j = jnp.arange(2 * ATTN_BLOCK)[None, :]
    dist = i + ATTN_BLOCK - j
    in_window = (dist >= 0) & (dist < WINDOW)
    not_pad = (jnp.arange(nb)[:, None, None] > 0) | (j >= ATTN_BLOCK)[None]
    mask = in_window[None] & not_pad
    logits = jnp.where(mask[None, :, None, None], logits, -jnp.inf)
    sink = jnp.broadcast_to(sinks.astype(jnp.float32).reshape(SWA_KV_HEADS, SWA_GROUP, 1, 1),
                            logits.shape[:-1] + (1,))
    probs = jax.nn.softmax(jnp.concatenate([logits, sink], axis=-1), axis=-1)[..., :-1]
    out = jnp.einsum('bnhgqk,bnkhd->bnqhgd', probs.astype(v.dtype), vb)
    return out.reshape(B, S, SWA_HEADS * HEAD_DIM)


def hgrn2(q, f, i, gate, lb, norm_w):
    B, S, _ = q.shape
    nc = S // HG_CHUNK
    f32 = jnp.float32

    def heads(t, d):
        return t.astype(f32).reshape(B, nc, HG_CHUNK, HG_HEADS, d).transpose(0, 3, 1, 2, 4)

    lbf = lb.astype(f32).reshape(HG_HEADS, 1, 1, HG_DK)
    log_f = jnp.logaddexp(jnp.log(lbf), jnp.log1p(-lbf) + jax.nn.log_sigmoid(heads(f, HG_DK)))
    kk = -jnp.expm1(log_f)
    qq = jax.nn.silu(heads(q, HG_DK)) * (HG_DK ** -0.5)
    vv = heads(i, HG_DV)
    b = jnp.cumsum(log_f, axis=3)
    causal = jnp.tril(jnp.ones((HG_CHUNK, HG_CHUNK), dtype=bool))
    diff = b[..., :, None, :] - b[..., None, :, :]
    decay = jnp.exp(jnp.where(causal[:, :, None], diff, -jnp.inf))
    scores = jnp.einsum('bhntk,bhnsk,bhntsk->bhnts', qq, kk, decay)
    o_intra = jnp.einsum('bhnts,bhnsv->bhntv', scores, vv)
    b_last = b[..., -1:, :]
    u = jnp.einsum('bhnsk,bhnsv->bhnkv', kk * jnp.exp(b_last - b), vv)
    chunk_decay = jnp.exp(b_last[..., 0, :])

    def step(state, inp):
        dec, upd = inp
        return dec[..., None] * state + upd, state

    s0 = jnp.zeros((B, HG_HEADS, HG_DK, HG_DV), f32)
    _, s_prev = lax.scan(step, s0, (jnp.moveaxis(chunk_decay, 2, 0), jnp.moveaxis(u, 2, 0)))
    s_prev = jnp.moveaxis(s_prev, 0, 2)
    o_inter = jnp.einsum('bhntk,bhnkv->bhntv', qq * jnp.exp(b), s_prev)
    o = (o_intra + o_inter).transpose(0, 2, 3, 1, 4).reshape(B, S, HG_HEADS, HG_DV)
    o = o * lax.rsqrt(jnp.mean(o * o, axis=-1, keepdims=True) + RMS_EPS) * norm_w.astype(f32)
    o = o.reshape(B, S, HG_HEADS * HG_DV) * jax.nn.silu(gate.astype(f32))
    return o.astype(q.dtype)


def memory_attention(q, mem_k, mem_v):
    B, S, _ = q.shape
    qh = q.reshape(B, S, MEM_HEADS, HEAD_DIM)
    logits = jnp.einsum('bshd,bmhd->bhsm', qh, mem_k).astype(jnp.float32) * (HEAD_DIM ** -0.5)
    probs = jax.nn.softmax(logits, axis=-1)
    out = jnp.einsum('bhsm,bmhd->bshd', probs.astype(mem_v.dtype), mem_v)
    return out.reshape(B, S, MEM_HEADS * HEAD_DIM)


def route(x2, w_router, router_bias):
    scores = jax.nn.sigmoid((x2 @ w_router).astype(jnp.float32))
    sel = scores + router_bias.astype(jnp.float32)
    grouped = sel.reshape(-1, N_GROUPS, EXPERTS_PER_GROUP)
    group_score = jnp.sum(lax.top_k(grouped, TOP_K)[0], axis=-1)
    best = jnp.argmax(group_score, axis=-1)
    in_group = (jnp.arange(N_EXPERTS) // EXPERTS_PER_GROUP)[None, :] == best[:, None]
    _, idx = lax.top_k(jnp.where(in_group, sel, -jnp.inf), TOP_K)
    w = jnp.take_along_axis(scores, idx, axis=-1)
    w = w / jnp.sum(w, axis=-1, keepdims=True)
    return idx, w


def moe(x, w_router, router_bias, w_gate, w_up, w_down):
    B, S, D = x.shape
    n_tok = B * S
    x2 = x.reshape(n_tok, D)
    idx, w = route(x2, w_router, router_bias)
    n_assign = n_tok * TOP_K
    e_flat = idx.reshape(-1)
    tok = jnp.repeat(jnp.arange(n_tok, dtype=jnp.int32), TOP_K)
    w_flat = w.reshape(-1)
    order = jnp.argsort(e_flat)
    e_sorted = e_flat[order]
    counts = jnp.bincount(e_flat, length=N_EXPERTS)
    padded = (counts + MOE_BLOCK - 1) // MOE_BLOCK * MOE_BLOCK
    starts = jnp.cumsum(counts) - counts
    padded_ends = jnp.cumsum(padded)
    padded_starts = padded_ends - padded
    dest = padded_starts[e_sorted] + jnp.arange(n_assign) - starts[e_sorted]
    cap = n_assign + N_EXPERTS * MOE_BLOCK
    n_blocks = cap // MOE_BLOCK
    slot_tok = jnp.zeros((cap,), jnp.int32).at[dest].set(tok[order])
    slot_w = jnp.zeros((cap,), w_flat.dtype).at[dest].set(w_flat[order])
    block_expert = jnp.minimum(
        jnp.searchsorted(padded_ends, jnp.arange(n_blocks) * MOE_BLOCK, side='right'), N_EXPERTS - 1)
    xs = x2[slot_tok].reshape(n_blocks, MOE_BLOCK, D)

    def expert_block(args):
        xb, e = args
        h = jax.nn.silu(xb @ w_gate[e]) * (xb @ w_up[e])
        return h @ w_down[e]

    ys = lax.map(expert_block, (xs, block_expert)).reshape(cap, D)
    y = jnp.zeros((n_tok, D), x.dtype).at[slot_tok].add(ys * slot_w[:, None].astype(ys.dtype))
    return y.reshape(B, S, D)


def setup_inputs(seed: int = 0) -> dict:
    key = jax.random.key(seed)
    ks = jax.random.split(key, 20)

    def normal(k, shape, scale):
        return jax.random.normal(k, shape, jnp.float32) * scale

    col_scale = jnp.concatenate([jnp.full((wd,), s, jnp.float32) for wd, s in
                                 zip(SPLITS, (1.0, 1.0, BETA, 1.0, 1.0, BETA, 1.0, 1.0))])
    mem_scale = jnp.concatenate([jnp.ones((MEM_HEADS * HEAD_DIM,), jnp.float32),
                                 jnp.full((MEM_HEADS * HEAD_DIM,), BETA, jnp.float32)])
    return {
        "x": normal(ks[0], (BATCH, SEQ, D_MODEL), 1.0),
        "mem": normal(ks[1], (BATCH, MEM_LEN, D_MODEL), 1.0),
        "w_in": normal(ks[2], (DEPTH, D_MODEL, IN_WIDTH), D_MODEL ** -0.5) * col_scale,
        "b_in": normal(ks[3], (DEPTH, IN_WIDTH), 0.02),
        "w_mem_kv": normal(ks[4], (DEPTH, D_MODEL, 2 * MEM_HEADS * HEAD_DIM), D_MODEL ** -0.5) * mem_scale,
        "attn_sinks": normal(ks[5], (DEPTH, SWA_HEADS), 0.5),
        "rel_bias": normal(ks[6], (N_BUCKETS, SWA_HEADS), 0.5),
        "hgrn_lb_logits": normal(ks[7], (DEPTH, HG_HEADS * HG_DK), 1.0),
        "hgrn_norm": 1.0 + normal(ks[8], (DEPTH, HG_DV), 0.02),
        "w_out": normal(ks[9], (DEPTH, MIX_WIDTH, D_MODEL), MIX_WIDTH ** -0.5 * BETA),
        "ln1_g": 1.0 + normal(ks[10], (DEPTH, D_MODEL), 0.02),
        "ln1_b": normal(ks[11], (DEPTH, D_MODEL), 0.02),
        "w_router": normal(ks[12], (D_MODEL, N_EXPERTS), D_MODEL ** -0.5),
        "router_bias": normal(ks[13], (N_EXPERTS,), 0.01),
        "w_gate": normal(ks[14], (DEPTH, N_EXPERTS, D_MODEL, D_EXPERT), D_MODEL ** -0.5),
        "w_up": normal(ks[15], (DEPTH, N_EXPERTS, D_MODEL, D_EXPERT), D_MODEL ** -0.5),
        "w_down": normal(ks[16], (DEPTH, N_EXPERTS, D_EXPERT, D_MODEL), D_EXPERT ** -0.5 * BETA),
        "ln2_g": 1.0 + normal(ks[17], (DEPTH, D_MODEL), 0.02),
        "ln2_b": normal(ks[18], (DEPTH, D_MODEL), 0.02),
    }


def reference(x, mem, w_in, b_in, w_mem_kv, attn_sinks, rel_bias, hgrn_lb_logits, hgrn_norm, w_out,
              ln1_g, ln1_b, w_router, router_bias, w_gate, w_up, w_down, ln2_g, ln2_b):
    B, S, _ = x.shape
    M = mem.shape[1]
    split_points = [int(c) for c in np.cumsum(SPLITS)[:-1]]
    pos_bias = banded_rel_bias(rel_bias)
    lb_all = jnp.cumsum(jax.nn.softmax(hgrn_lb_logits.astype(jnp.float32), axis=0), axis=0)
    lb_all = lb_all - lb_all[0:1]
    for l in range(DEPTH):
        proj = x @ w_in[l] + b_in[l]
        sq, sk, sv, hq, hf, hi, hg, mq = jnp.split(proj, split_points, axis=-1)
        mk, mv = jnp.split(mem @ w_mem_kv[l], 2, axis=-1)
        mk = mk.reshape(B, M, MEM_HEADS, HEAD_DIM)
        mv = mv.reshape(B, M, MEM_HEADS, HEAD_DIM)
        mix = jnp.concatenate([
            swa_with_sinks(sq, sk, sv, attn_sinks[l], pos_bias),
            hgrn2(hq, hf, hi, hg, lb_all[l], hgrn_norm[l]),
            memory_attention(mq, mk, mv),
        ], axis=-1)
        x = layer_norm(ALPHA * x + mix @ w_out[l], ln1_g[l], ln1_b[l])
        x = layer_norm(ALPHA * x + moe(x, w_router, router_bias, w_gate[l], w_up[l], w_down[l]),
                       ln2_g[l], ln2_b[l])
    return x
```

```cpp
#include <hip/hip_runtime.h>
#include <cstdio>
#include <cstdint>

#define LAS __attribute__((address_space(3)))
#define GAS __attribute__((address_space(1)))
typedef unsigned short bf16;
typedef short bf16x8 __attribute__((ext_vector_type(8)));
typedef short s16x4 __attribute__((ext_vector_type(4)));
typedef float f32x4 __attribute__((ext_vector_type(4)));
typedef float f32x2 __attribute__((ext_vector_type(2)));
typedef unsigned u32x4 __attribute__((ext_vector_type(4)));
typedef unsigned u32x2 __attribute__((ext_vector_type(2)));
typedef int i32x4 __attribute__((ext_vector_type(4)));
typedef int i32x8 __attribute__((ext_vector_type(8)));
typedef __bf16 bf16x2_t __attribute__((ext_vector_type(2)));

constexpr int NB = 8, SEQ = 4096, DM = 1024, NTOK = NB * SEQ, DEPTH = 4;
constexpr int INW = 2048, MIXW = 1024, NE = 16, DE = 512, MEMLEN = 256;
constexpr int C_SQ = 0, C_SK = 512, C_SV = 640, C_HQ = 768, C_HF = 1024, C_HI = 1280, C_HG = 1536, C_MQ = 1792;
constexpr float ALPHA = 1.6817928305074290f;
constexpr float LN_EPS = 1e-5f, RMS_EPS = 1e-6f;
constexpr int NSEG = 32, CPS = (SEQ / 16) / NSEG;
constexpr int LCAP = 32768;
constexpr int MAXTILES = NTOK * 2 / 256 + NE;
constexpr int NWAVES = 8, NTHR = 512;

constexpr size_t MiB = 1u << 20;
constexpr size_t WS_CTL = 0, CTL_ZERO_BYTES = 1 * MiB;
constexpr size_t WS_TAB = 1 * MiB;
constexpr size_t WS_WIN = 2 * MiB;
constexpr size_t WS_WOUT = 18 * MiB;
constexpr size_t WS_WMEM = 26 * MiB;
constexpr size_t WS_W1 = 30 * MiB;
constexpr size_t WS_XB8 = 94 * MiB;
constexpr size_t WS_W2 = 158 * MiB;
constexpr size_t WS_XB = 222 * MiB;
constexpr size_t WS_BIG = 286 * MiB;
constexpr size_t WS_MIX = 430 * MiB;
constexpr size_t WS_MEMKV = 502 * MiB;
constexpr size_t WS_MEMB = 510 * MiB;
constexpr size_t WS_LIST = 514 * MiB;
constexpr size_t WS_TOKREC = 516 * MiB;
constexpr size_t WS_HST = 517 * MiB;
constexpr size_t WS_END = 538 * MiB;
constexpr int CW_BAR = 4096;
constexpr int CW_CNT = 16384;
constexpr int CW_QUEUE = 32768;
constexpr int CW_TILE = 57344;
constexpr int CW_HA = 49152;

constexpr int RING_BYTES = 131072;
constexpr int LDSCTL_OFF = RING_BYTES, MISC_OFF = LDSCTL_OFF + 320;
constexpr int LDS_BYTES = 147456;

__device__ __forceinline__ unsigned pk2(float lo, float hi) { f32x2 v = {lo, hi}; bf16x2_t b = __builtin_convertvector(v, bf16x2_t); return __builtin_bit_cast(unsigned, b); }
__device__ __forceinline__ unsigned pk_fp8x4(f32x4 v) { int w = __builtin_amdgcn_cvt_pk_fp8_f32(v.x, v.y, 0, false); w = __builtin_amdgcn_cvt_pk_fp8_f32(v.z, v.w, w, true); return (unsigned)w; }
__device__ __forceinline__ f32x4 dec_fp8x4(unsigned w) { const f32x2 a = __builtin_amdgcn_cvt_pk_f32_fp8((int)w, false), b = __builtin_amdgcn_cvt_pk_f32_fp8((int)w, true); return (f32x4){a.x, a.y, b.x, b.y}; }
__device__ __forceinline__ void split_fp8(f32x4 y, unsigned& hi, unsigned& lo) { const f32x4 y8 = y * 8.f; hi = pk_fp8x4(y8); lo = pk_fp8x4((y8 - dec_fp8x4(hi)) * 16.f); }
__device__ __forceinline__ f32x4 join_fp8(unsigned hi, unsigned lo) { return dec_fp8x4(hi) * 0.125f + dec_fp8x4(lo) * 0.0078125f; }
__device__ __forceinline__ u32x4 fp8x8_to_bf16x8(u32x2 w) { const f32x4 a = dec_fp8x4(w.x), b = dec_fp8x4(w.y); u32x4 o; o.x = pk2(a.x, a.y); o.y = pk2(a.z, a.w); o.z = pk2(b.x, b.y); o.w = pk2(b.z, b.w); return o; }
__device__ __forceinline__ float frcp(float x) { return __builtin_amdgcn_rcpf(x); }
__device__ __forceinline__ float bflo(unsigned w) { return __uint_as_float(w << 16); }
__device__ __forceinline__ float bfhi(unsigned w) { return __uint_as_float(w & 0xffff0000u); }
#define DPPF(v, ctrl) __int_as_float(__builtin_amdgcn_update_dpp(0, __float_as_int(v), (ctrl), 0xf, 0xf, true))
__device__ __forceinline__ float wave_sum(float v) {
    v += DPPF(v, 0xB1);
    v += DPPF(v, 0x4E);
    v += DPPF(v, 0x141);
    v += DPPF(v, 0x140);
    v += __shfl_xor(v, 16); v += __shfl_xor(v, 32);
    return v;
}
__device__ __forceinline__ s16x4 ld_tr(const LAS unsigned char* p) { return __builtin_amdgcn_ds_read_tr16_b64_v4i16((LAS s16x4*)p); }
__device__ __forceinline__ float row_scan16(float x) {
    x += __int_as_float(__builtin_amdgcn_update_dpp(0, __float_as_int(x), 0x111, 0xf, 0xf, true));
    x += __int_as_float(__builtin_amdgcn_update_dpp(0, __float_as_int(x), 0x112, 0xf, 0xf, true));
    x += __int_as_float(__builtin_amdgcn_update_dpp(0, __float_as_int(x), 0x114, 0xf, 0xf, true));
    x += __int_as_float(__builtin_amdgcn_update_dpp(0, __float_as_int(x), 0x118, 0xf, 0xf, true));
    return x;
}
__device__ __forceinline__ bf16x8 mk8(unsigned a, unsigned b, unsigned c, unsigned d) { u32x4 w = {a, b, c, d}; return __builtin_bit_cast(bf16x8, w); }
__device__ __forceinline__ s16x4 mk4(unsigned a, unsigned b) { u32x2 w = {a, b}; return __builtin_bit_cast(s16x4, w); }

namespace pg8 {
constexpr int BM = 256, BK = 64, HALF = 128, HTB = HALF * BK * 2, STAGE_BYTES = 8 * HTB, NXCD = 8, WGM = 8;
constexpr int NXT_SLOT_OFF = 131072 + 2048;
__host__ __device__ __forceinline__ int lds_byte(int r, int c) { const int st = (r >> 4) * 2 + (c >> 5), rr = r & 15, cc = c & 31, ob = rr * 64 + cc * 2; return st * 1024 + (ob ^ (((ob >> 9) & 1) << 5)); }
__host__ __device__ __forceinline__ void stage_rc(int b, int& R, int& C) { const int st = b / 1024, sb = b % 1024, swz = sb ^ (((sb >> 9) & 1) << 5); R = (st >> 1) * 16 + swz / 64; C = (st & 1) * 32 + (swz % 64) / 2; }
__host__ __device__ __forceinline__ int perm32(int rho) { const int n = rho >> 4, i = rho & 15; return 8 * (i >> 2) + 4 * n + (i & 3); }
__host__ __device__ __forceinline__ int perm256(int R) { const int bj = R >> 7, wc = (R >> 5) & 3, n = (R >> 4) & 1, i = R & 15; return 64 * wc + 16 * (i >> 2) + 8 * bj + 4 * n + (i & 3); }

struct Unit {
    const char* A;
    const char* B;
    unsigned a00, a01, a10, a11;
    int row0, col0, aux;
};
__device__ __forceinline__ void tile_order(int L, int nM, int nN, int& pm, int& pn) {
    const int nwg = nM * nN; int wgid = L;
    { const int q = nwg / NXCD, r = nwg % NXCD, xcd = wgid % NXCD, off = wgid / NXCD; wgid = (xcd < r ? xcd * (q + 1) : r * (q + 1) + (xcd - r) * q) + off; }
    const int nig = WGM * nN, gid = wgid / nig, fm = gid * WGM, gsz = (nM - fm) < WGM ? (nM - fm) : WGM;
    pm = fm + ((wgid % nig) % gsz); pn = (wgid % nig) / gsz;
}

template <class Epi, class Sched, bool ALIGN_EPI>
__device__ __forceinline__ void gemm_phase(LAS unsigned char* lds, const int tid, const int RB  , Sched& S, const Epi& E) {
    const int wid = __builtin_amdgcn_readfirstlane(tid >> 6), lane = tid & 63, wr = wid >> 2, wc = wid & 3, fr = lane & 15, fq = lane >> 4;
    const int nt = RB / 128;
    unsigned voffB[2], voffA[2] = {0u, 0u};
    {
        int Ra[2], Ca[2];
#pragma unroll
        for (int i = 0; i < 2; ++i) { int R, C; stage_rc(tid * 16 + i * 8192, R, C); const int Rb = Epi::PERM16 ? perm256(R) : (Epi::PERM ? ((R & ~31) + perm32(R & 31)) : R);
            Ra[i] = R; Ca[i] = C; voffB[i] = (unsigned)(Rb * RB + 2 * C); }
        S.lane_init(Ra[0], Ca[0], Ra[1], Ca[1]);
        if constexpr (!Sched::GATHER) { voffA[0] = (unsigned)(Ra[0] * RB + 2 * Ca[0]); voffA[1] = (unsigned)(Ra[1] * RB + 2 * Ca[1]); }
    }
    const size_t kstep = (size_t)(BK * 2);
    const size_t hstepB = (size_t)HALF * RB;
    const size_t hstepW = Epi::PERM16 ? (size_t)8 * RB : hstepB;
    const unsigned ldsw = (unsigned)wid * 1024u;
    const int aoff = lds_byte(wr * 64 + fr, fq * 8), boff = lds_byte(wc * 32 + fr, fq * 8);
#define PG8_SA(b, h) (((b) * 2 + (h)) * HTB)
#define PG8_SB(b, h) ((4 + (b) * 2 + (h)) * HTB)
#define PG8_STAGE_B(bufoff, gbase) do { _Pragma("unroll") for (int _i = 0; _i < 2; ++_i) \
        __builtin_amdgcn_global_load_lds((const unsigned*)((const char*)(gbase) + voffB[_i]), (LAS unsigned*)(lds + (bufoff) + ldsw + _i * 8192), 16, 0, 0); } while (0)
#define PG8_STAGE_A(bufoff, gbase, hf, o0, o1) do { if constexpr (Sched::GATHER) { \
        __builtin_amdgcn_global_load_lds((const unsigned*)((const char*)(gbase) + (o0)), (LAS unsigned*)(lds + (bufoff) + ldsw), 16, 0, 0); \
        __builtin_amdgcn_global_load_lds((const unsigned*)((const char*)(gbase) + (o1)), (LAS unsigned*)(lds + (bufoff) + ldsw + 8192), 16, 0, 0); } else { \
        __builtin_amdgcn_global_load_lds((const unsigned*)((const char*)(gbase) + (hf) * hstepB + voffA[0]), (LAS unsigned*)(lds + (bufoff) + ldsw), 16, 0, 0); \
        __builtin_amdgcn_global_load_lds((const unsigned*)((const char*)(gbase) + (hf) * hstepB + voffA[1]), (LAS unsigned*)(lds + (bufoff) + ldsw + 8192), 16, 0, 0); } } while (0)
#define PG8_LDA(dst, b, h) do { _Pragma("unroll") for (int m = 0; m < 4; ++m) { dst[m].lo = *(const LAS i32x4*)(lds + PG8_SA(b, h) + aoff + m * 2048); dst[m].hi = *(const LAS i32x4*)(lds + PG8_SA(b, h) + aoff + m * 2048 + 1024); } } while (0)
#define PG8_LDB(dst, b, h) do { _Pragma("unroll") for (int n = 0; n < 2; ++n) { dst[n].lo = *(const LAS i32x4*)(lds + PG8_SB(b, h) + boff + n * 2048); dst[n].hi = *(const LAS i32x4*)(lds + PG8_SB(b, h) + boff + n * 2048 + 1024); } } while (0)
#define PG8_MMA(ai, bj, At, Bt) do { __builtin_amdgcn_s_setprio(1); _Pragma("unroll") for (int m = 0; m < 4; ++m) _Pragma("unroll") for (int n = 0; n < 2; ++n) { \
        if constexpr (Epi::FP8) asm volatile("v_mfma_scale_f32_16x16x128_f8f6f4 %0, %1, %2, %0, %3, %4 op_sel_hi:[0,0,0]" : "+v"(acc[ai][bj][m][n]) : "v"(Bt[n]), "v"(At[m]), "v"(sclw_), "v"(scla_));   \
        else { const i32x4 bl_ = Bt[n].lo, bh_ = Bt[n].hi, al_ = At[m].lo, ah_ = At[m].hi;     \
               acc[ai][bj][m][n] = __builtin_amdgcn_mfma_f32_16x16x32_bf16(__builtin_bit_cast(bf16x8, bl_), __builtin_bit_cast(bf16x8, al_), acc[ai][bj][m][n], 0, 0, 0); \
               acc[ai][bj][m][n] = __builtin_amdgcn_mfma_f32_16x16x32_bf16(__builtin_bit_cast(bf16x8, bh_), __builtin_bit_cast(bf16x8, ah_), acc[ai][bj][m][n], 0, 0, 0); } } __builtin_amdgcn_s_setprio(0); } while (0)
#define PG8_WAIT_V(n) asm volatile("s_waitcnt vmcnt(" #n ")" ::: "memory")
#define PG8_WAIT_L(n) asm volatile("s_waitcnt lgkmcnt(" #n ")" ::: "memory")
#define PG8_BAR __builtin_amdgcn_s_barrier()
#define PG8_SCHED __builtin_amdgcn_sched_barrier(0)
    Unit cur, nxt; int ui = 0;
    if (!S.next(0, cur)) return;
    f32x4 acc[2][2][4][2];
#pragma unroll
    for (int a = 0; a < 2; ++a)
#pragma unroll
        for (int b = 0; b < 2; ++b)
#pragma unroll
            for (int m = 0; m < 4; ++m)
#pragma unroll
                for (int n = 0; n < 2; ++n) acc[a][b][m][n] = (f32x4){0.f, 0.f, 0.f, 0.f};
    i32x8 At[4], B0[2], B1[2];
    int sclw_ = Epi::SCALE_W, scla_ = Epi::SCALE_A; asm volatile("" : "+v"(sclw_), "+v"(scla_));
    PG8_STAGE_B(PG8_SB(0, 0), cur.B); PG8_STAGE_B(PG8_SB(0, 1), cur.B + hstepW); PG8_STAGE_A(PG8_SA(0, 0), cur.A, 0, cur.a00, cur.a01); PG8_STAGE_A(PG8_SA(0, 1), cur.A, 1, cur.a10, cur.a11);
    if (wr == 1) PG8_BAR;
    PG8_WAIT_V(2); PG8_BAR;
    PG8_STAGE_B(PG8_SB(1, 0), cur.B + kstep); PG8_STAGE_A(PG8_SA(1, 0), cur.A + kstep, 0, cur.a00, cur.a01); PG8_STAGE_B(PG8_SB(1, 1), cur.B + hstepW + kstep);
    PG8_WAIT_V(6); PG8_BAR;
    for (;;) {
        const bool has_next = S.next(ui + 1, nxt);
        const char* nA = has_next ? nxt.A : cur.A; const char* nB = has_next ? nxt.B : cur.B;
        if constexpr (Sched::GATHER) {
            u32x4 nv; nv.x = has_next ? nxt.a00 : cur.a00; nv.y = has_next ? nxt.a01 : cur.a01; nv.z = has_next ? nxt.a10 : cur.a10; nv.w = has_next ? nxt.a11 : cur.a11;
            *(LAS u32x4*)(lds + NXT_SLOT_OFF + tid * 16) = nv; nxt.a00 = 0u; nxt.a01 = 0u; nxt.a10 = 0u; nxt.a11 = 0u;
        }
#pragma unroll 1
        for (int t = 0; t < nt; t += 2) {
            const bool last = (t == nt - 2);
            const char* a1 = cur.A + (size_t)(t + 1) * kstep;
            const char* a2 = last ? nA : cur.A + (size_t)(t + 2) * kstep; const char* b2 = last ? nB : cur.B + (size_t)(t + 2) * kstep;
            const char* a3 = a2 + kstep; const char* b3 = b2 + kstep;
            unsigned x00 = cur.a00, x01 = cur.a01, x10 = cur.a10, x11 = cur.a11;
            if constexpr (Sched::GATHER) { if (last) { const u32x4 nv = *(const LAS u32x4*)(lds + NXT_SLOT_OFF + tid * 16); x00 = nv.x; x01 = nv.y; x10 = nv.z; x11 = nv.w; } }
            PG8_LDB(B0, 0, 0); PG8_LDB(B1, 0, 1); PG8_SCHED; PG8_LDA(At, 0, 0); PG8_STAGE_A(PG8_SA(1, 1), a1, 1, cur.a10, cur.a11);
            PG8_WAIT_V(8); PG8_WAIT_L(0); PG8_BAR; PG8_MMA(0, 0, At, B0); PG8_MMA(0, 1, At, B1); PG8_BAR; PG8_SCHED;
            PG8_LDA(At, 0, 1); PG8_STAGE_B(PG8_SB(0, 0), b2); PG8_STAGE_B(PG8_SB(0, 1), b2 + hstepW); PG8_STAGE_A(PG8_SA(0, 0), a2, 0, x00, x01);
            PG8_WAIT_V(8); PG8_WAIT_L(0); PG8_BAR; PG8_MMA(1, 0, At, B0); PG8_MMA(1, 1, At, B1); PG8_BAR; PG8_SCHED;
            PG8_LDB(B0, 1, 0); PG8_LDB(B1, 1, 1); PG8_SCHED; PG8_LDA(At, 1, 0); PG8_STAGE_A(PG8_SA(0, 1), a2, 1, x10, x11);
            PG8_WAIT_V(8); PG8_WAIT_L(0); PG8_BAR; PG8_MMA(0, 0, At, B0); PG8_MMA(0, 1, At, B1); PG8_BAR; PG8_SCHED;
            PG8_LDA(At, 1, 1); PG8_STAGE_B(PG8_SB(1, 0), b3); PG8_STAGE_B(PG8_SB(1, 1), b3 + hstepW); PG8_STAGE_A(PG8_SA(1, 0), a3, 0, x00, x01);
            PG8_WAIT_V(8); PG8_WAIT_L(0); PG8_BAR; PG8_MMA(1, 0, At, B0); PG8_MMA(1, 1, At, B1); PG8_BAR; PG8_SCHED;
        }
        if constexpr (Epi::FP8) asm volatile("s_nop 15\n\ts_nop 7" ::: "memory");
        if constexpr (ALIGN_EPI) { if (wr == 0) PG8_BAR; }
        E(acc, cur, wr, wc, fr, fq);
        if (!has_next) break;
#pragma unroll
        for (int a = 0; a < 2; ++a)
#pragma unroll
            for (int b = 0; b < 2; ++b)
#pragma unroll
                for (int m = 0; m < 4; ++m)
#pragma unroll
                    for (int n = 0; n < 2; ++n) acc[a][b][m][n] = (f32x4){0.f, 0.f, 0.f, 0.f};
        cur = nxt; ++ui;
        if constexpr (Sched::GATHER) { const u32x4 nv = *(const LAS u32x4*)(lds + NXT_SLOT_OFF + tid * 16); cur.a00 = nv.x; cur.a01 = nv.y; cur.a10 = nv.z; cur.a11 = nv.w; }
        if constexpr (ALIGN_EPI) { if (wr == 1) PG8_BAR; }
    }
    PG8_WAIT_V(0);
    if constexpr (!ALIGN_EPI) { if (wr == 0) PG8_BAR; }
    PG8_BAR;
#undef PG8_SA
#undef PG8_SB
#undef PG8_STAGE_A
#undef PG8_STAGE_B
#undef PG8_LDA
#undef PG8_LDB
#undef PG8_MMA
#undef PG8_WAIT_V
#undef PG8_WAIT_L
#undef PG8_BAR
#undef PG8_SCHED
}
}

#define XB_TMO      128
#define XB_XCNT(j)  (256  + 64 * (j))
#define XB_XSUB(j)  (1280 + 64 * (j))
#define XB_XGEN(j)  (2304 + 64 * (j))
#define XB_TOP      3328
#define XB_TOPGEN   3392
#define XCD_BAR_WORDS 3456
#define XB_SPIN_CAP (1u << 22)
__device__ __forceinline__ unsigned xb_ld(unsigned* p)              { return __hip_atomic_load(p, __ATOMIC_RELAXED, __HIP_MEMORY_SCOPE_AGENT); }
__device__ __forceinline__ unsigned xb_add(unsigned* p, unsigned v) { return __hip_atomic_fetch_add(p, v, __ATOMIC_RELAXED, __HIP_MEMORY_SCOPE_AGENT); }
__device__ __forceinline__ unsigned xb_xcc_id() { return (unsigned)__builtin_amdgcn_s_getreg((3 << 11) | 20) & 0xFu; }
#define XB_SPIN(cond, bar) do { unsigned _sp = 0; while (cond) { __builtin_amdgcn_s_sleep(1); \
    if ((++_sp & 255u) == 0u) { if (xb_ld(&(bar)[XB_TMO])) break; if (_sp > XB_SPIN_CAP) { atomicAdd(&(bar)[XB_TMO], 1u); break; } } } } while (0)
struct XcdBarrier { unsigned* bar; unsigned x; volatile LAS unsigned* st; };
__device__ __forceinline__ XcdBarrier xcd_barrier_post(unsigned* bar, volatile LAS unsigned* st) {
    XcdBarrier b; b.bar = bar; b.x = xb_xcc_id(); b.st = st;
    if (threadIdx.x == 0) (void)xb_add(&bar[XB_XCNT(b.x)], 1u);
    return b;
}
__device__ __forceinline__ void xcd_barrier_complete(unsigned* bar, unsigned x, unsigned& nloc, unsigned& nx) {
    const unsigned G = gridDim.x * gridDim.y * gridDim.z;
    unsigned sum, cnt, mine, sp = 0u;
    for (;;) {
        sum = 0u; cnt = 0u; mine = 0u;
#pragma unroll
        for (unsigned j = 0; j < 16; ++j) { const unsigned c = xb_ld(&bar[XB_XCNT(j)]); sum += c; cnt += (c > 0u) ? 1u : 0u; mine = (j == x) ? c : mine; }
        if (sum == G) break;
        __builtin_amdgcn_s_sleep(1);
        if ((++sp & 255u) == 0u) { if (xb_ld(&bar[XB_TMO])) break; if (sp > XB_SPIN_CAP) { atomicAdd(&bar[XB_TMO], 1u); break; } }
    }
    nloc = mine > 0u ? mine : 1u; nx = cnt > 0u ? cnt : 1u;
}
__device__ __forceinline__ void xcd_barrier(const XcdBarrier& b) {
    asm volatile("s_waitcnt vmcnt(0)" ::: "memory");
    __syncthreads();
    if (threadIdx.x == 0) {
        unsigned* bar = b.bar;
        __builtin_amdgcn_s_waitcnt(0);
        unsigned nloc = b.st[0], nx = b.st[1];
        if (nloc == 0u) { xcd_barrier_complete(bar, b.x, nloc, nx); b.st[0] = nloc; b.st[1] = nx; }
        const unsigned old = xb_add(&bar[XB_XSUB(b.x)], 1u);
        const unsigned gen = old / nloc;
        if (old + 1u == (gen + 1u) * nloc) {
            __builtin_amdgcn_fence(__ATOMIC_RELEASE, "agent");
            asm volatile("s_waitcnt vmcnt(0)" ::: "memory");
            const unsigned og = xb_add(&bar[XB_TOP], 1u);
            const unsigned tg = og / nx;
            if (og + 1u == (tg + 1u) * nx) xb_add(&bar[XB_TOPGEN], 1u);
            else XB_SPIN(xb_ld(&bar[XB_TOPGEN]) == tg, bar);
            __builtin_amdgcn_fence(__ATOMIC_ACQUIRE, "agent");
            xb_add(&bar[XB_XGEN(b.x)], 1u);
            asm volatile("s_waitcnt vmcnt(0)" ::: "memory");
        } else {
            XB_SPIN(xb_ld(&bar[XB_XGEN(b.x)]) == gen, bar);
            __builtin_amdgcn_fence(__ATOMIC_ACQUIRE, "agent");
            asm volatile("s_waitcnt vmcnt(0)" ::: "memory");
        }
    }
    __syncthreads();
}

struct Args {
    const float* in[19];
    float* out; unsigned char* ws;
    int ph_lo, ph_hi, use_bar, rep;
};
struct Ctx {
    const float *x, *mem, *w_in, *b_in, *w_mem_kv, *sinks, *rel_bias, *lb_logits, *hnorm, *w_out, *ln1g, *ln1b, *w_router, *rbias, *w_gate, *w_up, *w_down, *ln2g, *ln2b;
    float* xcur;
    unsigned char* ws;
    unsigned* ctl;
    bf16 *Win, *Wout, *Wmem, *W1, *W2, *xb, *proj, *ys, *mix, *hmid, *memkv, *memb;
    bf16* hpre; float* biastab; float* lbtab; int* list; u32x4* tokrec; float* hst; unsigned char* xb8;
    int vcu, G, rep;
};

__constant__ unsigned char T5_BUCKET[128] = {0, 1, 2, 3, 4, 5, 6, 7, 8, 9, 10, 11, 12, 13, 14, 15, 16, 16, 16, 17, 17, 18, 18, 18, 19, 19, 19, 20, 20, 20, 20, 21, 21, 21, 21, 22, 22, 22, 22, 22, 23, 23, 23, 23, 23, 23, 24, 24, 24, 24, 24, 24, 25, 25, 25, 25, 25, 25, 25, 26, 26, 26, 26, 26, 26, 26, 26, 27, 27, 27, 27, 27, 27, 27, 27, 27, 27, 28, 28, 28, 28, 28, 28, 28, 28, 28, 28, 29, 29, 29, 29, 29, 29, 29, 29, 29, 29, 29, 29, 30, 30, 30, 30, 30, 30, 30, 30, 30, 30, 30, 30, 30, 30, 31, 31, 31, 31, 31, 31, 31, 31, 31, 31, 31, 31, 31, 31, 31};

struct TrItem { const float* src; bf16* dst; int N, K; float fp8s; };
__device__ __forceinline__ bool p0_item(const Ctx& C, int it, TrItem& t) {
    constexpr int I_IN = DEPTH * 16 * 64, I_OUT = DEPTH * 16 * 32, I_MEM = DEPTH * 16 * 16, I_G = 64 * 16 * 16, I_D = 64 * 8 * 32;
    constexpr int NITEMS = I_IN + I_OUT + I_MEM + 2 * I_G + I_D;
    if (it >= NITEMS) return false;
    int r = it;
    if (r < I_IN) { const int l = r / 1024, q = r % 1024, kb = q / 64, nb = q % 64; t.fp8s = 32.f; t.N = INW; t.K = DM; t.src = C.w_in + (size_t)l * DM * INW + (size_t)(64 * kb) * INW + 32 * nb; t.dst = (bf16*)((unsigned char*)C.Win + (size_t)l * INW * DM + (size_t)(32 * nb) * DM + 64 * kb); return true; } r -= I_IN;
    if (r < I_OUT) { const int l = r / 512, q = r % 512, kb = q / 32, nb = q % 32; t.fp8s = 64.f; t.N = DM; t.K = MIXW; t.src = C.w_out + (size_t)l * MIXW * DM + (size_t)(64 * kb) * DM + 32 * nb; t.dst = (bf16*)((unsigned char*)C.Wout + (size_t)l * DM * MIXW + (size_t)(32 * nb) * MIXW + 64 * kb); return true; } r -= I_OUT;
    if (r < I_MEM) { const int l = r / 256, q = r % 256, kb = q / 16, nb = q % 16; t.fp8s = 32.f; t.N = 512; t.K = DM; t.src = C.w_mem_kv + (size_t)l * DM * 512 + (size_t)(64 * kb) * 512 + 32 * nb; t.dst = (bf16*)((unsigned char*)C.Wmem + (size_t)l * 512 * DM + (size_t)(32 * nb) * DM + 64 * kb); return true; } r -= I_MEM;
    if (r < 2 * I_G) { const int up = r >= I_G; if (up) r -= I_G; const int le = r / 256, q = r % 256, kb = q / 16, nb = q % 16; const int n0 = 32 * nb;
        t.N = DE; t.K = DM; t.src = (up ? C.w_up : C.w_gate) + (size_t)le * DM * DE + (size_t)(64 * kb) * DE + n0; t.fp8s = 32.f; t.dst = (bf16*)((unsigned char*)C.W1 + (size_t)le * 1024 * DM + (size_t)((n0 >> 7) * 256 + (up ? 128 : 0) + (n0 & 127)) * DM + 64 * kb); return true; } r -= 2 * I_G;
    { const int le = r / 256, q = r % 256, kb = q / 32, nb = q % 32; t.N = DM; t.K = DE; t.src = C.w_down + (size_t)le * DE * DM + (size_t)(64 * kb) * DM + 32 * nb; t.fp8s = 64.f; t.dst = (bf16*)((unsigned char*)C.W2 + (size_t)le * DM * DE + (size_t)(32 * nb) * DE + 64 * kb); }
    return true;
}
__device__ __forceinline__ void p0_prologue(const Ctx& C, LAS unsigned char* lds, int wave, int lane) {
    LAS float* scr = (LAS float*)(lds + wave * 16384);
    const int gw = C.vcu * NWAVES + wave, NGW = C.G * NWAVES;
    {
        TrItem cur, nxt; float va[32], vb[32];
        bool have = p0_item(C, gw, cur);
        if (have) {
#pragma unroll
            for (int i = 0; i < 32; ++i) va[i] = cur.src[(size_t)(2 * i + (lane >> 5)) * cur.N + (lane & 31)];
        }
        for (int it = gw; have; it += NGW) {
            const bool hn = p0_item(C, it + NGW, nxt);
            if (hn) {
#pragma unroll
                for (int i = 0; i < 32; ++i) vb[i] = nxt.src[(size_t)(2 * i + (lane >> 5)) * nxt.N + (lane & 31)];
            }
#pragma unroll
            for (int i = 0; i < 32; ++i) scr[(2 * i + (lane >> 5)) * 33 + (lane & 31)] = va[i];
            const int c = lane & 7;
#pragma unroll
            for (int j = 0; j < 4; ++j) { const int n = (lane >> 3) + 8 * j; const LAS float* s = scr + (8 * c) * 33 + n;
                if (cur.fp8s != 0.f) { const float sc = cur.fp8s;
                    int w0 = __builtin_amdgcn_cvt_pk_fp8_f32(s[0 * 33] * sc, s[1 * 33] * sc, 0, false); w0 = __builtin_amdgcn_cvt_pk_fp8_f32(s[2 * 33] * sc, s[3 * 33] * sc, w0, true);
                    int w1 = __builtin_amdgcn_cvt_pk_fp8_f32(s[4 * 33] * sc, s[5 * 33] * sc, 0, false); w1 = __builtin_amdgcn_cvt_pk_fp8_f32(s[6 * 33] * sc, s[7 * 33] * sc, w1, true);
                    u32x2 o8; o8.x = (unsigned)w0; o8.y = (unsigned)w1;
                    *(u32x2*)((unsigned char*)cur.dst + (size_t)n * cur.K + 8 * c) = o8; }
                else { u32x4 o; o.x = pk2(s[0 * 33], s[1 * 33]); o.y = pk2(s[2 * 33], s[3 * 33]); o.z = pk2(s[4 * 33], s[5 * 33]); o.w = pk2(s[6 * 33], s[7 * 33]);
                    *(u32x4*)(cur.dst + (size_t)n * cur.K + 8 * c) = o; } }
#pragma unroll
            for (int i = 0; i < 32; ++i) va[i] = vb[i];
            cur = nxt; have = hn;
        }
    }
    for (int m = gw; m < NTOK + NB * MEMLEN; m += NGW) {
        const bool ism = m >= NTOK; const int r = ism ? m - NTOK : m;
        const f32x4* src = (const f32x4*)((ism ? C.mem : C.x) + (size_t)r * DM) + lane;
        f32x4 v[4];
#pragma unroll
        for (int j = 0; j < 4; ++j) v[j] = src[64 * j];
        unsigned* q8 = (unsigned*)((ism ? (unsigned char*)C.memb : C.xb8) + (size_t)r * DM) + lane;
        unsigned* ql = (unsigned*)((unsigned char*)C.xb + (size_t)r * DM) + lane;
#pragma unroll
        for (int j = 0; j < 4; ++j) { unsigned hi, lo; split_fp8(v[j], hi, lo); q8[64 * j] = hi; if (!ism) ql[64 * j] = lo; }
    }
    if (blockIdx.x == 0) {
        const int tid = wave * 64 + lane;
        for (int i = tid; i < 8 * 128; i += NTHR) { const int h = i >> 7, d = i & 127; C.biastab[i] = C.rel_bias[(int)T5_BUCKET[d] * 8 + h]; }
        if (tid < 256) { float v0 = C.lb_logits[tid], v1 = C.lb_logits[256 + tid], v2 = C.lb_logits[512 + tid], v3 = C.lb_logits[768 + tid];
            const float mx = fmaxf(fmaxf(v0, v1), fmaxf(v2, v3)); v0 = __expf(v0 - mx); v1 = __expf(v1 - mx); v2 = __expf(v2 - mx); v3 = __expf(v3 - mx);
            const float inv = 1.f / (v0 + v1 + v2 + v3);
            C.lbtab[tid] = 0.f; C.lbtab[256 + tid] = v1 * inv; C.lbtab[512 + tid] = (v1 + v2) * inv; C.lbtab[768 + tid] = (v1 + v2 + v3) * inv; }
    }
}

struct DenseSched {
    static constexpr bool GATHER = false;
    const char* A0; const char* B0; int nM0, nN0, K0;
    const char* A1; const char* B1; int nM1, nN1;
    int G, c;
    __device__ __forceinline__ void lane_init(int, int, int, int) {}
    __device__ __forceinline__ bool next(int i, pg8::Unit& u) const {
        const int n0 = nM0 * nN0; const int L = i * G + c; if (L >= n0 + nM1 * nN1) return false;
        int pm, pn; const char* A; const char* B; int aux;
        if (L < n0) { pg8::tile_order(L, nM0, nN0, pm, pn); A = A0; B = B0; aux = 0; }
        else { pg8::tile_order(L - n0, nM1, nN1, pm, pn); A = A1; B = B1; aux = 1; }
        u.A = A + (size_t)pm * 256 * K0; u.B = B + (size_t)pn * 256 * K0;
        u.a00 = 0u; u.a01 = 0u; u.a10 = 0u; u.a11 = 0u;
        u.row0 = pm * 256; u.col0 = pn * 256; u.aux = aux; return true;
    }
};
template <bool GATHER_> struct MoeSched {
    static constexpr bool GATHER = GATHER_;
    const char* A; const char* Bl; int K; size_t bstride;
    const int* list; const LAS int* tb;
    int g0, g1, gU, mode; int R0, C0, R1, C1;
    __device__ __forceinline__ void lane_init(int r0, int c0, int r1, int c1) { R0 = r0; C0 = c0; R1 = r1; C1 = c1; }
    __device__ __forceinline__ bool next(int i, pg8::Unit& u) const {
        int g;
        if (mode == 0) { g = g0 + i * g1; if (g >= gU) return false; }
        else {
            const int c = g0, E = g1;
            if (c < E) { if (i == 0) g = 1024 + c; else if (i <= 2) g = c + (i - 1) * E; else return false; }
            else { g = 2 * E + (c - E) + i * (256 - E); if (g >= gU) return false; }
        }
        const int tile = g >> 2, pn = g & 3;
        int e = 0;
#pragma unroll
        for (int j = 1; j < 16; ++j) e += (tile >= tb[j]) ? 1 : 0;
        e = __builtin_amdgcn_readfirstlane(e);
        u.B = Bl + (size_t)e * bstride + (size_t)pn * 256 * K;
        u.A = A;
        if (GATHER) {
            const int p0 = (tile - __builtin_amdgcn_readfirstlane(tb[e])) * 256, cnt = __builtin_amdgcn_readfirstlane(tb[17 + e]); const int* le = list + (size_t)e * LCAP;
            const int cm = cnt - 1;
            const int t00 = le[min(p0 + R0, cm)], t01 = le[min(p0 + R1, cm)], t10 = le[min(p0 + 128 + R0, cm)], t11 = le[min(p0 + 128 + R1, cm)];
            u.a00 = (unsigned)t00 * K + 2 * C0; u.a01 = (unsigned)t01 * K + 2 * C1; u.a10 = (unsigned)t10 * K + 2 * C0; u.a11 = (unsigned)t11 * K + 2 * C1;
        } else {
            u.A = A + (size_t)tile * 256 * K; u.a00 = 0u; u.a01 = 0u; u.a10 = 0u; u.a11 = 0u;
        }
        u.row0 = tile * 256; u.col0 = pn * 256; u.aux = e; return true;
    }
};
struct EpiProj {
    static constexpr bool PERM = true, PERM16 = true, FP8 = true; static constexpr int SCALE_W = 0x7A7A7A7A  , SCALE_A = 0x7C7C7C7C  ;
    unsigned char* O0; const float* bias; unsigned char* O1;
    __device__ __forceinline__ void operator()(const f32x4 (&acc)[2][2][4][2], const pg8::Unit& u, int wr, int wc, int fr, int fq) const {
        unsigned char* base = u.aux ? O1 : O0; const int row0 = u.row0 + wr * 64 + fr, col0 = u.col0 + wc * 64 + 16 * fq;
        f32x4 bv[2][2];
#pragma unroll
        for (int bj = 0; bj < 2; ++bj)
#pragma unroll
            for (int n = 0; n < 2; ++n) bv[bj][n] = u.aux ? (f32x4){0.f, 0.f, 0.f, 0.f} : *(const f32x4*)(bias + col0 + 8 * bj + 4 * n);
#pragma unroll
        for (int ai = 0; ai < 2; ++ai)
#pragma unroll
            for (int m = 0; m < 4; ++m) { unsigned char* rowp = base + (size_t)(row0 + ai * 128 + m * 16) * INW + col0;
                u32x4 w; w.x = pk_fp8x4((acc[ai][0][m][0] + bv[0][0]) * 8.f); w.y = pk_fp8x4((acc[ai][0][m][1] + bv[0][1]) * 8.f); w.z = pk_fp8x4((acc[ai][1][m][0] + bv[1][0]) * 8.f); w.w = pk_fp8x4((acc[ai][1][m][1] + bv[1][1]) * 8.f);
                *(u32x4*)rowp = w; }
    }
};
struct EpiOut {
    static constexpr bool PERM = true, PERM16 = true, FP8 = true; static constexpr int SCALE_W = 0x79797979  , SCALE_A = 0x7C7C7C7C  ;
    unsigned char* H;
    __device__ __forceinline__ void operator()(const f32x4 (&acc)[2][2][4][2], const pg8::Unit& u, int wr, int wc, int fr, int fq) const {
        const int row0 = u.row0 + wr * 64 + fr, col0 = u.col0 + wc * 64 + 16 * fq;
#pragma unroll
        for (int ai = 0; ai < 2; ++ai)
#pragma unroll
            for (int m = 0; m < 4; ++m) { const size_t off = (size_t)(row0 + ai * 128 + m * 16) * DM + col0;
                u32x4 w; w.x = pk_fp8x4(acc[ai][0][m][0] * 64.f); w.y = pk_fp8x4(acc[ai][0][m][1] * 64.f); w.z = pk_fp8x4(acc[ai][1][m][0] * 64.f); w.w = pk_fp8x4(acc[ai][1][m][1] * 64.f);
                *(u32x4*)(H + off) = w; }
    }
};
struct EpiG1 {
    static constexpr bool PERM = true, PERM16 = false, FP8 = true; static constexpr int SCALE_W = 0x7A7A7A7A  , SCALE_A = 0x7C7C7C7C  ;
    unsigned char* O;
    __device__ __forceinline__ void operator()(const f32x4 (&acc)[2][2][4][2], const pg8::Unit& u, int wr, int wc, int fr, int fq) const {
        const int row0 = u.row0 + wr * 64 + fr, col0 = (u.col0 >> 1) + wc * 32 + 8 * fq;
#pragma unroll
        for (int ai = 0; ai < 2; ++ai)
#pragma unroll
            for (int m = 0; m < 4; ++m) { unsigned char* rowp = O + (size_t)(row0 + ai * 128 + m * 16) * DE + col0;
                float hv[8];
#pragma unroll
                for (int n = 0; n < 2; ++n)
#pragma unroll
                    for (int j = 0; j < 4; ++j) { const float gte = acc[ai][0][m][n][j], up = acc[ai][1][m][n][j]; hv[n * 4 + j] = gte * frcp(1.f + __expf(-gte)) * up * 8.f; }
                int w0 = __builtin_amdgcn_cvt_pk_fp8_f32(hv[0], hv[1], 0, false); w0 = __builtin_amdgcn_cvt_pk_fp8_f32(hv[2], hv[3], w0, true);
                int w1 = __builtin_amdgcn_cvt_pk_fp8_f32(hv[4], hv[5], 0, false); w1 = __builtin_amdgcn_cvt_pk_fp8_f32(hv[6], hv[7], w1, true);
                u32x2 w; w.x = (unsigned)w0; w.y = (unsigned)w1;
                *(u32x2*)rowp = w; }
    }
};
struct EpiG2 {
    static constexpr bool PERM = true, PERM16 = true, FP8 = true; static constexpr int SCALE_W = 0x79797979  , SCALE_A = 0x7C7C7C7C  ;
    unsigned char* O;
    __device__ __forceinline__ void operator()(const f32x4 (&acc)[2][2][4][2], const pg8::Unit& u, int wr, int wc, int fr, int fq) const {
        const int row0 = u.row0 + wr * 64 + fr, col0 = u.col0 + wc * 64 + 16 * fq;
#pragma unroll
        for (int ai = 0; ai < 2; ++ai)
#pragma unroll
            for (int m = 0; m < 4; ++m) { unsigned char* rowp = O + (size_t)(row0 + ai * 128 + m * 16) * DM + col0;
                u32x4 w; w.x = pk_fp8x4(acc[ai][0][m][0] * 16.f); w.y = pk_fp8x4(acc[ai][0][m][1] * 16.f); w.z = pk_fp8x4(acc[ai][1][m][0] * 16.f); w.w = pk_fp8x4(acc[ai][1][m][1] * 16.f);
                *(u32x4*)rowp = w; }
    }
};

constexpr int AT_KOFF = 0, AT_VOFF = 36864, AT_BOFF = 73728, AT_OOFF = 77824;
template <bool SWA>
__device__ __forceinline__ void attn_item(const Ctx& C, LAS unsigned char* lds, int l, int item, int tid, int wave, int lane) {
    const int tk = lane & 15, g = lane >> 4;
    int b, nb = 0, kvh = 0, hm = 0, qb = 0;
    const unsigned char *Kg, *Vg; size_t kpitch;
    if (SWA) { b = item >> 6; nb = (item >> 1) & 31; kvh = item & 1;
        Kg = (const unsigned char*)C.proj + ((size_t)b * SEQ + (size_t)(nb - 1) * 128) * INW + C_SK + kvh * 64; Vg = Kg + (C_SV - C_SK); kpitch = INW; }
    else { b = item >> 5; hm = (item >> 3) & 3; qb = item & 7;
        Kg = (const unsigned char*)C.memkv + (size_t)b * MEMLEN * 2048 + l * 512 + hm * 64; Vg = Kg + 256; kpitch = 2048; }
    __syncthreads();
#pragma unroll
    for (int i = 0; i < 4; ++i) { const int c = tid + 512 * i, key = c >> 3, part = c & 7;
        u32x2 k8 = {0u, 0u}, v8 = {0u, 0u};
        if (!SWA || nb > 0 || key >= 128) { k8 = *(const u32x2*)(Kg + (size_t)key * kpitch + part * 8); v8 = *(const u32x2*)(Vg + (size_t)key * kpitch + part * 8); }
        *(LAS u32x4*)(lds + AT_KOFF + key * 144 + part * 16) = fp8x8_to_bf16x8(k8); *(LAS u32x4*)(lds + AT_VOFF + key * 144 + part * 16) = fp8x8_to_bf16x8(v8); }
    if (SWA) ((LAS float*)(lds + AT_BOFF))[tid] = C.biastab[(kvh * 4 + (tid >> 7)) * 128 + (tid & 127)] * 1.44269504f;
    __syncthreads();
    int hq = 0; float sink = 0.f; size_t qrow_base; int qcol, ocol, i0w = 0;
    if (SWA) { hq = kvh * 4 + (wave >> 1); sink = C.sinks[l * 8 + hq]; i0w = (wave & 1) * 64; qrow_base = (size_t)b * SEQ + nb * 128 + i0w; qcol = C_SQ + hq * 64; ocol = hq * 64; }
    else { qrow_base = (size_t)b * SEQ + qb * 512 + wave * 64; qcol = C_MQ + hm * 64; ocol = 768 + hm * 64; }
    const LAS float* biasL = (const LAS float*)(lds + AT_BOFF) + (wave >> 1) * 128;
    const LAS unsigned char* kbase = lds + AT_KOFF + tk * 144 + g * 16;
    const LAS unsigned char* vbase = lds + AT_VOFF + (4 * g + (tk >> 2)) * 144 + (tk & 3) * 8;
#pragma unroll 1
    for (int rt = 0; rt < 4; ++rt) {
        const size_t qrow = qrow_base + rt * 16;
        const unsigned char* qp = (const unsigned char*)C.proj + (qrow + tk) * INW + qcol + 8 * g;
        const bf16x8 q0 = __builtin_bit_cast(bf16x8, fp8x8_to_bf16x8(*(const u32x2*)qp)), q1 = __builtin_bit_cast(bf16x8, fp8x8_to_bf16x8(*(const u32x2*)(qp + 32)));
        constexpr int NT = SWA ? 10 : 16;
        const int t0 = SWA ? ((i0w >> 4) + rt) : 0;
        f32x4 st[NT];
#pragma unroll
        for (int t = 0; t < NT; ++t) {
            const int tc = SWA ? min(t0 + t, 15) : t;
            const bf16x8 k0 = *(const LAS bf16x8*)(kbase + tc * 16 * 144), k1 = *(const LAS bf16x8*)(kbase + tc * 16 * 144 + 64);
            f32x4 a = {0.f, 0.f, 0.f, 0.f};
            a = __builtin_amdgcn_mfma_f32_16x16x32_bf16(k0, q0, a, 0, 0, 0);
            st[t] = __builtin_amdgcn_mfma_f32_16x16x32_bf16(k1, q1, a, 0, 0, 0);
        }
        constexpr float C2 = 0.125f * 1.44269504f * (1.f / 64.f);
        float mx2, sum = 0.f;
        if (SWA) {
            const float sink2 = sink * 1.44269504f;
            const int iq = i0w + rt * 16 + tk;
            const int d0 = iq + 128 - 16 * t0 - 4 * g;
            const unsigned lim = (nb > 0) ? 128u : (unsigned)min(128, iq + 1);
            const LAS float* bl = biasL + (d0 - 16 * (NT - 1) - 3);
            float m4[4] = {sink2, sink2, sink2, sink2};
#pragma unroll
            for (int t = 0; t < NT; ++t)
#pragma unroll
                for (int r = 0; r < 4; ++r) {
                    const unsigned dist = (unsigned)(d0 - 16 * t - r);
                    const float xv = (dist < lim) ? __builtin_fmaf(st[t][r], C2, bl[16 * (NT - 1 - t) + (3 - r)]) : -INFINITY;
                    st[t][r] = xv; m4[r] = fmaxf(m4[r], xv);
                }
            mx2 = fmaxf(fmaxf(m4[0], m4[1]), fmaxf(m4[2], m4[3]));
            mx2 = fmaxf(mx2, __shfl_xor(mx2, 16)); mx2 = fmaxf(mx2, __shfl_xor(mx2, 32));
            float s4[4] = {0.f, 0.f, 0.f, 0.f};
#pragma unroll
            for (int t = 0; t < NT; ++t)
#pragma unroll
                for (int r = 0; r < 4; ++r) { const float p = __builtin_amdgcn_exp2f(st[t][r] - mx2); st[t][r] = p; s4[r] += p; }
            sum = (s4[0] + s4[1]) + (s4[2] + s4[3]);
            sum += __shfl_xor(sum, 16); sum += __shfl_xor(sum, 32);
            sum += __builtin_amdgcn_exp2f(sink2 - mx2);
        } else {
            float m4[4] = {st[0][0], st[0][1], st[0][2], st[0][3]};
#pragma unroll
            for (int t = 1; t < NT; ++t)
#pragma unroll
                for (int r = 0; r < 4; ++r) m4[r] = fmaxf(m4[r], st[t][r]);
            float mr = fmaxf(fmaxf(m4[0], m4[1]), fmaxf(m4[2], m4[3]));
            mr = fmaxf(mr, __shfl_xor(mr, 16)); mr = fmaxf(mr, __shfl_xor(mr, 32));
            const float nm = -mr * C2;
            float s4[4] = {0.f, 0.f, 0.f, 0.f};
#pragma unroll
            for (int t = 0; t < NT; ++t)
#pragma unroll
                for (int r = 0; r < 4; ++r) { const float p = __builtin_amdgcn_exp2f(__builtin_fmaf(st[t][r], C2, nm)); st[t][r] = p; s4[r] += p; }
            sum = (s4[0] + s4[1]) + (s4[2] + s4[3]);
            sum += __shfl_xor(sum, 16); sum += __shfl_xor(sum, 32);
        }
        const float inv = frcp(sum);
        f32x4 o[4];
#pragma unroll
        for (int n = 0; n < 4; ++n) o[n] = (f32x4){0.f, 0.f, 0.f, 0.f};
#pragma unroll
        for (int s = 0; s < NT / 2; ++s) {
            const f32x4 pa = st[2 * s] * inv, pb = st[2 * s + 1] * inv;
            const bf16x8 pfrag = mk8(pk2(pa[0], pa[1]), pk2(pa[2], pa[3]), pk2(pb[0], pb[1]), pk2(pb[2], pb[3]));
            const int ta = SWA ? min(t0 + 2 * s, 15) : 2 * s, tb2 = SWA ? min(t0 + 2 * s + 1, 15) : 2 * s + 1;
#pragma unroll
            for (int n = 0; n < 4; ++n) {
                const s16x4 lo = ld_tr(vbase + (16 * ta) * 144 + n * 32), hi = ld_tr(vbase + (16 * tb2) * 144 + n * 32);
                const bf16x8 vf = {lo[0], lo[1], lo[2], lo[3], hi[0], hi[1], hi[2], hi[3]};
                o[n] = __builtin_amdgcn_mfma_f32_16x16x32_bf16(pfrag, vf, o[n], 0, 0, 0);
            }
        }
        LAS unsigned char* ost = lds + AT_OOFF + wave * 2304;
#pragma unroll
        for (int r = 0; r < 4; ++r)
#pragma unroll
            for (int n = 0; n < 4; n += 2) { const unsigned w = (unsigned)__builtin_amdgcn_cvt_pk_fp8_f32(o[n][r], o[n + 1][r], 0, false);
                *(LAS unsigned char*)(ost + (4 * g + r) * 80 + 16 * n + tk) = (unsigned char)(w & 0xffu); *(LAS unsigned char*)(ost + (4 * g + r) * 80 + 16 * (n + 1) + tk) = (unsigned char)((w >> 8) & 0xffu); }
        { const int orow = lane >> 2, part = lane & 3;
            const u32x4 w = *(const LAS u32x4*)(ost + orow * 80 + part * 16);
            *(u32x4*)((unsigned char*)C.mix + (size_t)(qrow + orow) * MIXW + ocol + part * 16) = w; }
    }
}

template <bool PB>
__device__ __forceinline__ void hgrn_item(const Ctx& C, LAS unsigned char* lds, int wv, int l, int witem, int lane) {
    LAS unsigned char* scr = lds + wv * 4608;
    const int tk = lane & 15, g = lane >> 4;
    const int bh = witem / NSEG, seg = witem % NSEG, b = bh >> 2, h = bh & 3;
    float oml[4][4];
#pragma unroll
    for (int c = 0; c < 4; ++c)
#pragma unroll
        for (int i = 0; i < 4; ++i) oml[c][i] = 1.f - C.lbtab[l * 256 + h * 64 + 16 * c + 4 * g + i];
    f32x4 S[4][4];
#pragma unroll
    for (int mt = 0; mt < 4; ++mt)
#pragma unroll
        for (int n = 0; n < 4; ++n) S[mt][n] = (f32x4){0.f, 0.f, 0.f, 0.f};
    float dseg[4][4];
#pragma unroll
    for (int c = 0; c < 4; ++c)
#pragma unroll
        for (int i = 0; i < 4; ++i) dseg[c][i] = 1.f;
    if (PB) {
        if (lane == 0 && wv == 0) {
            unsigned* cnt = C.ctl + CW_HA + (l * 32 + bh) * 64; unsigned sp = 0;
            while (__hip_atomic_load(cnt, __ATOMIC_RELAXED, __HIP_MEMORY_SCOPE_AGENT) < (unsigned)(NSEG / NWAVES)) { __builtin_amdgcn_s_sleep(2); if (++sp > (1u << 24)) break; }
            __builtin_amdgcn_fence(__ATOMIC_ACQUIRE, "agent");
            asm volatile("s_waitcnt vmcnt(0)" ::: "memory");
        }
    }
    if (PB) {
        LAS float* pl = (LAS float*)lds;
        const int seg0 = seg - wv;
        __syncthreads();
#pragma unroll 1
        for (int qq = 0; qq < 8; ++qq) {
            const int q = wv * 8 + qq, dq = 64 + (q >> 4) * 4 + (q & 3);
            const float* base = C.hst + (size_t)bh * NSEG * 80 * 64 + lane;
            float Sx = 0.f;
            for (int j0 = 0; j0 < seg0; j0 += 8) {
                float dv[8], sv[8];
#pragma unroll
                for (int j = 0; j < 8; ++j) { dv[j] = base[((size_t)(j0 + j) * 80 + dq) * 64]; sv[j] = base[((size_t)(j0 + j) * 80 + q) * 64]; }
#pragma unroll
                for (int j = 0; j < 8; ++j) Sx = Sx * dv[j] + sv[j];
            }
            float dv[8], sv[8];
#pragma unroll
            for (int j = 0; j < 8; ++j) { dv[j] = base[((size_t)(seg0 + j) * 80 + dq) * 64]; sv[j] = base[((size_t)(seg0 + j) * 80 + q) * 64]; }
#pragma unroll
            for (int j = 0; j < 8; ++j) { pl[(j * 64 + q) * 64 + lane] = Sx; Sx = Sx * dv[j] + sv[j]; }
        }
        __syncthreads();
#pragma unroll
        for (int mt = 0; mt < 4; ++mt)
#pragma unroll
            for (int n = 0; n < 4; ++n)
#pragma unroll
                for (int r = 0; r < 4; ++r) S[mt][n][r] = pl[(wv * 64 + (mt * 4 + n) * 4 + r) * 64 + lane];
        __syncthreads();
    }
    float nw[4][4];
    if (PB) {
#pragma unroll
        for (int c = 0; c < 4; ++c)
#pragma unroll
            for (int i = 0; i < 4; ++i) nw[c][i] = C.hnorm[l * 64 + 16 * c + 4 * g + i];
    }
    const size_t rowbase = (size_t)b * SEQ + (size_t)seg * CPS * 16;
    LAS unsigned char* sk = scr; LAS unsigned char* sv = scr + 2304;
    const LAS unsigned char* trk = sk + (4 * g + (tk >> 2)) * 144 + (tk & 3) * 8;
    const LAS unsigned char* trv = sv + (4 * g + (tk >> 2)) * 144 + (tk & 3) * 8;
    unsigned nzf[4], nvi[4];
    { const unsigned char* pr = (const unsigned char*)C.proj + (rowbase + tk) * INW + h * 64 + 4 * g;
#pragma unroll
        for (int c = 0; c < 4; ++c) { nzf[c] = *(const unsigned*)(pr + C_HF + 16 * c); nvi[c] = *(const unsigned*)(pr + C_HI + 16 * c); } }
#pragma unroll 1
    for (int ch = 0; ch < CPS; ++ch) {
        const size_t row = rowbase + ch * 16 + tk;
        unsigned zf_[4], vi_[4], zq_[4], gt_[4];
#pragma unroll
        for (int c = 0; c < 4; ++c) { zf_[c] = nzf[c]; vi_[c] = nvi[c]; }
        if (PB) { const unsigned char* pr = (const unsigned char*)C.proj + row * INW + h * 64 + 4 * g;
#pragma unroll
            for (int c = 0; c < 4; ++c) { zq_[c] = *(const unsigned*)(pr + C_HQ + 16 * c); gt_[c] = *(const unsigned*)(pr + C_HG + 16 * c); } }
        { const unsigned char* pr = (const unsigned char*)C.proj + (rowbase + (ch < CPS - 1 ? ch + 1 : ch) * 16 + tk) * INW + h * 64 + 4 * g;
#pragma unroll
            for (int c = 0; c < 4; ++c) { nzf[c] = *(const unsigned*)(pr + C_HF + 16 * c); nvi[c] = *(const unsigned*)(pr + C_HI + 16 * c); } }
        float kk[4][4], bcs[4][4], dreg[4][4];
#pragma unroll
        for (int c = 0; c < 4; ++c) { const f32x4 zf4 = dec_fp8x4(zf_[c]) * 0.125f;
#pragma unroll
            for (int i = 0; i < 4; ++i) {
                const float z = zf4[i];
                const float sneg = frcp(1.f + __expf(z));
                const float kv = oml[c][i] * sneg;
                kk[c][i] = kv;
                bcs[c][i] = row_scan16(__logf(1.f - kv));
            } }
#pragma unroll
        for (int c = 0; c < 4; ++c)
#pragma unroll
            for (int i = 0; i < 4; ++i) { const float bl = __shfl(bcs[c][i], (lane & 48) | 15); dreg[c][i] = __expf(bl); }
        unsigned kop_[4][2];
#pragma unroll
        for (int c = 0; c < 4; ++c) {
            const float e0 = kk[c][0] * __expf(-bcs[c][0]), e1 = kk[c][1] * __expf(-bcs[c][1]), e2 = kk[c][2] * __expf(-bcs[c][2]), e3 = kk[c][3] * __expf(-bcs[c][3]);
            kop_[c][0] = pk2(e0, e1); kop_[c][1] = pk2(e2, e3);
            u32x2 w; w.x = kop_[c][0]; w.y = kop_[c][1];
            *(LAS u32x2*)(sk + tk * 144 + (16 * c + 4 * g) * 2) = w;
            { const f32x4 vv = dec_fp8x4(vi_[c]) * 0.125f; u32x2 wv; wv.x = pk2(vv.x, vv.y); wv.y = pk2(vv.z, vv.w); *(LAS u32x2*)(sv + tk * 144 + (16 * c + 4 * g) * 2) = wv; }
        }
        s16x4 kT[4], vT[4];
#pragma unroll
        for (int m = 0; m < 4; ++m) { kT[m] = ld_tr(trk + m * 32); vT[m] = ld_tr(trv + m * 32); }
        f32x4 o[4];
        if (PB) {
            unsigned qop_[4][2];
#pragma unroll
            for (int c = 0; c < 4; ++c) {
                float qv[4]; const f32x4 zq4 = dec_fp8x4(zq_[c]) * 0.125f;
#pragma unroll
                for (int i = 0; i < 4; ++i) { const float z = zq4[i];
                    qv[i] = z * frcp(1.f + __expf(-z)) * 0.125f * __expf(bcs[c][i]); }
                qop_[c][0] = pk2(qv[0], qv[1]); qop_[c][1] = pk2(qv[2], qv[3]);
            }
            const bf16x8 qa = mk8(qop_[0][0], qop_[0][1], qop_[1][0], qop_[1][1]), qb2 = mk8(qop_[2][0], qop_[2][1], qop_[3][0], qop_[3][1]);
            const bf16x8 ka = mk8(kop_[0][0], kop_[0][1], kop_[1][0], kop_[1][1]), kb2 = mk8(kop_[2][0], kop_[2][1], kop_[3][0], kop_[3][1]);
            f32x4 sT = {0.f, 0.f, 0.f, 0.f};
            sT = __builtin_amdgcn_mfma_f32_16x16x32_bf16(ka, qa, sT, 0, 0, 0);
            sT = __builtin_amdgcn_mfma_f32_16x16x32_bf16(kb2, qb2, sT, 0, 0, 0);
#pragma unroll
            for (int r = 0; r < 4; ++r) if (4 * g + r > tk) sT[r] = 0.f;
            const s16x4 sT4 = mk4(pk2(sT[0], sT[1]), pk2(sT[2], sT[3]));
#pragma unroll
            for (int n = 0; n < 4; ++n) {
                f32x4 a = {0.f, 0.f, 0.f, 0.f};
                a = __builtin_amdgcn_mfma_f32_16x16x16bf16_1k(vT[n], sT4, a, 0, 0, 0);
                const bf16x8 s0 = mk8(pk2(S[0][n][0], S[0][n][1]), pk2(S[0][n][2], S[0][n][3]), pk2(S[1][n][0], S[1][n][1]), pk2(S[1][n][2], S[1][n][3]));
                const bf16x8 s1 = mk8(pk2(S[2][n][0], S[2][n][1]), pk2(S[2][n][2], S[2][n][3]), pk2(S[3][n][0], S[3][n][1]), pk2(S[3][n][2], S[3][n][3]));
                f32x4 a2 = {0.f, 0.f, 0.f, 0.f};
                a2 = __builtin_amdgcn_mfma_f32_16x16x32_bf16(s0, qa, a2, 0, 0, 0);
                a2 = __builtin_amdgcn_mfma_f32_16x16x32_bf16(s1, qb2, a2, 0, 0, 0);
                o[n] = a + a2;
            }
        }
#pragma unroll
        for (int mt = 0; mt < 4; ++mt)
#pragma unroll
            for (int n = 0; n < 4; ++n) {
                f32x4 a = __builtin_amdgcn_mfma_f32_16x16x16bf16_1k(kT[mt], vT[n], S[mt][n], 0, 0, 0);
#pragma unroll
                for (int r = 0; r < 4; ++r) a[r] *= dreg[mt][r];
                S[mt][n] = a;
            }
        if (PB) {
            float ss = 0.f;
#pragma unroll
            for (int n = 0; n < 4; ++n)
#pragma unroll
                for (int r = 0; r < 4; ++r) ss += o[n][r] * o[n][r];
            ss += __shfl_xor(ss, 16); ss += __shfl_xor(ss, 32);
            const float rinv = __builtin_amdgcn_rsqf(ss * (1.f / 64.f) + RMS_EPS);
            unsigned char* op = (unsigned char*)C.mix + row * MIXW + 512 + h * 64 + 4 * g;
#pragma unroll
            for (int n = 0; n < 4; ++n) {
                float ov[4]; const f32x4 gz4 = dec_fp8x4(gt_[n]) * 0.125f;
#pragma unroll
                for (int r = 0; r < 4; ++r) { const float z = gz4[r];
                    ov[r] = __builtin_amdgcn_fmed3f(o[n][r] * rinv * nw[n][r] * (z * frcp(1.f + __expf(-z))) * 8.f, -448.f, 448.f); }
                *(unsigned*)(op + 16 * n) = pk_fp8x4((f32x4){ov[0], ov[1], ov[2], ov[3]});
            }
        } else {
#pragma unroll
            for (int c = 0; c < 4; ++c)
#pragma unroll
                for (int i = 0; i < 4; ++i) dseg[c][i] *= dreg[c][i];
        }
    }
    if (!PB) {
        float* sl = C.hst + ((size_t)witem * 80) * 64 + lane;
#pragma unroll
        for (int mt = 0; mt < 4; ++mt)
#pragma unroll
            for (int n = 0; n < 4; ++n)
#pragma unroll
                for (int r = 0; r < 4; ++r) sl[((mt * 4 + n) * 4 + r) * 64] = S[mt][n][r];
#pragma unroll
        for (int c = 0; c < 4; ++c)
#pragma unroll
            for (int i = 0; i < 4; ++i) sl[(64 + c * 4 + i) * 64] = dseg[c][i];
        asm volatile("s_waitcnt vmcnt(0)" ::: "memory");
        __syncthreads();
        if (lane == 0 && wv == 0) {
            __builtin_amdgcn_fence(__ATOMIC_RELEASE, "agent");
            asm volatile("s_waitcnt vmcnt(0)" ::: "memory");
            __hip_atomic_fetch_add(C.ctl + CW_HA + (l * 32 + bh) * 64, 1u, __ATOMIC_RELAXED, __HIP_MEMORY_SCOPE_AGENT);
        }
    }
}

__device__ __forceinline__ void mixer_phase(const Ctx& C, LAS unsigned char* lds, int l, int tid, int wave, int lane) {
    constexpr int NH = 32 * NSEG / NWAVES;
    constexpr int N_MEM = NB * 4 * 8, N_SWA = NB * 32 * 2;
    unsigned* head = C.ctl + CW_QUEUE + l * 64;
    volatile LAS int* slot = (volatile LAS int*)(lds + LDSCTL_OFF + 256);
    for (;;) {
        __syncthreads();
        if (tid == 0) slot[0] = (int)__hip_atomic_fetch_add(head, 1u, __ATOMIC_RELAXED, __HIP_MEMORY_SCOPE_AGENT);
        __syncthreads();
        int it = __builtin_amdgcn_readfirstlane(slot[0]);
        if (it >= 2 * NH + N_MEM + N_SWA) break;
        int lane_i = lane; asm volatile("" : "+v"(lane_i));
        if (it < NH) { hgrn_item<false>(C, lds, wave, l, it * NWAVES + wave, lane_i); continue; } it -= NH;
        if (it < N_SWA / 2) { attn_item<true>(C, lds, l, it, wave * 64 + lane_i, wave, lane_i); continue; } it -= N_SWA / 2;
        if (it < NH) { hgrn_item<true>(C, lds, wave, l, it * NWAVES + wave, lane_i); continue; } it -= NH;
        if (it < N_SWA / 2) { attn_item<true>(C, lds, l, it + N_SWA / 2, wave * 64 + lane_i, wave, lane_i); continue; } it -= N_SWA / 2;
        attn_item<false>(C, lds, l, it, wave * 64 + lane_i, wave, lane_i);
    }
}

__device__ __forceinline__ float reduce_scatter16(const float (&p)[16], int lane) {
    const bool h5 = (lane & 32) != 0, h4 = (lane & 16) != 0, h3 = (lane & 8) != 0, h2 = (lane & 4) != 0;
    float q8[8], q4[4], q2[2];
#pragma unroll
    for (int i = 0; i < 8; ++i) { const float snd = h5 ? p[i] : p[i + 8], kp = h5 ? p[i + 8] : p[i]; q8[i] = kp + __shfl_xor(snd, 32); }
#pragma unroll
    for (int i = 0; i < 4; ++i) { const float snd = h4 ? q8[i] : q8[i + 4], kp = h4 ? q8[i + 4] : q8[i]; q4[i] = kp + __shfl_xor(snd, 16); }
#pragma unroll
    for (int i = 0; i < 2; ++i) { const float snd = h3 ? q4[i] : q4[i + 2], kp = h3 ? q4[i + 2] : q4[i]; q2[i] = kp + DPPF(snd, 0x128); }
    float q1; { const float snd = h2 ? q2[0] : q2[1], kp = h2 ? q2[1] : q2[0]; q1 = kp + __shfl_xor(snd, 4); }
    q1 += DPPF(q1, 0x4E); q1 += DPPF(q1, 0xB1);
    return q1;
}
__device__ __forceinline__ void route_rows16(const LAS float* lg, const float (&rb)[16], LAS unsigned* dec16, int lane) {
    const int r = lane & 15;
    float sel[16], sc[16];
#pragma unroll
    for (int q = 0; q < 4; ++q) { const f32x4 v = *(const LAS f32x4*)(lg + r * 16 + 4 * q);
        sc[4 * q] = frcp(1.f + __expf(-v.x)); sc[4 * q + 1] = frcp(1.f + __expf(-v.y)); sc[4 * q + 2] = frcp(1.f + __expf(-v.z)); sc[4 * q + 3] = frcp(1.f + __expf(-v.w)); }
#pragma unroll
    for (int e = 0; e < 16; ++e) sel[e] = sc[e] + rb[e];
    float bestv = -INFINITY, w1 = 0.f, w2 = 0.f; int e1 = 0, e2 = 1;
#pragma unroll
    for (int gi = 0; gi < 4; ++gi) {
        float m1 = sel[4 * gi], s1 = sc[4 * gi]; int i1 = 0;
#pragma unroll
        for (int i = 1; i < 4; ++i) if (sel[4 * gi + i] > m1) { m1 = sel[4 * gi + i]; s1 = sc[4 * gi + i]; i1 = i; }
        float m2 = -INFINITY, s2v = 0.f; int i2 = 0;
#pragma unroll
        for (int i = 0; i < 4; ++i) if (i != i1 && sel[4 * gi + i] > m2) { m2 = sel[4 * gi + i]; s2v = sc[4 * gi + i]; i2 = i; }
        const float gs = m1 + m2;
        if (gs > bestv) { bestv = gs; e1 = 4 * gi + i1; e2 = 4 * gi + i2; w1 = s1; w2 = s2v; }
    }
    const float wn = 1.f / (w1 + w2);
    if (lane < 16) { u32x4 d; d.x = (unsigned)e1; d.y = (unsigned)e2; d.z = __float_as_uint(w1 * wn); d.w = __float_as_uint(w2 * wn); *(LAS u32x4*)(dec16 + r * 4) = d; }
}
__device__ __forceinline__ void ln_row(const unsigned (&h)[4], const u32x2 (&x)[4], const f32x4 (&gv)[4], const f32x4 (&bv)[4], f32x4 (&v)[4]) {
    float s = 0.f;
#pragma unroll
    for (int j = 0; j < 4; ++j) { v[j] = join_fp8(x[j].x, x[j].y) * ALPHA + dec_fp8x4(h[j]) * 0.015625f;
        s += (v[j].x + v[j].y) + (v[j].z + v[j].w); }
    const float mean = wave_sum(s) * (1.f / DM); float s2 = 0.f;
#pragma unroll
    for (int j = 0; j < 4; ++j) { v[j] = v[j] - mean; s2 += (v[j].x * v[j].x + v[j].y * v[j].y) + (v[j].z * v[j].z + v[j].w * v[j].w); }
    const float rstd = __builtin_amdgcn_rsqf(wave_sum(s2) * (1.f / DM) + LN_EPS);
#pragma unroll
    for (int j = 0; j < 4; ++j) v[j] = v[j] * rstd * gv[j] + bv[j];
}
__device__ __forceinline__ void p4_ln_route(const Ctx& C, LAS unsigned char* lds, int l, int tid, int wave, int lane) {
    LAS float* wr = (LAS float*)lds;
    constexpr int WRP = DM + 4;
    LAS unsigned* dec = (LAS unsigned*)(lds + 66048);
    LAS unsigned* posb = (LAS unsigned*)(lds + 66048 + 2048);
    LAS float* lgw = (LAS float*)(lds + 66048 + 4096) + wave * 256;
    for (int i = tid; i < DM * NE; i += NTHR) { const int d = i >> 4, e = i & 15; wr[e * WRP + d] = C.w_router[i]; }
    f32x4 gv[4], bv[4];
#pragma unroll
    for (int j = 0; j < 4; ++j) { gv[j] = *((const f32x4*)(C.ln1g + l * DM) + lane + 64 * j); bv[j] = *((const f32x4*)(C.ln1b + l * DM) + lane + 64 * j); }
    float rb[16];
#pragma unroll
    for (int e = 0; e < 16; ++e) rb[e] = C.rbias[e];
    unsigned* cntl = C.ctl + CW_CNT + (l + C.rep * DEPTH) * 16 * 64;
    __syncthreads();
    for (int blk = C.vcu; blk < NTOK / 128; blk += C.G) {
        const size_t rowb = (size_t)blk * 128 + wave * 16;
        const unsigned char* hp8 = (const unsigned char*)C.hpre; unsigned char* xlo = (unsigned char*)C.xb;
        unsigned h0[4], h1[4]; u32x2 x0[4], x1[4];
#pragma unroll
        for (int j = 0; j < 4; ++j) { h0[j] = ((const unsigned*)(hp8 + rowb * DM) + lane)[64 * j]; h1[j] = ((const unsigned*)(hp8 + (rowb + 1) * DM) + lane)[64 * j];
            x0[j].x = ((const unsigned*)(C.xb8 + rowb * DM) + lane)[64 * j]; x0[j].y = ((const unsigned*)(xlo + rowb * DM) + lane)[64 * j];
            x1[j].x = ((const unsigned*)(C.xb8 + (rowb + 1) * DM) + lane)[64 * j]; x1[j].y = ((const unsigned*)(xlo + (rowb + 1) * DM) + lane)[64 * j]; }
#pragma unroll 1
        for (int pr = 0; pr < 8; ++pr) {
            const size_t row = rowb + 2 * pr; const size_t nrow = rowb + 2 * (pr < 7 ? pr + 1 : pr);
            unsigned n0[4], n1[4]; u32x2 y0[4], y1[4];
#pragma unroll
            for (int j = 0; j < 4; ++j) { n0[j] = ((const unsigned*)(hp8 + nrow * DM) + lane)[64 * j]; n1[j] = ((const unsigned*)(hp8 + (nrow + 1) * DM) + lane)[64 * j];
                y0[j].x = ((const unsigned*)(C.xb8 + nrow * DM) + lane)[64 * j]; y0[j].y = ((const unsigned*)(xlo + nrow * DM) + lane)[64 * j];
                y1[j].x = ((const unsigned*)(C.xb8 + (nrow + 1) * DM) + lane)[64 * j]; y1[j].y = ((const unsigned*)(xlo + (nrow + 1) * DM) + lane)[64 * j]; }
            f32x4 v0[4], v1[4];
            ln_row(h0, x0, gv, bv, v0); ln_row(h1, x1, gv, bv, v1);
            unsigned* xl0 = (unsigned*)(xlo + row * DM) + lane; unsigned* xl1 = (unsigned*)(xlo + (row + 1) * DM) + lane;
            unsigned* x80 = (unsigned*)(C.xb8 + row * DM) + lane; unsigned* x81 = (unsigned*)(C.xb8 + (row + 1) * DM) + lane;
#pragma unroll
            for (int j = 0; j < 4; ++j) { unsigned hi, lo; split_fp8(v0[j], hi, lo); x80[64 * j] = hi; xl0[64 * j] = lo; split_fp8(v1[j], hi, lo); x81[64 * j] = hi; xl1[64 * j] = lo; }
            float p0[16], p1[16];
#pragma unroll
            for (int e = 0; e < 16; ++e) {
                f32x2 a0 = {0.f, 0.f}, a1 = {0.f, 0.f};
#pragma unroll
                for (int j = 0; j < 4; ++j) { const f32x4 w = *((const LAS f32x4*)(wr + e * WRP) + lane + 64 * j);
                    const f32x2 wl = {w.x, w.y}, wh = {w.z, w.w};
                    a0 = __builtin_elementwise_fma((f32x2){v0[j].x, v0[j].y}, wl, a0); a0 = __builtin_elementwise_fma((f32x2){v0[j].z, v0[j].w}, wh, a0);
                    a1 = __builtin_elementwise_fma((f32x2){v1[j].x, v1[j].y}, wl, a1); a1 = __builtin_elementwise_fma((f32x2){v1[j].z, v1[j].w}, wh, a1); }
                p0[e] = a0.x + a0.y; p1[e] = a1.x + a1.y;
            }
            const float qa = reduce_scatter16(p0, lane), qb = reduce_scatter16(p1, lane);
            if ((lane & 3) == 0) { lgw[(2 * pr) * 16 + (lane >> 2)] = qa; lgw[(2 * pr + 1) * 16 + (lane >> 2)] = qb; }
#pragma unroll
            for (int j = 0; j < 4; ++j) { h0[j] = n0[j]; h1[j] = n1[j]; x0[j] = y0[j]; x1[j] = y1[j]; }
        }
        route_rows16(lgw, rb, dec + wave * 16 * 4, lane);
        __syncthreads();
        if (wave == 0) {
            unsigned ea[4], rk[4]; unsigned tot = 0;
#pragma unroll
            for (int i = 0; i < 4; ++i) { const int a = lane + 64 * i; ea[i] = dec[(a >> 1) * 4 + (a & 1)]; rk[i] = 0; }
#pragma unroll
            for (int e = 0; e < 16; ++e) {
                unsigned run = 0;
#pragma unroll
                for (int i = 0; i < 4; ++i) { const unsigned long long m = __ballot(ea[i] == (unsigned)e);
                    const unsigned below = __builtin_amdgcn_mbcnt_hi((unsigned)(m >> 32), __builtin_amdgcn_mbcnt_lo((unsigned)m, 0u));
                    if (ea[i] == (unsigned)e) rk[i] = run + below;
                    run += (unsigned)__popcll(m); }
                if (lane == e) tot = run;
            }
            unsigned base = 0;
            if (lane < 16) base = tot ? atomicAdd(cntl + 64 * lane, tot) : 0u;
#pragma unroll
            for (int i = 0; i < 4; ++i) { const unsigned bs = __shfl(base, (int)ea[i]); const unsigned pos = bs + rk[i]; const int a = lane + 64 * i;
                posb[a] = pos; C.list[(size_t)ea[i] * LCAP + pos] = blk * 128 + (a >> 1); }
        }
        __syncthreads();
        if (tid < 128) { u32x4 rec; rec.x = (dec[tid * 4] << 16) | posb[tid * 2]; rec.y = (dec[tid * 4 + 1] << 16) | posb[tid * 2 + 1]; rec.z = dec[tid * 4 + 2]; rec.w = dec[tid * 4 + 3];
            C.tokrec[(size_t)blk * 128 + tid] = rec; }
        __syncthreads();
    }
}

__device__ __forceinline__ void moe_prefix(const Ctx& C, LAS int* tb, int l, int tid) {
    if (tid == 0) {
        unsigned* cntl = C.ctl + CW_CNT + l * 16 * 64; int acc = 0;
        for (int e = 0; e < 16; ++e) { const int c = (int)__hip_atomic_load(cntl + 64 * e, __ATOMIC_RELAXED, __HIP_MEMORY_SCOPE_AGENT); tb[e] = acc; tb[17 + e] = c; acc += (c + 255) >> 8; }
        tb[16] = acc;
    }
    __syncthreads();
}

__device__ __forceinline__ void p7_combine(const Ctx& C, LAS unsigned char* lds, int l, int tid, int wave, int lane) {
    LAS int* tb = (LAS int*)lds;
    moe_prefix(C, tb, l, tid);
    f32x4 gv[4], bv[4];
#pragma unroll
    for (int j = 0; j < 4; ++j) { gv[j] = *((const f32x4*)(C.ln2g + l * DM) + lane + 64 * j); bv[j] = *((const f32x4*)(C.ln2b + l * DM) + lane + 64 * j); }
    const bool lastl = (l == DEPTH - 1);
    for (int r0 = (C.vcu * NWAVES + wave) * 16; r0 < NTOK; r0 += C.G * NWAVES * 16) {
        u32x4 rec = C.tokrec[r0 + (lane & 15)];
        const unsigned sa_l = (unsigned)tb[rec.x >> 16] * 256u + (rec.x & 0xffffu), sb_l = (unsigned)tb[rec.y >> 16] * 256u + (rec.y & 0xffffu);
#pragma unroll 1
        for (int bq = 0; bq < 2; ++bq) {
            u32x2 xv[8][4]; unsigned av[8][4], bw[8][4]; float wa[8], wb[8];
#pragma unroll
            for (int k = 0; k < 8; ++k) { const int idx = bq * 8 + k;
                const size_t sa = (size_t)__builtin_amdgcn_readlane(sa_l, idx), sb = (size_t)__builtin_amdgcn_readlane(sb_l, idx);
                wa[k] = __uint_as_float(__builtin_amdgcn_readlane(rec.z, idx)) * 0.0625f; wb[k] = __uint_as_float(__builtin_amdgcn_readlane(rec.w, idx)) * 0.0625f;
                const unsigned* xph = (const unsigned*)(C.xb8 + (size_t)(r0 + idx) * DM) + lane; const unsigned* xpl = (const unsigned*)((const unsigned char*)C.xb + (size_t)(r0 + idx) * DM) + lane; const unsigned* ya = (const unsigned*)((const unsigned char*)C.ys + sa * DM) + lane; const unsigned* yb = (const unsigned*)((const unsigned char*)C.ys + sb * DM) + lane;
#pragma unroll
                for (int j = 0; j < 4; ++j) { xv[k][j].x = xph[64 * j]; xv[k][j].y = xpl[64 * j]; av[k][j] = ya[64 * j]; bw[k][j] = yb[64 * j]; } }
#pragma unroll
            for (int k = 0; k < 8; ++k) { const int row = r0 + bq * 8 + k;
                f32x4 v[4]; float s = 0.f;
#pragma unroll
                for (int j = 0; j < 4; ++j) { const u32x2 x2 = xv[k][j];
                    const f32x2 al = __builtin_amdgcn_cvt_pk_f32_fp8((int)av[k][j], false), ah = __builtin_amdgcn_cvt_pk_f32_fp8((int)av[k][j], true);
                    const f32x2 bl = __builtin_amdgcn_cvt_pk_f32_fp8((int)bw[k][j], false), bh = __builtin_amdgcn_cvt_pk_f32_fp8((int)bw[k][j], true);
                    const f32x4 xr = join_fp8(x2.x, x2.y) * ALPHA;
                    v[j].x = xr.x + (al.x * wa[k] + bl.x * wb[k]); v[j].y = xr.y + (al.y * wa[k] + bl.y * wb[k]);
                    v[j].z = xr.z + (ah.x * wa[k] + bh.x * wb[k]); v[j].w = xr.w + (ah.y * wa[k] + bh.y * wb[k]);
                    s += (v[j].x + v[j].y) + (v[j].z + v[j].w); }
                const float mean = wave_sum(s) * (1.f / DM); float s2 = 0.f;
#pragma unroll
                for (int j = 0; j < 4; ++j) { v[j] = v[j] - mean; s2 += (v[j].x * v[j].x + v[j].y * v[j].y) + (v[j].z * v[j].z + v[j].w * v[j].w); }
                const float rstd = __builtin_amdgcn_rsqf(wave_sum(s2) * (1.f / DM) + LN_EPS);
                if (lastl) { f32x4* xo = (f32x4*)(C.xcur + (size_t)row * DM) + lane;
#pragma unroll
                    for (int j = 0; j < 4; ++j) xo[64 * j] = v[j] * rstd * gv[j] + bv[j]; }
                else { unsigned* xlo = (unsigned*)((unsigned char*)C.xb + (size_t)row * DM) + lane; unsigned* x8o = (unsigned*)(C.xb8 + (size_t)row * DM) + lane;
#pragma unroll
                    for (int j = 0; j < 4; ++j) { const f32x4 y = v[j] * rstd * gv[j] + bv[j]; unsigned hi, lo; split_fp8(y, hi, lo); x8o[64 * j] = hi; xlo[64 * j] = lo; } }
            }
        }
    }
}

template <class T> __device__ __forceinline__ T* as_g(T* p) { return (T*)(GAS T*)p; }
typedef const __attribute__((address_space(4))) Args* KArgs;
__device__ __forceinline__ Ctx make_ctx(KArgs ap) {
    asm volatile("" : "+s"(ap));
    Ctx C;
    C.x = as_g(ap->in[0]); C.mem = as_g(ap->in[1]); C.w_in = as_g(ap->in[2]); C.b_in = as_g(ap->in[3]); C.w_mem_kv = as_g(ap->in[4]); C.sinks = as_g(ap->in[5]); C.rel_bias = as_g(ap->in[6]); C.lb_logits = as_g(ap->in[7]);
    C.hnorm = as_g(ap->in[8]); C.w_out = as_g(ap->in[9]); C.ln1g = as_g(ap->in[10]); C.ln1b = as_g(ap->in[11]); C.w_router = as_g(ap->in[12]); C.rbias = as_g(ap->in[13]); C.w_gate = as_g(ap->in[14]); C.w_up = as_g(ap->in[15]);
    C.w_down = as_g(ap->in[16]); C.ln2g = as_g(ap->in[17]); C.ln2b = as_g(ap->in[18]);
    unsigned char* ws = as_g(ap->ws);
    C.xcur = as_g(ap->out); C.ws = ws; C.ctl = (unsigned*)(ws + WS_CTL);
    C.Win = (bf16*)(ws + WS_WIN); C.Wout = (bf16*)(ws + WS_WOUT); C.Wmem = (bf16*)(ws + WS_WMEM); C.W1 = (bf16*)(ws + WS_W1); C.W2 = (bf16*)(ws + WS_W2);
    C.xb = (bf16*)(ws + WS_XB); C.proj = (bf16*)(ws + WS_BIG); C.hpre = (bf16*)(ws + WS_BIG); C.ys = (bf16*)(ws + WS_BIG);
    C.mix = (bf16*)(ws + WS_MIX); C.hmid = (bf16*)(ws + WS_MIX); C.memkv = (bf16*)(ws + WS_MEMKV); C.memb = (bf16*)(ws + WS_MEMB);
    C.biastab = (float*)(ws + WS_TAB); C.lbtab = (float*)(ws + WS_TAB + 4096); C.list = (int*)(ws + WS_LIST); C.tokrec = (u32x4*)(ws + WS_TOKREC); C.hst = (float*)(ws + WS_HST); C.xb8 = ws + WS_XB8;
    C.rep = ap->rep; C.G = gridDim.x; { const int bx = blockIdx.x; C.vcu = (C.G % 8 == 0) ? (bx % 8) * (C.G / 8) + bx / 8 : bx; }
    return C;
}
constexpr int PH_PER_LAYER = 7, N_PHASES = 1 + DEPTH * PH_PER_LAYER;
__global__ void __launch_bounds__(NTHR, 2) trunk_fwd(Args args) {
    extern __shared__ __attribute__((aligned(16))) unsigned char lds_raw[];
    LAS unsigned char* lds = (LAS unsigned char*)lds_raw;
    volatile LAS unsigned* MISC = (volatile LAS unsigned*)(lds + MISC_OFF);
    const int tid0 = threadIdx.x; const int wave0 = __builtin_amdgcn_readfirstlane(tid0 >> 6);
    for (int u = tid0; u < (LDS_BYTES - LDSCTL_OFF) / 4; u += NTHR) ((LAS unsigned*)(lds + LDSCTL_OFF))[u] = 0u;
    __syncthreads();
    KArgs ap = (KArgs)__builtin_amdgcn_kernarg_segment_ptr();
    XcdBarrier bar; bar.bar = (unsigned*)(as_g(args.ws) + WS_CTL) + CW_BAR; bar.x = 0; bar.st = nullptr;
    if (args.use_bar) bar = xcd_barrier_post((unsigned*)(as_g(args.ws) + WS_CTL) + CW_BAR, MISC + 8);
    const int lo = args.ph_lo, hi = args.ph_hi;
#define IN(k) (lo <= (k) && (k) < hi)
#define PHASE_IDS unsigned ones_ = ~0u; asm volatile("" : "+s"(ones_)); int lane = (int)__builtin_amdgcn_mbcnt_hi(ones_, __builtin_amdgcn_mbcnt_lo(ones_, 0u)); asm volatile("" : "+v"(lane)); int wave = wave0; asm volatile("" : "+s"(wave)); const int tid = wave * 64 + lane; (void)tid
#define SEAM(k) do { if (IN(k) && IN((k) + 1)) { XcdBarrier b2_ = bar; unsigned z_ = 0u; asm volatile("" : "+s"(z_)); b2_.bar = bar.bar + z_; xcd_barrier(b2_); } } while (0)

    if (IN(0)) { PHASE_IDS; const Ctx C = make_ctx(ap); p0_prologue(C, lds, wave, lane); }
    SEAM(0);
#pragma unroll 1
    for (int l = 0; l < DEPTH; ++l) {
        const int pb = 1 + l * PH_PER_LAYER;
        if (IN(pb + 0)) {
            PHASE_IDS; const Ctx C = make_ctx(ap);
            DenseSched S; S.A0 = (const char*)C.xb8; S.B0 = (const char*)C.Win + (size_t)l * INW * DM; S.nM0 = NTOK / 256; S.nN0 = INW / 256; S.K0 = DM  ;
            S.A1 = (const char*)C.memb; S.B1 = (const char*)C.Wmem; S.nM1 = (l == 0) ? (NB * MEMLEN) / 256 : 0; S.nN1 = 2048 / 256; S.G = C.G; S.c = (int)blockIdx.x;
            EpiProj E{(unsigned char*)C.proj, C.b_in + l * INW, (unsigned char*)C.memkv};
            pg8::gemm_phase<EpiProj, DenseSched, true>(lds, tid, DM, S, E);
        }
        SEAM(pb + 0);
        if (IN(pb + 1)) { PHASE_IDS; const Ctx C = make_ctx(ap); mixer_phase(C, lds, l, tid, wave, lane); }
        SEAM(pb + 1);
        if (IN(pb + 2)) {
            PHASE_IDS; const Ctx C = make_ctx(ap);
            DenseSched S; S.A0 = (const char*)C.mix; S.B0 = (const char*)C.Wout + (size_t)l * DM * MIXW; S.nM0 = NTOK / 256; S.nN0 = DM / 256; S.K0 = MIXW  ;
            S.A1 = nullptr; S.B1 = nullptr; S.nM1 = 0; S.nN1 = 0; S.G = C.G; S.c = (int)blockIdx.x;
            EpiOut E{(unsigned char*)C.hpre};
            pg8::gemm_phase<EpiOut, DenseSched, true>(lds, tid, MIXW, S, E);
        }
        SEAM(pb + 2);
        if (IN(pb + 3)) { PHASE_IDS; const Ctx C = make_ctx(ap); p4_ln_route(C, lds, l, tid, wave, lane); }
        SEAM(pb + 3);
        if (IN(pb + 4)) {
            PHASE_IDS; const Ctx C = make_ctx(ap);
            LAS int* tb = (LAS int*)(lds + LDSCTL_OFF + 64);
            moe_prefix(C, tb, l, tid);
            const int U = tb[16] * 4;
            MoeSched<true> S; S.A = (const char*)C.xb8; S.Bl = (const char*)C.W1 + (size_t)l * NE * 1024 * DM; S.K = DM  ; S.bstride = (size_t)1024 * DM; S.list = C.list; S.tb = tb;
            S.mode = 0; S.g0 = C.vcu; S.g1 = C.G; S.gU = U < 1024 ? U : 1024;
            EpiG1 E{(unsigned char*)C.hmid};
            pg8::gemm_phase<EpiG1, MoeSched<true>, true>(lds, tid, DM, S, E);
        }
        SEAM(pb + 4);
        if (IN(pb + 5)) {
            PHASE_IDS; const Ctx C = make_ctx(ap);
            LAS int* tb = (LAS int*)(lds + LDSCTL_OFF + 64);
            moe_prefix(C, tb, l, tid);
            const int U = tb[16] * 4, Etail = U > 1024 ? U - 1024 : 0;
            if (C.vcu < Etail) {
                MoeSched<true> S; S.A = (const char*)C.xb8; S.Bl = (const char*)C.W1 + (size_t)l * NE * 1024 * DM; S.K = DM  ; S.bstride = (size_t)1024 * DM; S.list = C.list; S.tb = tb;
                S.mode = 0; S.g0 = 1024 + C.vcu; S.g1 = 1 << 20; S.gU = 1024 + C.vcu + 1;
                EpiG1 E{(unsigned char*)C.hmid};
                pg8::gemm_phase<EpiG1, MoeSched<true>, true>(lds, tid, DM, S, E);
                asm volatile("s_waitcnt vmcnt(0)" ::: "memory");
                __syncthreads();
                if (tid == 0) {
                    unsigned* cnt = C.ctl + CW_TILE + (l * 16 + (C.vcu >> 2)) * 64; unsigned sp = 0;
                    __builtin_amdgcn_fence(__ATOMIC_RELEASE, "agent");
                    asm volatile("s_waitcnt vmcnt(0)" ::: "memory");
                    __hip_atomic_fetch_add(cnt, 1u, __ATOMIC_RELAXED, __HIP_MEMORY_SCOPE_AGENT);
                    while (__hip_atomic_load(cnt, __ATOMIC_RELAXED, __HIP_MEMORY_SCOPE_AGENT) < 4u) { __builtin_amdgcn_s_sleep(2); if (++sp > (1u << 24)) break; }
                    __builtin_amdgcn_fence(__ATOMIC_ACQUIRE, "agent");
                    asm volatile("s_waitcnt vmcnt(0)" ::: "memory");
                }
                __syncthreads();
            }
            MoeSched<false> S; S.A = (const char*)C.hmid; S.Bl = (const char*)C.W2 + (size_t)l * NE * DM * DE; S.K = DE  ; S.bstride = (size_t)DM * DE; S.list = C.list; S.tb = tb;
            S.mode = 1; S.g0 = C.vcu; S.g1 = Etail; S.gU = U < 1024 ? U : 1024;
            EpiG2 E{(unsigned char*)C.ys};
            pg8::gemm_phase<EpiG2, MoeSched<false>, true>(lds, tid, DE, S, E);
        }
        SEAM(pb + 5);
        if (IN(pb + 6)) { PHASE_IDS; const Ctx C = make_ctx(ap); p7_combine(C, lds, l, tid, wave, lane); }
        SEAM(pb + 6);
    }
#undef IN
#undef SEAM
}

#ifndef ONE_LAUNCH
#define ONE_LAUNCH 1
#endif
extern "C" void kernel_launch(void* const* d_in, const int* in_sizes, int n_in, void* d_out, int out_size, void* d_ws, size_t ws_size, hipStream_t stream) {
    static int grid = 0;
    if (grid == 0) {
        if (n_in != 19 || in_sizes[0] != NTOK * DM || out_size != NTOK * DM || ws_size < WS_END) {
            fprintf(stderr, "kernel_launch: unexpected shapes (n_in %d, in0 %d, out %d, ws %zu < %zu); nothing launched\n", n_in, n_in > 0 ? in_sizes[0] : -1, out_size, ws_size, (size_t)WS_END); grid = -1; return; }
        int dev = 0, cus = 0, per_cu = 0;
        if (hipGetDevice(&dev) != hipSuccess || hipDeviceGetAttribute(&cus, hipDeviceAttributeMultiprocessorCount, dev) != hipSuccess) { grid = -1; return; }
        if (hipFuncSetAttribute((const void*)trunk_fwd, hipFuncAttributeMaxDynamicSharedMemorySize, LDS_BYTES) != hipSuccess) { fprintf(stderr, "kernel_launch: hipFuncSetAttribute failed\n"); grid = -1; return; }
        if (hipOccupancyMaxActiveBlocksPerMultiprocessor(&per_cu, (const void*)trunk_fwd, NTHR, LDS_BYTES) != hipSuccess || per_cu < 1) { fprintf(stderr, "kernel_launch: occupancy query says %d\n", per_cu); }
        (void)hipGetLastError();
        grid = cus;
        fprintf(stderr, "kernel_launch: grid %d, occupancy/CU %d, ws %zu\n", grid, per_cu, ws_size);
    }
    if (grid < 0) return;
    (void)hipMemsetAsync((char*)d_ws + WS_CTL, 0, CTL_ZERO_BYTES, stream);
    Args a{};
    for (int i = 0; i < 19; ++i) a.in[i] = (const float*)d_in[i];
    a.out = (float*)d_out; a.ws = (unsigned char*)d_ws;
#if ONE_LAUNCH
    a.ph_lo = 0; a.ph_hi = N_PHASES; a.use_bar = 1;
    void* kargs[] = {&a};
    hipError_t e = hipLaunchCooperativeKernel((const void*)trunk_fwd, dim3(grid), dim3(NTHR), kargs, LDS_BYTES, stream);
    if (e != hipSuccess) fprintf(stderr, "kernel_launch: cooperative launch failed: %s\n", hipGetErrorString(e));
#else
    for (int p = 0; p < N_PHASES; ++p) {
        a.ph_lo = p; a.ph_hi = p + 1; a.use_bar = 0;
        hipLaunchKernelGGL(trunk_fwd, dim3(grid), dim3(NTHR), LDS_BYTES, stream, a);
    }
#endif
}
```

```cpp
#include <hip/hip_runtime.h>
#include <cstdio>
#include <cstdint>

#define LAS __attribute__((address_space(3)))
#define GAS __attribute__((address_space(1)))
typedef unsigned short bf16;
typedef short bf16x8 __attribute__((ext_vector_type(8)));
typedef short s16x4 __attribute__((ext_vector_type(4)));
typedef float f32x4 __attribute__((ext_vector_type(4)));
typedef float f32x2 __attribute__((ext_vector_type(2)));
typedef unsigned u32x4 __attribute__((ext_vector_type(4)));
typedef unsigned u32x2 __attribute__((ext_vector_type(2)));
typedef int i32x4 __attribute__((ext_vector_type(4)));
typedef int i32x8 __attribute__((ext_vector_type(8)));
typedef __bf16 bf16x2_t __attribute__((ext_vector_type(2)));

constexpr int NB = 8, SEQ = 4096, DM = 1024, NTOK = NB * SEQ, DEPTH = 4;
constexpr int INW = 2048, MIXW = 1024, NE = 16, DE = 512, MEMLEN = 256;
constexpr int C_SQ = 0, C_SK = 512, C_SV = 640, C_HQ = 768, C_HF = 1024, C_HI = 1280, C_HG = 1536, C_MQ = 1792;
constexpr float ALPHA = 1.6817928305074290f;
constexpr float LN_EPS = 1e-5f, RMS_EPS = 1e-6f;
constexpr int NSEG = 32, CPS = (SEQ / 16) / NSEG;
constexpr int LCAP = 32768;
constexpr int MAXTILES = NTOK * 2 / 256 + NE;
constexpr int NWAVES = 8, NTHR = 512;

constexpr size_t MiB = 1u << 20;
constexpr size_t WS_CTL = 0, CTL_ZERO_BYTES = 1 * MiB;
constexpr size_t WS_TAB = 1 * MiB;
constexpr size_t WS_WIN = 2 * MiB;
constexpr size_t WS_WOUT = 18 * MiB;
constexpr size_t WS_WMEM = 26 * MiB;
constexpr size_t WS_W1 = 30 * MiB;
constexpr size_t WS_XB8 = 94 * MiB;
constexpr size_t WS_W2 = 158 * MiB;
constexpr size_t WS_XB = 222 * MiB;
constexpr size_t WS_BIG = 286 * MiB;
constexpr size_t WS_MIX = 430 * MiB;
constexpr size_t WS_MEMKV = 502 * MiB;
constexpr size_t WS_MEMB = 510 * MiB;
constexpr size_t WS_LIST = 514 * MiB;
constexpr size_t WS_TOKREC = 516 * MiB;
constexpr size_t WS_HST = 517 * MiB;
constexpr size_t WS_END = 538 * MiB;
constexpr int CW_BAR = 4096;
constexpr int CW_CNT = 16384;
constexpr int CW_QUEUE = 32768;
constexpr int CW_TILE = 57344;
constexpr int CW_HA = 49152;

constexpr int RING_BYTES = 131072;
constexpr int LDSCTL_OFF = RING_BYTES, MISC_OFF = LDSCTL_OFF + 320;
constexpr int LDS_BYTES = 147456;

__device__ __forceinline__ unsigned pk2(float lo, float hi) { f32x2 v = {lo, hi}; bf16x2_t b = __builtin_convertvector(v, bf16x2_t); return __builtin_bit_cast(unsigned, b); }
__device__ __forceinline__ unsigned pk_fp8x4(f32x4 v) { int w = __builtin_amdgcn_cvt_pk_fp8_f32(v.x, v.y, 0, false); w = __builtin_amdgcn_cvt_pk_fp8_f32(v.z, v.w, w, true); return (unsigned)w; }
__device__ __forceinline__ f32x4 dec_fp8x4(unsigned w) { const f32x2 a = __builtin_amdgcn_cvt_pk_f32_fp8((int)w, false), b = __builtin_amdgcn_cvt_pk_f32_fp8((int)w, true); return (f32x4){a.x, a.y, b.x, b.y}; }
__device__ __forceinline__ void split_fp8(f32x4 y, unsigned& hi, unsigned& lo) { const f32x4 y8 = y * 8.f; hi = pk_fp8x4(y8); lo = pk_fp8x4((y8 - dec_fp8x4(hi)) * 16.f); }
__device__ __forceinline__ f32x4 join_fp8(unsigned hi, unsigned lo) { return dec_fp8x4(hi) * 0.125f + dec_fp8x4(lo) * 0.0078125f; }
__device__ __forceinline__ u32x4 fp8x8_to_bf16x8(u32x2 w) { const f32x4 a = dec_fp8x4(w.x), b = dec_fp8x4(w.y); u32x4 o; o.x = pk2(a.x, a.y); o.y = pk2(a.z, a.w); o.z = pk2(b.x, b.y); o.w = pk2(b.z, b.w); return o; }
__device__ __forceinline__ float frcp(float x) { return __builtin_amdgcn_rcpf(x); }
__device__ __forceinline__ float bflo(unsigned w) { return __uint_as_float(w << 16); }
__device__ __forceinline__ float bfhi(unsigned w) { return __uint_as_float(w & 0xffff0000u); }
#define DPPF(v, ctrl) __int_as_float(__builtin_amdgcn_update_dpp(0, __float_as_int(v), (ctrl), 0xf, 0xf, true))
__device__ __forceinline__ float wave_sum(float v) {
    v += DPPF(v, 0xB1);
    v += DPPF(v, 0x4E);
    v += DPPF(v, 0x141);
    v += DPPF(v, 0x140);
    v += __shfl_xor(v, 16); v += __shfl_xor(v, 32);
    return v;
}
__device__ __forceinline__ s16x4 ld_tr(const LAS unsigned char* p) { return __builtin_amdgcn_ds_read_tr16_b64_v4i16((LAS s16x4*)p); }
__device__ __forceinline__ float row_scan16(float x) {
    x += __int_as_float(__builtin_amdgcn_update_dpp(0, __float_as_int(x), 0x111, 0xf, 0xf, true));
    x += __int_as_float(__builtin_amdgcn_update_dpp(0, __float_as_int(x), 0x112, 0xf, 0xf, true));
    x += __int_as_float(__builtin_amdgcn_update_dpp(0, __float_as_int(x), 0x114, 0xf, 0xf, true));
    x += __int_as_float(__builtin_amdgcn_update_dpp(0, __float_as_int(x), 0x118, 0xf, 0xf, true));
    return x;
}
__device__ __forceinline__ bf16x8 mk8(unsigned a, unsigned b, unsigned c, unsigned d) { u32x4 w = {a, b, c, d}; return __builtin_bit_cast(bf16x8, w); }
__device__ __forceinline__ s16x4 mk4(unsigned a, unsigned b) { u32x2 w = {a, b}; return __builtin_bit_cast(s16x4, w); }

namespace pg8 {
constexpr int BM = 256, BK = 64, HALF = 128, HTB = HALF * BK * 2, STAGE_BYTES = 8 * HTB, NXCD = 8, WGM = 8;
constexpr int NXT_SLOT_OFF = 131072 + 2048;
__host__ __device__ __forceinline__ int lds_byte(int r, int c) { const int st = (r >> 4) * 2 + (c >> 5), rr = r & 15, cc = c & 31, ob = rr * 64 + cc * 2; return st * 1024 + (ob ^ (((ob >> 9) & 1) << 5)); }
__host__ __device__ __forceinline__ void stage_rc(int b, int& R, int& C) { const int st = b / 1024, sb = b % 1024, swz = sb ^ (((sb >> 9) & 1) << 5); R = (st >> 1) * 16 + swz / 64; C = (st & 1) * 32 + (swz % 64) / 2; }
__host__ __device__ __forceinline__ int perm32(int rho) { const int n = rho >> 4, i = rho & 15; return 8 * (i >> 2) + 4 * n + (i & 3); }
__host__ __device__ __forceinline__ int perm256(int R) { const int bj = R >> 7, wc = (R >> 5) & 3, n = (R >> 4) & 1, i = R & 15; return 64 * wc + 16 * (i >> 2) + 8 * bj + 4 * n + (i & 3); }

struct Unit {
    const char* A;
    const char* B;
    unsigned a00, a01, a10, a11;
    int row0, col0, aux;
};
__device__ __forceinline__ void tile_order(int L, int nM, int nN, int& pm, int& pn) {
    const int nwg = nM * nN; int wgid = L;
    { const int q = nwg / NXCD, r = nwg % NXCD, xcd = wgid % NXCD, off = wgid / NXCD; wgid = (xcd < r ? xcd * (q + 1) : r * (q + 1) + (xcd - r) * q) + off; }
    const int nig = WGM * nN, gid = wgid / nig, fm = gid * WGM, gsz = (nM - fm) < WGM ? (nM - fm) : WGM;
    pm = fm + ((wgid % nig) % gsz); pn = (wgid % nig) / gsz;
}

template <class Epi, class Sched, bool ALIGN_EPI>
__device__ __forceinline__ void gemm_phase(LAS unsigned char* lds, const int tid, const int RB  , Sched& S, const Epi& E) {
    const int wid = __builtin_amdgcn_readfirstlane(tid >> 6), lane = tid & 63, wr = wid >> 2, wc = wid & 3, fr = lane & 15, fq = lane >> 4;
    const int nt = RB / 128;
    unsigned voffB[2], voffA[2] = {0u, 0u};
    {
        int Ra[2], Ca[2];
#pragma unroll
        for (int i = 0; i < 2; ++i) { int R, C; stage_rc(tid * 16 + i * 8192, R, C); const int Rb = Epi::PERM16 ? perm256(R) : (Epi::PERM ? ((R & ~31) + perm32(R & 31)) : R);
            Ra[i] = R; Ca[i] = C; voffB[i] = (unsigned)(Rb * RB + 2 * C); }
        S.lane_init(Ra[0], Ca[0], Ra[1], Ca[1]);
        if constexpr (!Sched::GATHER) { voffA[0] = (unsigned)(Ra[0] * RB + 2 * Ca[0]); voffA[1] = (unsigned)(Ra[1] * RB + 2 * Ca[1]); }
    }
    const size_t kstep = (size_t)(BK * 2);
    const size_t hstepB = (size_t)HALF * RB;
    const size_t hstepW = Epi::PERM16 ? (size_t)8 * RB : hstepB;
    const unsigned ldsw = (unsigned)wid * 1024u;
    const int aoff = lds_byte(wr * 64 + fr, fq * 8), boff = lds_byte(wc * 32 + fr, fq * 8);
#define PG8_SA(b, h) (((b) * 2 + (h)) * HTB)
#define PG8_SB(b, h) ((4 + (b) * 2 + (h)) * HTB)
#define PG8_STAGE_B(bufoff, gbase) do { _Pragma("unroll") for (int _i = 0; _i < 2; ++_i) \
        __builtin_amdgcn_global_load_lds((const unsigned*)((const char*)(gbase) + voffB[_i]), (LAS unsigned*)(lds + (bufoff) + ldsw + _i * 8192), 16, 0, 0); } while (0)
#define PG8_STAGE_A(bufoff, gbase, hf, o0, o1) do { if constexpr (Sched::GATHER) { \
        __builtin_amdgcn_global_load_lds((const unsigned*)((const char*)(gbase) + (o0)), (LAS unsigned*)(lds + (bufoff) + ldsw), 16, 0, 0); \
        __builtin_amdgcn_global_load_lds((const unsigned*)((const char*)(gbase) + (o1)), (LAS unsigned*)(lds + (bufoff) + ldsw + 8192), 16, 0, 0); } else { \
        __builtin_amdgcn_global_load_lds((const unsigned*)((const char*)(gbase) + (hf) * hstepB + voffA[0]), (LAS unsigned*)(lds + (bufoff) + ldsw), 16, 0, 0); \
        __builtin_amdgcn_global_load_lds((const unsigned*)((const char*)(gbase) + (hf) * hstepB + voffA[1]), (LAS unsigned*)(lds + (bufoff) + ldsw + 8192), 16, 0, 0); } } while (0)
#define PG8_LDA(dst, b, h) do { _Pragma("unroll") for (int m = 0; m < 4; ++m) { dst[m].lo = *(const LAS i32x4*)(lds + PG8_SA(b, h) + aoff + m * 2048); dst[m].hi = *(const LAS i32x4*)(lds + PG8_SA(b, h) + aoff + m * 2048 + 1024); } } while (0)
#define PG8_LDB(dst, b, h) do { _Pragma("unroll") for (int n = 0; n < 2; ++n) { dst[n].lo = *(const LAS i32x4*)(lds + PG8_SB(b, h) + boff + n * 2048); dst[n].hi = *(const LAS i32x4*)(lds + PG8_SB(b, h) + boff + n * 2048 + 1024); } } while (0)
#define PG8_MMA(ai, bj, At, Bt) do { __builtin_amdgcn_s_setprio(1); _Pragma("unroll") for (int m = 0; m < 4; ++m) _Pragma("unroll") for (int n = 0; n < 2; ++n) { \
        if constexpr (Epi::FP8) asm volatile("v_mfma_scale_f32_16x16x128_f8f6f4 %0, %1, %2, %0, %3, %4 op_sel_hi:[0,0,0]" : "+v"(acc[ai][bj][m][n]) : "v"(Bt[n]), "v"(At[m]), "v"(sclw_), "v"(scla_));   \
        else { const i32x4 bl_ = Bt[n].lo, bh_ = Bt[n].hi, al_ = At[m].lo, ah_ = At[m].hi;     \
               acc[ai][bj][m][n] = __builtin_amdgcn_mfma_f32_16x16x32_bf16(__builtin_bit_cast(bf16x8, bl_), __builtin_bit_cast(bf16x8, al_), acc[ai][bj][m][n], 0, 0, 0); \
               acc[ai][bj][m][n] = __builtin_amdgcn_mfma_f32_16x16x32_bf16(__builtin_bit_cast(bf16x8, bh_), __builtin_bit_cast(bf16x8, ah_), acc[ai][bj][m][n], 0, 0, 0); } } __builtin_amdgcn_s_setprio(0); } while (0)
#define PG8_WAIT_V(n) asm volatile("s_waitcnt vmcnt(" #n ")" ::: "memory")
#define PG8_WAIT_L(n) asm volatile("s_waitcnt lgkmcnt(" #n ")" ::: "memory")
#define PG8_BAR __builtin_amdgcn_s_barrier()
#define PG8_SCHED __builtin_amdgcn_sched_barrier(0)
    Unit cur, nxt; int ui = 0;
    if (!S.next(0, cur)) return;
    f32x4 acc[2][2][4][2];
#pragma unroll
    for (int a = 0; a < 2; ++a)
#pragma unroll
        for (int b = 0; b < 2; ++b)
#pragma unroll
            for (int m = 0; m < 4; ++m)
#pragma unroll
                for (int n = 0; n < 2; ++n) acc[a][b][m][n] = (f32x4){0.f, 0.f, 0.f, 0.f};
    i32x8 At[4], B0[2], B1[2];
    int sclw_ = Epi::SCALE_W, scla_ = Epi::SCALE_A; asm volatile("" : "+v"(sclw_), "+v"(scla_));
    PG8_STAGE_B(PG8_SB(0, 0), cur.B); PG8_STAGE_B(PG8_SB(0, 1), cur.B + hstepW); PG8_STAGE_A(PG8_SA(0, 0), cur.A, 0, cur.a00, cur.a01); PG8_STAGE_A(PG8_SA(0, 1), cur.A, 1, cur.a10, cur.a11);
    if (wr == 1) PG8_BAR;
    PG8_WAIT_V(2); PG8_BAR;
    PG8_STAGE_B(PG8_SB(1, 0), cur.B + kstep); PG8_STAGE_A(PG8_SA(1, 0), cur.A + kstep, 0, cur.a00, cur.a01); PG8_STAGE_B(PG8_SB(1, 1), cur.B + hstepW + kstep);
    PG8_WAIT_V(6); PG8_BAR;
    for (;;) {
        const bool has_next = S.next(ui + 1, nxt);
        const char* nA = has_next ? nxt.A : cur.A; const char* nB = has_next ? nxt.B : cur.B;
        if constexpr (Sched::GATHER) {
            u32x4 nv; nv.x = has_next ? nxt.a00 : cur.a00; nv.y = has_next ? nxt.a01 : cur.a01; nv.z = has_next ? nxt.a10 : cur.a10; nv.w = has_next ? nxt.a11 : cur.a11;
            *(LAS u32x4*)(lds + NXT_SLOT_OFF + tid * 16) = nv; nxt.a00 = 0u; nxt.a01 = 0u; nxt.a10 = 0u; nxt.a11 = 0u;
        }
#pragma unroll 1
        for (int t = 0; t < nt; t += 2) {
            const bool last = (t == nt - 2);
            const char* a1 = cur.A + (size_t)(t + 1) * kstep;
            const char* a2 = last ? nA : cur.A + (size_t)(t + 2) * kstep; const char* b2 = last ? nB : cur.B + (size_t)(t + 2) * kstep;
            const char* a3 = a2 + kstep; const char* b3 = b2 + kstep;
            unsigned x00 = cur.a00, x01 = cur.a01, x10 = cur.a10, x11 = cur.a11;
            if constexpr (Sched::GATHER) { if (last) { const u32x4 nv = *(const LAS u32x4*)(lds + NXT_SLOT_OFF + tid * 16); x00 = nv.x; x01 = nv.y; x10 = nv.z; x11 = nv.w; } }
            PG8_LDB(B0, 0, 0); PG8_LDB(B1, 0, 1); PG8_SCHED; PG8_LDA(At, 0, 0); PG8_STAGE_A(PG8_SA(1, 1), a1, 1, cur.a10, cur.a11);
            PG8_WAIT_V(8); PG8_WAIT_L(0); PG8_BAR; PG8_MMA(0, 0, At, B0); PG8_MMA(0, 1, At, B1); PG8_BAR; PG8_SCHED;
            PG8_LDA(At, 0, 1); PG8_STAGE_B(PG8_SB(0, 0), b2); PG8_STAGE_B(PG8_SB(0, 1), b2 + hstepW); PG8_STAGE_A(PG8_SA(0, 0), a2, 0, x00, x01);
            PG8_WAIT_V(8); PG8_WAIT_L(0); PG8_BAR; PG8_MMA(1, 0, At, B0); PG8_MMA(1, 1, At, B1); PG8_BAR; PG8_SCHED;
            PG8_LDB(B0, 1, 0); PG8_LDB(B1, 1, 1); PG8_SCHED; PG8_LDA(At, 1, 0); PG8_STAGE_A(PG8_SA(0, 1), a2, 1, x10, x11);
            PG8_WAIT_V(8); PG8_WAIT_L(0); PG8_BAR; PG8_MMA(0, 0, At, B0); PG8_MMA(0, 1, At, B1); PG8_BAR; PG8_SCHED;
            PG8_LDA(At, 1, 1); PG8_STAGE_B(PG8_SB(1, 0), b3); PG8_STAGE_B(PG8_SB(1, 1), b3 + hstepW); PG8_STAGE_A(PG8_SA(1, 0), a3, 0, x00, x01);
            PG8_WAIT_V(8); PG8_WAIT_L(0); PG8_BAR; PG8_MMA(1, 0, At, B0); PG8_MMA(1, 1, At, B1); PG8_BAR; PG8_SCHED;
        }
        if constexpr (Epi::FP8) asm volatile("s_nop 15\n\ts_nop 7" ::: "memory");
        if constexpr (ALIGN_EPI) { if (wr == 0) PG8_BAR; }
        E(acc, cur, wr, wc, fr, fq);
        if (!has_next) break;
#pragma unroll
        for (int a = 0; a < 2; ++a)
#pragma unroll
            for (int b = 0; b < 2; ++b)
#pragma unroll
                for (int m = 0; m < 4; ++m)
#pragma unroll
                    for (int n = 0; n < 2; ++n) acc[a][b][m][n] = (f32x4){0.f, 0.f, 0.f, 0.f};
        cur = nxt; ++ui;
        if constexpr (Sched::GATHER) { const u32x4 nv = *(const LAS u32x4*)(lds + NXT_SLOT_OFF + tid * 16); cur.a00 = nv.x; cur.a01 = nv.y; cur.a10 = nv.z; cur.a11 = nv.w; }
        if constexpr (ALIGN_EPI) { if (wr == 1) PG8_BAR; }
    }
    PG8_WAIT_V(0);
    if constexpr (!ALIGN_EPI) { if (wr == 0) PG8_BAR; }
    PG8_BAR;
#undef PG8_SA
#undef PG8_SB
#undef PG8_STAGE_A
#undef PG8_STAGE_B
#undef PG8_LDA
#undef PG8_LDB
#undef PG8_MMA
#undef PG8_WAIT_V
#undef PG8_WAIT_L
#undef PG8_BAR
#undef PG8_SCHED
}
}

#define XB_TMO      128
#define XB_XCNT(j)  (256  + 64 * (j))
#define XB_XSUB(j)  (1280 + 64 * (j))
#define XB_XGEN(j)  (2304 + 64 * (j))
#define XB_TOP      3328
#define XB_TOPGEN   3392
#define XCD_BAR_WORDS 3456
#define XB_SPIN_CAP (1u << 22)
__device__ __forceinline__ unsigned xb_ld(unsigned* p)              { return __hip_atomic_load(p, __ATOMIC_RELAXED, __HIP_MEMORY_SCOPE_AGENT); }
__device__ __forceinline__ unsigned xb_add(unsigned* p, unsigned v) { return __hip_atomic_fetch_add(p, v, __ATOMIC_RELAXED, __HIP_MEMORY_SCOPE_AGENT); }
__device__ __forceinline__ unsigned xb_xcc_id() { return (unsigned)__builtin_amdgcn_s_getreg((3 << 11) | 20) & 0xFu; }
#define XB_SPIN(cond, bar) do { unsigned _sp = 0; while (cond) { __builtin_amdgcn_s_sleep(1); \
    if ((++_sp & 255u) == 0u) { if (xb_ld(&(bar)[XB_TMO])) break; if (_sp > XB_SPIN_CAP) { atomicAdd(&(bar)[XB_TMO], 1u); break; } } } } while (0)
struct XcdBarrier { unsigned* bar; unsigned x; volatile LAS unsigned* st; };
__device__ __forceinline__ XcdBarrier xcd_barrier_post(unsigned* bar, volatile LAS unsigned* st) {
    XcdBarrier b; b.bar = bar; b.x = xb_xcc_id(); b.st = st;
    if (threadIdx.x == 0) (void)xb_add(&bar[XB_XCNT(b.x)], 1u);
    return b;
}
__device__ __forceinline__ void xcd_barrier_complete(unsigned* bar, unsigned x, unsigned& nloc, unsigned& nx) {
    const unsigned G = gridDim.x * gridDim.y * gridDim.z;
    unsigned sum, cnt, mine, sp = 0u;
    for (;;) {
        sum = 0u; cnt = 0u; mine = 0u;
#pragma unroll
        for (unsigned j = 0; j < 16; ++j) { const unsigned c = xb_ld(&bar[XB_XCNT(j)]); sum += c; cnt += (c > 0u) ? 1u : 0u; mine = (j == x) ? c : mine; }
        if (sum == G) break;
        __builtin_amdgcn_s_sleep(1);
        if ((++sp & 255u) == 0u) { if (xb_ld(&bar[XB_TMO])) break; if (sp > XB_SPIN_CAP) { atomicAdd(&bar[XB_TMO], 1u); break; } }
    }
    nloc = mine > 0u ? mine : 1u; nx = cnt > 0u ? cnt : 1u;
}
__device__ __forceinline__ void xcd_barrier(const XcdBarrier& b) {
    asm volatile("s_waitcnt vmcnt(0)" ::: "memory");
    __syncthreads();
    if (threadIdx.x == 0) {
        unsigned* bar = b.bar;
        __builtin_amdgcn_s_waitcnt(0);
        unsigned nloc = b.st[0], nx = b.st[1];
        if (nloc == 0u) { xcd_barrier_complete(bar, b.x, nloc, nx); b.st[0] = nloc; b.st[1] = nx; }
        const unsigned old = xb_add(&bar[XB_XSUB(b.x)], 1u);
        const unsigned gen = old / nloc;
        if (old + 1u == (gen + 1u) * nloc) {
            __builtin_amdgcn_fence(__ATOMIC_RELEASE, "agent");
            asm volatile("s_waitcnt vmcnt(0)" ::: "memory");
            const unsigned og = xb_add(&bar[XB_TOP], 1u);
            const unsigned tg = og / nx;
            if (og + 1u == (tg + 1u) * nx) xb_add(&bar[XB_TOPGEN], 1u);
            else XB_SPIN(xb_ld(&bar[XB_TOPGEN]) == tg, bar);
            __builtin_amdgcn_fence(__ATOMIC_ACQUIRE, "agent");
            xb_add(&bar[XB_XGEN(b.x)], 1u);
            asm volatile("s_waitcnt vmcnt(0)" ::: "memory");
        } else {
            XB_SPIN(xb_ld(&bar[XB_XGEN(b.x)]) == gen, bar);
            __builtin_amdgcn_fence(__ATOMIC_ACQUIRE, "agent");
            asm volatile("s_waitcnt vmcnt(0)" ::: "memory");
        }
    }
    __syncthreads();
}

struct Args {
    const float* in[19];
    float* out; unsigned char* ws;
    int ph_lo, ph_hi, use_bar, rep;
};
struct Ctx {
    const float *x, *mem, *w_in, *b_in, *w_mem_kv, *sinks, *rel_bias, *lb_logits, *hnorm, *w_out, *ln1g, *ln1b, *w_router, *rbias, *w_gate, *w_up, *w_down, *ln2g, *ln2b;
    float* xcur;
    unsigned char* ws;
    unsigned* ctl;
    bf16 *Win, *Wout, *Wmem, *W1, *W2, *xb, *proj, *ys, *mix, *hmid, *memkv, *memb;
    bf16* hpre; float* biastab; float* lbtab; int* list; u32x4* tokrec; float* hst; unsigned char* xb8;
    int vcu, G, rep;
};

__constant__ unsigned char T5_BUCKET[128] = {0, 1, 2, 3, 4, 5, 6, 7, 8, 9, 10, 11, 12, 13, 14, 15, 16, 16, 16, 17, 17, 18, 18, 18, 19, 19, 19, 20, 20, 20, 20, 21, 21, 21, 21, 22, 22, 22, 22, 22, 23, 23, 23, 23, 23, 23, 24, 24, 24, 24, 24, 24, 25, 25, 25, 25, 25, 25, 25, 26, 26, 26, 26, 26, 26, 26, 26, 27, 27, 27, 27, 27, 27, 27, 27, 27, 27, 28, 28, 28, 28, 28, 28, 28, 28, 28, 28, 29, 29, 29, 29, 29, 29, 29, 29, 29, 29, 29, 29, 30, 30, 30, 30, 30, 30, 30, 30, 30, 30, 30, 30, 30, 30, 31, 31, 31, 31, 31, 31, 31, 31, 31, 31, 31, 31, 31, 31, 31};

struct TrItem { const float* src; bf16* dst; int N, K; float fp8s; };
__device__ __forceinline__ bool p0_item(const Ctx& C, int it, TrItem& t) {
    constexpr int I_IN = DEPTH * 16 * 64, I_OUT = DEPTH * 16 * 32, I_MEM = DEPTH * 16 * 16, I_G = 64 * 16 * 16, I_D = 64 * 8 * 32;
    constexpr int NITEMS = I_IN + I_OUT + I_MEM + 2 * I_G + I_D;
    if (it >= NITEMS) return false;
    int r = it;
    if (r < I_IN) { const int l = r / 1024, q = r % 1024, kb = q / 64, nb = q % 64; t.fp8s = 32.f; t.N = INW; t.K = DM; t.src = C.w_in + (size_t)l * DM * INW + (size_t)(64 * kb) * INW + 32 * nb; t.dst = (bf16*)((unsigned char*)C.Win + (size_t)l * INW * DM + (size_t)(32 * nb) * DM + 64 * kb); return true; } r -= I_IN;
    if (r < I_OUT) { const int l = r / 512, q = r % 512, kb = q / 32, nb = q % 32; t.fp8s = 64.f; t.N = DM; t.K = MIXW; t.src = C.w_out + (size_t)l * MIXW * DM + (size_t)(64 * kb) * DM + 32 * nb; t.dst = (bf16*)((unsigned char*)C.Wout + (size_t)l * DM * MIXW + (size_t)(32 * nb) * MIXW + 64 * kb); return true; } r -= I_OUT;
    if (r < I_MEM) { const int l = r / 256, q = r % 256, kb = q / 16, nb = q % 16; t.fp8s = 32.f; t.N = 512; t.K = DM; t.src = C.w_mem_kv + (size_t)l * DM * 512 + (size_t)(64 * kb) * 512 + 32 * nb; t.dst = (bf16*)((unsigned char*)C.Wmem + (size_t)l * 512 * DM + (size_t)(32 * nb) * DM + 64 * kb); return true; } r -= I_MEM;
    if (r < 2 * I_G) { const int up = r >= I_G; if (up) r -= I_G; const int le = r / 256, q = r % 256, kb = q / 16, nb = q % 16; const int n0 = 32 * nb;
        t.N = DE; t.K = DM; t.src = (up ? C.w_up : C.w_gate) + (size_t)le * DM * DE + (size_t)(64 * kb) * DE + n0; t.fp8s = 32.f; t.dst = (bf16*)((unsigned char*)C.W1 + (size_t)le * 1024 * DM + (size_t)((n0 >> 7) * 256 + (up ? 128 : 0) + (n0 & 127)) * DM + 64 * kb); return true; } r -= 2 * I_G;
    { const int le = r / 256, q = r % 256, kb = q / 32, nb = q % 32; t.N = DM; t.K = DE; t.src = C.w_down + (size_t)le * DE * DM + (size_t)(64 * kb) * DM + 32 * nb; t.fp8s = 64.f; t.dst = (bf16*)((unsigned char*)C.W2 + (size_t)le * DM * DE + (size_t)(32 * nb) * DE + 64 * kb); }
    return true;
}
__device__ __forceinline__ void p0_prologue(const Ctx& C, LAS unsigned char* lds, int wave, int lane) {
    LAS float* scr = (LAS float*)(lds + wave * 16384);
    const int gw = C.vcu * NWAVES + wave, NGW = C.G * NWAVES;
    {
        TrItem cur, nxt; float va[32], vb[32];
        bool have = p0_item(C, gw, cur);
        if (have) {
#pragma unroll
            for (int i = 0; i < 32; ++i) va[i] = cur.src[(size_t)(2 * i + (lane >> 5)) * cur.N + (lane & 31)];
        }
        for (int it = gw; have; it += NGW) {
            const bool hn = p0_item(C, it + NGW, nxt);
            if (hn) {
#pragma unroll
                for (int i = 0; i < 32; ++i) vb[i] = nxt.src[(size_t)(2 * i + (lane >> 5)) * nxt.N + (lane & 31)];
            }
#pragma unroll
            for (int i = 0; i < 32; ++i) scr[(2 * i + (lane >> 5)) * 33 + (lane & 31)] = va[i];
            const int c = lane & 7;
#pragma unroll
            for (int j = 0; j < 4; ++j) { const int n = (lane >> 3) + 8 * j; const LAS float* s = scr + (8 * c) * 33 + n;
                if (cur.fp8s != 0.f) { const float sc = cur.fp8s;
                    int w0 = __builtin_amdgcn_cvt_pk_fp8_f32(s[0 * 33] * sc, s[1 * 33] * sc, 0, false); w0 = __builtin_amdgcn_cvt_pk_fp8_f32(s[2 * 33] * sc, s[3 * 33] * sc, w0, true);
                    int w1 = __builtin_amdgcn_cvt_pk_fp8_f32(s[4 * 33] * sc, s[5 * 33] * sc, 0, false); w1 = __builtin_amdgcn_cvt_pk_fp8_f32(s[6 * 33] * sc, s[7 * 33] * sc, w1, true);
                    u32x2 o8; o8.x = (unsigned)w0; o8.y = (unsigned)w1;
                    *(u32x2*)((unsigned char*)cur.dst + (size_t)n * cur.K + 8 * c) = o8; }
                else { u32x4 o; o.x = pk2(s[0 * 33], s[1 * 33]); o.y = pk2(s[2 * 33], s[3 * 33]); o.z = pk2(s[4 * 33], s[5 * 33]); o.w = pk2(s[6 * 33], s[7 * 33]);
                    *(u32x4*)(cur.dst + (size_t)n * cur.K + 8 * c) = o; } }
#pragma unroll
            for (int i = 0; i < 32; ++i) va[i] = vb[i];
            cur = nxt; have = hn;
        }
    }
    for (int m = gw; m < NTOK + NB * MEMLEN; m += NGW) {
        const bool ism = m >= NTOK; const int r = ism ? m - NTOK : m;
        const f32x4* src = (const f32x4*)((ism ? C.mem : C.x) + (size_t)r * DM) + lane;
        f32x4 v[4];
#pragma unroll
        for (int j = 0; j < 4; ++j) v[j] = src[64 * j];
        unsigned* q8 = (unsigned*)((ism ? (unsigned char*)C.memb : C.xb8) + (size_t)r * DM) + lane;
        unsigned* ql = (unsigned*)((unsigned char*)C.xb + (size_t)r * DM) + lane;
#pragma unroll
        for (int j = 0; j < 4; ++j) { unsigned hi, lo; split_fp8(v[j], hi, lo); q8[64 * j] = hi; if (!ism) ql[64 * j] = lo; }
    }
    if (blockIdx.x == 0) {
        const int tid = wave * 64 + lane;
        for (int i = tid; i < 8 * 128; i += NTHR) { const int h = i >> 7, d = i & 127; C.biastab[i] = C.rel_bias[(int)T5_BUCKET[d] * 8 + h]; }
        if (tid < 256) { float v0 = C.lb_logits[tid], v1 = C.lb_logits[256 + tid], v2 = C.lb_logits[512 + tid], v3 = C.lb_logits[768 + tid];
            const float mx = fmaxf(fmaxf(v0, v1), fmaxf(v2, v3)); v0 = __expf(v0 - mx); v1 = __expf(v1 - mx); v2 = __expf(v2 - mx); v3 = __expf(v3 - mx);
            const float inv = 1.f / (v0 + v1 + v2 + v3);
            C.lbtab[tid] = 0.f; C.lbtab[256 + tid] = v1 * inv; C.lbtab[512 + tid] = (v1 + v2) * inv; C.lbtab[768 + tid] = (v1 + v2 + v3) * inv; }
    }
}

struct DenseSched {
    static constexpr bool GATHER = false;
    const char* A0; const char* B0; int nM0, nN0, K0;
    const char* A1; const char* B1; int nM1, nN1;
    int G, c;
    __device__ __forceinline__ void lane_init(int, int, int, int) {}
    __device__ __forceinline__ bool next(int i, pg8::Unit& u) const {
        const int n0 = nM0 * nN0; const int L = i * G + c; if (L >= n0 + nM1 * nN1) return false;
        int pm, pn; const char* A; const char* B; int aux;
        if (L < n0) { pg8::tile_order(L, nM0, nN0, pm, pn); A = A0; B = B0; aux = 0; }
        else { pg8::tile_order(L - n0, nM1, nN1, pm, pn); A = A1; B = B1; aux = 1; }
        u.A = A + (size_t)pm * 256 * K0; u.B = B + (size_t)pn * 256 * K0;
        u.a00 = 0u; u.a01 = 0u; u.a10 = 0u; u.a11 = 0u;
        u.row0 = pm * 256; u.col0 = pn * 256; u.aux = aux; return true;
    }
};
template <bool GATHER_> struct MoeSched {
    static constexpr bool GATHER = GATHER_;
    const char* A; const char* Bl; int K; size_t bstride;
    const int* list; const LAS int* tb;
    int g0, g1, gU, mode; int R0, C0, R1, C1;
    __device__ __forceinline__ void lane_init(int r0, int c0, int r1, int c1) { R0 = r0; C0 = c0; R1 = r1; C1 = c1; }
    __device__ __forceinline__ bool next(int i, pg8::Unit& u) const {
        int g;
        if (mode == 0) { g = g0 + i * g1; if (g >= gU) return false; }
        else {
            const int c = g0, E = g1;
            if (c < E) { if (i == 0) g = 1024 + c; else if (i <= 2) g = c + (i - 1) * E; else return false; }
            else { g = 2 * E + (c - E) + i * (256 - E); if (g >= gU) return false; }
        }
        const int tile = g >> 2, pn = g & 3;
        int e = 0;
#pragma unroll
        for (int j = 1; j < 16; ++j) e += (tile >= tb[j]) ? 1 : 0;
        e = __builtin_amdgcn_readfirstlane(e);
        u.B = Bl + (size_t)e * bstride + (size_t)pn * 256 * K;
        u.A = A;
        if (GATHER) {
            const int p0 = (tile - __builtin_amdgcn_readfirstlane(tb[e])) * 256, cnt = __builtin_amdgcn_readfirstlane(tb[17 + e]); const int* le = list + (size_t)e * LCAP;
            const int cm = cnt - 1;
            const int t00 = le[min(p0 + R0, cm)], t01 = le[min(p0 + R1, cm)], t10 = le[min(p0 + 128 + R0, cm)], t11 = le[min(p0 + 128 + R1, cm)];
            u.a00 = (unsigned)t00 * K + 2 * C0; u.a01 = (unsigned)t01 * K + 2 * C1; u.a10 = (unsigned)t10 * K + 2 * C0; u.a11 = (unsigned)t11 * K + 2 * C1;
        } else {
            u.A = A + (size_t)tile * 256 * K; u.a00 = 0u; u.a01 = 0u; u.a10 = 0u; u.a11 = 0u;
        }
        u.row0 = tile * 256; u.col0 = pn * 256; u.aux = e; return true;
    }
};
struct EpiProj {
    static constexpr bool PERM = true, PERM16 = true, FP8 = true; static constexpr int SCALE_W = 0x7A7A7A7A  , SCALE_A = 0x7C7C7C7C  ;
    unsigned char* O0; const float* bias; unsigned char* O1;
    __device__ __forceinline__ void operator()(const f32x4 (&acc)[2][2][4][2], const pg8::Unit& u, int wr, int wc, int fr, int fq) const {
        unsigned char* base = u.aux ? O1 : O0; const int row0 = u.row0 + wr * 64 + fr, col0 = u.col0 + wc * 64 + 16 * fq;
        f32x4 bv[2][2];
#pragma unroll
        for (int bj = 0; bj < 2; ++bj)
#pragma unroll
            for (int n = 0; n < 2; ++n) bv[bj][n] = u.aux ? (f32x4){0.f, 0.f, 0.f, 0.f} : *(const f32x4*)(bias + col0 + 8 * bj + 4 * n);
#pragma unroll
        for (int ai = 0; ai < 2; ++ai)
#pragma unroll
            for (int m = 0; m < 4; ++m) { unsigned char* rowp = base + (size_t)(row0 + ai * 128 + m * 16) * INW + col0;
                u32x4 w; w.x = pk_fp8x4((acc[ai][0][m][0] + bv[0][0]) * 8.f); w.y = pk_fp8x4((acc[ai][0][m][1] + bv[0][1]) * 8.f); w.z = pk_fp8x4((acc[ai][1][m][0] + bv[1][0]) * 8.f); w.w = pk_fp8x4((acc[ai][1][m][1] + bv[1][1]) * 8.f);
                *(u32x4*)rowp = w; }
    }
};
struct EpiOut {
    static constexpr bool PERM = true, PERM16 = true, FP8 = true; static constexpr int SCALE_W = 0x79797979  , SCALE_A = 0x7C7C7C7C  ;
    unsigned char* H;
    __device__ __forceinline__ void operator()(const f32x4 (&acc)[2][2][4][2], const pg8::Unit& u, int wr, int wc, int fr, int fq) const {
        const int row0 = u.row0 + wr * 64 + fr, col0 = u.col0 + wc * 64 + 16 * fq;
#pragma unroll
        for (int ai = 0; ai < 2; ++ai)
#pragma unroll
            for (int m = 0; m < 4; ++m) { const size_t off = (size_t)(row0 + ai * 128 + m * 16) * DM + col0;
                u32x4 w; w.x = pk_fp8x4(acc[ai][0][m][0] * 64.f); w.y = pk_fp8x4(acc[ai][0][m][1] * 64.f); w.z = pk_fp8x4(acc[ai][1][m][0] * 64.f); w.w = pk_fp8x4(acc[ai][1][m][1] * 64.f);
                *(u32x4*)(H + off) = w; }
    }
};
struct EpiG1 {
    static constexpr bool PERM = true, PERM16 = false, FP8 = true; static constexpr int SCALE_W = 0x7A7A7A7A  , SCALE_A = 0x7C7C7C7C  ;
    unsigned char* O;
    __device__ __forceinline__ void operator()(const f32x4 (&acc)[2][2][4][2], const pg8::Unit& u, int wr, int wc, int fr, int fq) const {
        const int row0 = u.row0 + wr * 64 + fr, col0 = (u.col0 >> 1) + wc * 32 + 8 * fq;
#pragma unroll
        for (int ai = 0; ai < 2; ++ai)
#pragma unroll
            for (int m = 0; m < 4; ++m) { unsigned char* rowp = O + (size_t)(row0 + ai * 128 + m * 16) * DE + col0;
                float hv[8];
#pragma unroll
                for (int n = 0; n < 2; ++n)
#pragma unroll
                    for (int j = 0; j < 4; ++j) { const float gte = acc[ai][0][m][n][j], up = acc[ai][1][m][n][j]; hv[n * 4 + j] = gte * frcp(1.f + __expf(-gte)) * up * 8.f; }
                int w0 = __builtin_amdgcn_cvt_pk_fp8_f32(hv[0], hv[1], 0, false); w0 = __builtin_amdgcn_cvt_pk_fp8_f32(hv[2], hv[3], w0, true);
                int w1 = __builtin_amdgcn_cvt_pk_fp8_f32(hv[4], hv[5], 0, false); w1 = __builtin_amdgcn_cvt_pk_fp8_f32(hv[6], hv[7], w1, true);
                u32x2 w; w.x = (unsigned)w0; w.y = (unsigned)w1;
                *(u32x2*)rowp = w; }
    }
};
struct EpiG2 {
    static constexpr bool PERM = true, PERM16 = true, FP8 = true; static constexpr int SCALE_W = 0x79797979  , SCALE_A = 0x7C7C7C7C  ;
    unsigned char* O;
    __device__ __forceinline__ void operator()(const f32x4 (&acc)[2][2][4][2], const pg8::Unit& u, int wr, int wc, int fr, int fq) const {
        const int row0 = u.row0 + wr * 64 + fr, col0 = u.col0 + wc * 64 + 16 * fq;
#pragma unroll
        for (int ai = 0; ai < 2; ++ai)
#pragma unroll
            for (int m = 0; m < 4; ++m) { unsigned char* rowp = O + (size_t)(row0 + ai * 128 + m * 16) * DM + col0;
                u32x4 w; w.x = pk_fp8x4(acc[ai][0][m][0] * 16.f); w.y = pk_fp8x4(acc[ai][0][m][1] * 16.f); w.z = pk_fp8x4(acc[ai][1][m][0] * 16.f); w.w = pk_fp8x4(acc[ai][1][m][1] * 16.f);
                *(u32x4*)rowp = w; }
    }
};

constexpr int AT_KOFF = 0, AT_VOFF = 36864, AT_BOFF = 73728, AT_OOFF = 77824;
template <bool SWA>
__device__ __forceinline__ void attn_item(const Ctx& C, LAS unsigned char* lds, int l, int item, int tid, int wave, int lane) {
    const int tk = lane & 15, g = lane >> 4;
    int b, nb = 0, kvh = 0, hm = 0, qb = 0;
    const unsigned char *Kg, *Vg; size_t kpitch;
    if (SWA) { b = item >> 6; nb = (item >> 1) & 31; kvh = item & 1;
        Kg = (const unsigned char*)C.proj + ((size_t)b * SEQ + (size_t)(nb - 1) * 128) * INW + C_SK + kvh * 64; Vg = Kg + (C_SV - C_SK); kpitch = INW; }
    else { b = item >> 5; hm = (item >> 3) & 3; qb = item & 7;
        Kg = (const unsigned char*)C.memkv + (size_t)b * MEMLEN * 2048 + l * 512 + hm * 64; Vg = Kg + 256; kpitch = 2048; }
    __syncthreads();
#pragma unroll
    for (int i = 0; i < 4; ++i) { const int c = tid + 512 * i, key = c >> 3, part = c & 7;
        u32x2 k8 = {0u, 0u}, v8 = {0u, 0u};
        if (!SWA || nb > 0 || key >= 128) { k8 = *(const u32x2*)(Kg + (size_t)key * kpitch + part * 8); v8 = *(const u32x2*)(Vg + (size_t)key * kpitch + part * 8); }
        *(LAS u32x4*)(lds + AT_KOFF + key * 144 + part * 16) = fp8x8_to_bf16x8(k8); *(LAS u32x4*)(lds + AT_VOFF + key * 144 + part * 16) = fp8x8_to_bf16x8(v8); }
    if (SWA) ((LAS float*)(lds + AT_BOFF))[tid] = C.biastab[(kvh * 4 + (tid >> 7)) * 128 + (tid & 127)] * 1.44269504f;
    __syncthreads();
    int hq = 0; float sink = 0.f; size_t qrow_base; int qcol, ocol, i0w = 0;
    if (SWA) { hq = kvh * 4 + (wave >> 1); sink = C.sinks[l * 8 + hq]; i0w = (wave & 1) * 64; qrow_base = (size_t)b * SEQ + nb * 128 + i0w; qcol = C_SQ + hq * 64; ocol = hq * 64; }
    else { qrow_base = (size_t)b * SEQ + qb * 512 + wave * 64; qcol = C_MQ + hm * 64; ocol = 768 + hm * 64; }
    const LAS float* biasL = (const LAS float*)(lds + AT_BOFF) + (wave >> 1) * 128;
    const LAS unsigned char* kbase = lds + AT_KOFF + tk * 144 + g * 16;
    const LAS unsigned char* vbase = lds + AT_VOFF + (4 * g + (tk >> 2)) * 144 + (tk & 3) * 8;
#pragma unroll 1
    for (int rt = 0; rt < 4; ++rt) {
        const size_t qrow = qrow_base + rt * 16;
        const unsigned char* qp = (const unsigned char*)C.proj + (qrow + tk) * INW + qcol + 8 * g;
        const bf16x8 q0 = __builtin_bit_cast(bf16x8, fp8x8_to_bf16x8(*(const u32x2*)qp)), q1 = __builtin_bit_cast(bf16x8, fp8x8_to_bf16x8(*(const u32x2*)(qp + 32)));
        constexpr int NT = SWA ? 10 : 16;
        const int t0 = SWA ? ((i0w >> 4) + rt) : 0;
        f32x4 st[NT];
#pragma unroll
        for (int t = 0; t < NT; ++t) {
            const int tc = SWA ? min(t0 + t, 15) : t;
            const bf16x8 k0 = *(const LAS bf16x8*)(kbase + tc * 16 * 144), k1 = *(const LAS bf16x8*)(kbase + tc * 16 * 144 + 64);
            f32x4 a = {0.f, 0.f, 0.f, 0.f};
            a = __builtin_amdgcn_mfma_f32_16x16x32_bf16(k0, q0, a, 0, 0, 0);
            st[t] = __builtin_amdgcn_mfma_f32_16x16x32_bf16(k1, q1, a, 0, 0, 0);
        }
        constexpr float C2 = 0.125f * 1.44269504f * (1.f / 64.f);
        float mx2, sum = 0.f;
        if (SWA) {
            const float sink2 = sink * 1.44269504f;
            const int iq = i0w + rt * 16 + tk;
            const int d0 = iq + 128 - 16 * t0 - 4 * g;
            const unsigned lim = (nb > 0) ? 128u : (unsigned)min(128, iq + 1);
            const LAS float* bl = biasL + (d0 - 16 * (NT - 1) - 3);
            float m4[4] = {sink2, sink2, sink2, sink2};
#pragma unroll
            for (int t = 0; t < NT; ++t)
#pragma unroll
                for (int r = 0; r < 4; ++r) {
                    const unsigned dist = (unsigned)(d0 - 16 * t - r);
                    const float xv = (dist < lim) ? __builtin_fmaf(st[t][r], C2, bl[16 * (NT - 1 - t) + (3 - r)]) : -INFINITY;
                    st[t][r] = xv; m4[r] = fmaxf(m4[r], xv);
                }
            mx2 = fmaxf(fmaxf(m4[0], m4[1]), fmaxf(m4[2], m4[3]));
            mx2 = fmaxf(mx2, __shfl_xor(mx2, 16)); mx2 = fmaxf(mx2, __shfl_xor(mx2, 32));
            float s4[4] = {0.f, 0.f, 0.f, 0.f};
#pragma unroll
            for (int t = 0; t < NT; ++t)
#pragma unroll
                for (int r = 0; r < 4; ++r) { const float p = __builtin_amdgcn_exp2f(st[t][r] - mx2); st[t][r] = p; s4[r] += p; }
            sum = (s4[0] + s4[1]) + (s4[2] + s4[3]);
            sum += __shfl_xor(sum, 16); sum += __shfl_xor(sum, 32);
            sum += __builtin_amdgcn_exp2f(sink2 - mx2);
        } else {
            float m4[4] = {st[0][0], st[0][1], st[0][2], st[0][3]};
#pragma unroll
            for (int t = 1; t < NT; ++t)
#pragma unroll
                for (int r = 0; r < 4; ++r) m4[r] = fmaxf(m4[r], st[t][r]);
            float mr = fmaxf(fmaxf(m4[0], m4[1]), fmaxf(m4[2], m4[3]));
            mr = fmaxf(mr, __shfl_xor(mr, 16)); mr = fmaxf(mr, __shfl_xor(mr, 32));
            const float nm = -mr * C2;
            float s4[4] = {0.f, 0.f, 0.f, 0.f};
#pragma unroll
            for (int t = 0; t < NT; ++t)
#pragma unroll
                for (int r = 0; r < 4; ++r) { const float p = __builtin_amdgcn_exp2f(__builtin_fmaf(st[t][r], C2, nm)); st[t][r] = p; s4[r] += p; }
            sum = (s4[0] + s4[1]) + (s4[2] + s4[3]);
            sum += __shfl_xor(sum, 16); sum += __shfl_xor(sum, 32);
        }
        const float inv = frcp(sum);
        f32x4 o[4];
#pragma unroll
        for (int n = 0; n < 4; ++n) o[n] = (f32x4){0.f, 0.f, 0.f, 0.f};
#pragma unroll
        for (int s = 0; s < NT / 2; ++s) {
            const f32x4 pa = st[2 * s] * inv, pb = st[2 * s + 1] * inv;
            const bf16x8 pfrag = mk8(pk2(pa[0], pa[1]), pk2(pa[2], pa[3]), pk2(pb[0], pb[1]), pk2(pb[2], pb[3]));
            const int ta = SWA ? min(t0 + 2 * s, 15) : 2 * s, tb2 = SWA ? min(t0 + 2 * s + 1, 15) : 2 * s + 1;
#pragma unroll
            for (int n = 0; n < 4; ++n) {
                const s16x4 lo = ld_tr(vbase + (16 * ta) * 144 + n * 32), hi = ld_tr(vbase + (16 * tb2) * 144 + n * 32);
                const bf16x8 vf = {lo[0], lo[1], lo[2], lo[3], hi[0], hi[1], hi[2], hi[3]};
                o[n] = __builtin_amdgcn_mfma_f32_16x16x32_bf16(pfrag, vf, o[n], 0, 0, 0);
            }
        }
        LAS unsigned char* ost = lds + AT_OOFF + wave * 2304;
#pragma unroll
        for (int r = 0; r < 4; ++r)
#pragma unroll
            for (int n = 0; n < 4; n += 2) { const unsigned w = (unsigned)__builtin_amdgcn_cvt_pk_fp8_f32(o[n][r], o[n + 1][r], 0, false);
                *(LAS unsigned char*)(ost + (4 * g + r) * 80 + 16 * n + tk) = (unsigned char)(w & 0xffu); *(LAS unsigned char*)(ost + (4 * g + r) * 80 + 16 * (n + 1) + tk) = (unsigned char)((w >> 8) & 0xffu); }
        { const int orow = lane >> 2, part = lane & 3;
            const u32x4 w = *(const LAS u32x4*)(ost + orow * 80 + part * 16);
            *(u32x4*)((unsigned char*)C.mix + (size_t)(qrow + orow) * MIXW + ocol + part * 16) = w; }
    }
}

template <bool PB>
__device__ __forceinline__ void hgrn_item(const Ctx& C, LAS unsigned char* lds, int wv, int l, int witem, int lane) {
    LAS unsigned char* scr = lds + wv * 4608;
    const int tk = lane & 15, g = lane >> 4;
    const int bh = witem / NSEG, seg = witem % NSEG, b = bh >> 2, h = bh & 3;
    float oml[4][4];
#pragma unroll
    for (int c = 0; c < 4; ++c)
#pragma unroll
        for (int i = 0; i < 4; ++i) oml[c][i] = 1.f - C.lbtab[l * 256 + h * 64 + 16 * c + 4 * g + i];
    f32x4 S[4][4];
#pragma unroll
    for (int mt = 0; mt < 4; ++mt)
#pragma unroll
        for (int n = 0; n < 4; ++n) S[mt][n] = (f32x4){0.f, 0.f, 0.f, 0.f};
    float dseg[4][4];
#pragma unroll
    for (int c = 0; c < 4; ++c)
#pragma unroll
        for (int i = 0; i < 4; ++i) dseg[c][i] = 1.f;
    if (PB) {
        if (lane == 0 && wv == 0) {
            unsigned* cnt = C.ctl + CW_HA + (l * 32 + bh) * 64; unsigned sp = 0;
            while (__hip_atomic_load(cnt, __ATOMIC_RELAXED, __HIP_MEMORY_SCOPE_AGENT) < (unsigned)(NSEG / NWAVES)) { __builtin_amdgcn_s_sleep(2); if (++sp > (1u << 24)) break; }
            __builtin_amdgcn_fence(__ATOMIC_ACQUIRE, "agent");
            asm volatile("s_waitcnt vmcnt(0)" ::: "memory");
        }
    }
    if (PB) {
        LAS float* pl = (LAS float*)lds;
        const int seg0 = seg - wv;
        __syncthreads();
#pragma unroll 1
        for (int qq = 0; qq < 8; ++qq) {
            const int q = wv * 8 + qq, dq = 64 + (q >> 4) * 4 + (q & 3);
            const float* base = C.hst + (size_t)bh * NSEG * 80 * 64 + lane;
            float Sx = 0.f;
            for (int j0 = 0; j0 < seg0; j0 += 8) {
                float dv[8], sv[8];
#pragma unroll
                for (int j = 0; j < 8; ++j) { dv[j] = base[((size_t)(j0 + j) * 80 + dq) * 64]; sv[j] = base[((size_t)(j0 + j) * 80 + q) * 64]; }
#pragma unroll
                for (int j = 0; j < 8; ++j) Sx = Sx * dv[j] + sv[j];
            }
            float dv[8], sv[8];
#pragma unroll
            for (int j = 0; j < 8; ++j) { dv[j] = base[((size_t)(seg0 + j) * 80 + dq) * 64]; sv[j] = base[((size_t)(seg0 + j) * 80 + q) * 64]; }
#pragma unroll
            for (int j = 0; j < 8; ++j) { pl[(j * 64 + q) * 64 + lane] = Sx; Sx = Sx * dv[j] + sv[j]; }
        }
        __syncthreads();
#pragma unroll
        for (int mt = 0; mt < 4; ++mt)
#pragma unroll
            for (int n = 0; n < 4; ++n)
#pragma unroll
                for (int r = 0; r < 4; ++r) S[mt][n][r] = pl[(wv * 64 + (mt * 4 + n) * 4 + r) * 64 + lane];
        __syncthreads();
    }
    float nw[4][4];
    if (PB) {
#pragma unroll
        for (int c = 0; c < 4; ++c)
#pragma unroll
            for (int i = 0; i < 4; ++i) nw[c][i] = C.hnorm[l * 64 + 16 * c + 4 * g + i];
    }
    const size_t rowbase = (size_t)b * SEQ + (size_t)seg * CPS * 16;
    LAS unsigned char* sk = scr; LAS unsigned char* sv = scr + 2304;
    const LAS unsigned char* trk = sk + (4 * g + (tk >> 2)) * 144 + (tk & 3) * 8;
    const LAS unsigned char* trv = sv + (4 * g + (tk >> 2)) * 144 + (tk & 3) * 8;
    unsigned nzf[4], nvi[4];
    { const unsigned char* pr = (const unsigned char*)C.proj + (rowbase + tk) * INW + h * 64 + 4 * g;
#pragma unroll
        for (int c = 0; c < 4; ++c) { nzf[c] = *(const unsigned*)(pr + C_HF + 16 * c); nvi[c] = *(const unsigned*)(pr + C_HI + 16 * c); } }
#pragma unroll 1
    for (int ch = 0; ch < CPS; ++ch) {
        const size_t row = rowbase + ch * 16 + tk;
        unsigned zf_[4], vi_[4], zq_[4], gt_[4];
#pragma unroll
        for (int c = 0; c < 4; ++c) { zf_[c] = nzf[c]; vi_[c] = nvi[c]; }
        if (PB) { const unsigned char* pr = (const unsigned char*)C.proj + row * INW + h * 64 + 4 * g;
#pragma unroll
            for (int c = 0; c < 4; ++c) { zq_[c] = *(const unsigned*)(pr + C_HQ + 16 * c); gt_[c] = *(const unsigned*)(pr + C_HG + 16 * c); } }
        { const unsigned char* pr = (const unsigned char*)C.proj + (rowbase + (ch < CPS - 1 ? ch + 1 : ch) * 16 + tk) * INW + h * 64 + 4 * g;
#pragma unroll
            for (int c = 0; c < 4; ++c) { nzf[c] = *(const unsigned*)(pr + C_HF + 16 * c); nvi[c] = *(const unsigned*)(pr + C_HI + 16 * c); } }
        float kk[4][4], bcs[4][4], dreg[4][4];
#pragma unroll
        for (int c = 0; c < 4; ++c) { const f32x4 zf4 = dec_fp8x4(zf_[c]) * 0.125f;
#pragma unroll
            for (int i = 0; i < 4; ++i) {
                const float z = zf4[i];
                const float sneg = frcp(1.f + __expf(z));
                const float kv = oml[c][i] * sneg;
                kk[c][i] = kv;
                bcs[c][i] = row_scan16(__logf(1.f - kv));
            } }
#pragma unroll
        for (int c = 0; c < 4; ++c)
#pragma unroll
            for (int i = 0; i < 4; ++i) { const float bl = __shfl(bcs[c][i], (lane & 48) | 15); dreg[c][i] = __expf(bl); }
        unsigned kop_[4][2];
#pragma unroll
        for (int c = 0; c < 4; ++c) {
            const float e0 = kk[c][0] * __expf(-bcs[c][0]), e1 = kk[c][1] * __expf(-bcs[c][1]), e2 = kk[c][2] * __expf(-bcs[c][2]), e3 = kk[c][3] * __expf(-bcs[c][3]);
            kop_[c][0] = pk2(e0, e1); kop_[c][1] = pk2(e2, e3);
            u32x2 w; w.x = kop_[c][0]; w.y = kop_[c][1];
            *(LAS u32x2*)(sk + tk * 144 + (16 * c + 4 * g) * 2) = w;
            { const f32x4 vv = dec_fp8x4(vi_[c]) * 0.125f; u32x2 wv; wv.x = pk2(vv.x, vv.y); wv.y = pk2(vv.z, vv.w); *(LAS u32x2*)(sv + tk * 144 + (16 * c + 4 * g) * 2) = wv; }
        }
        s16x4 kT[4], vT[4];
#pragma unroll
        for (int m = 0; m < 4; ++m) { kT[m] = ld_tr(trk + m * 32); vT[m] = ld_tr(trv + m * 32); }
        f32x4 o[4];
        if (PB) {
            unsigned qop_[4][2];
#pragma unroll
            for (int c = 0; c < 4; ++c) {
                float qv[4]; const f32x4 zq4 = dec_fp8x4(zq_[c]) * 0.125f;
#pragma unroll
                for (int i = 0; i < 4; ++i) { const float z = zq4[i];
                    qv[i] = z * frcp(1.f + __expf(-z)) * 0.125f * __expf(bcs[c][i]); }
                qop_[c][0] = pk2(qv[0], qv[1]); qop_[c][1] = pk2(qv[2], qv[3]);
            }
            const bf16x8 qa = mk8(qop_[0][0], qop_[0][1], qop_[1][0], qop_[1][1]), qb2 = mk8(qop_[2][0], qop_[2][1], qop_[3][0], qop_[3][1]);
            const bf16x8 ka = mk8(kop_[0][0], kop_[0][1], kop_[1][0], kop_[1][1]), kb2 = mk8(kop_[2][0], kop_[2][1], kop_[3][0], kop_[3][1]);
            f32x4 sT = {0.f, 0.f, 0.f, 0.f};
            sT = __builtin_amdgcn_mfma_f32_16x16x32_bf16(ka, qa, sT, 0, 0, 0);
            sT = __builtin_amdgcn_mfma_f32_16x16x32_bf16(kb2, qb2, sT, 0, 0, 0);
#pragma unroll
            for (int r = 0; r < 4; ++r) if (4 * g + r > tk) sT[r] = 0.f;
            const s16x4 sT4 = mk4(pk2(sT[0], sT[1]), pk2(sT[2], sT[3]));
#pragma unroll
            for (int n = 0; n < 4; ++n) {
                f32x4 a = {0.f, 0.f, 0.f, 0.f};
                a = __builtin_amdgcn_mfma_f32_16x16x16bf16_1k(vT[n], sT4, a, 0, 0, 0);
                const bf16x8 s0 = mk8(pk2(S[0][n][0], S[0][n][1]), pk2(S[0][n][2], S[0][n][3]), pk2(S[1][n][0], S[1][n][1]), pk2(S[1][n][2], S[1][n][3]));
                const bf16x8 s1 = mk8(pk2(S[2][n][0], S[2][n][1]), pk2(S[2][n][2], S[2][n][3]), pk2(S[3][n][0], S[3][n][1]), pk2(S[3][n][2], S[3][n][3]));
                f32x4 a2 = {0.f, 0.f, 0.f, 0.f};
                a2 = __builtin_amdgcn_mfma_f32_16x16x32_bf16(s0, qa, a2, 0, 0, 0);
                a2 = __builtin_amdgcn_mfma_f32_16x16x32_bf16(s1, qb2, a2, 0, 0, 0);
                o[n] = a + a2;
            }
        }
#pragma unroll
        for (int mt = 0; mt < 4; ++mt)
#pragma unroll
            for (int n = 0; n < 4; ++n) {
                f32x4 a = __builtin_amdgcn_mfma_f32_16x16x16bf16_1k(kT[mt], vT[n], S[mt][n], 0, 0, 0);
#pragma unroll
                for (int r = 0; r < 4; ++r) a[r] *= dreg[mt][r];
                S[mt][n] = a;
            }
        if (PB) {
            float ss = 0.f;
#pragma unroll
            for (int n = 0; n < 4; ++n)
#pragma unroll
                for (int r = 0; r < 4; ++r) ss += o[n][r] * o[n][r];
            ss += __shfl_xor(ss, 16); ss += __shfl_xor(ss, 32);
            const float rinv = __builtin_amdgcn_rsqf(ss * (1.f / 64.f) + RMS_EPS);
            unsigned char* op = (unsigned char*)C.mix + row * MIXW + 512 + h * 64 + 4 * g;
#pragma unroll
            for (int n = 0; n < 4; ++n) {
                float ov[4]; const f32x4 gz4 = dec_fp8x4(gt_[n]) * 0.125f;
#pragma unroll
                for (int r = 0; r < 4; ++r) { const float z = gz4[r];
                    ov[r] = __builtin_amdgcn_fmed3f(o[n][r] * rinv * nw[n][r] * (z * frcp(1.f + __expf(-z))) * 8.f, -448.f, 448.f); }
                *(unsigned*)(op + 16 * n) = pk_fp8x4((f32x4){ov[0], ov[1], ov[2], ov[3]});
            }
        } else {
#pragma unroll
            for (int c = 0; c < 4; ++c)
#pragma unroll
                for (int i = 0; i < 4; ++i) dseg[c][i] *= dreg[c][i];
        }
    }
    if (!PB) {
        float* sl = C.hst + ((size_t)witem * 80) * 64 + lane;
#pragma unroll
        for (int mt = 0; mt < 4; ++mt)
#pragma unroll
            for (int n = 0; n < 4; ++n)
#pragma unroll
                for (int r = 0; r < 4; ++r) sl[((mt * 4 + n) * 4 + r) * 64] = S[mt][n][r];
#pragma unroll
        for (int c = 0; c < 4; ++c)
#pragma unroll
            for (int i = 0; i < 4; ++i) sl[(64 + c * 4 + i) * 64] = dseg[c][i];
        asm volatile("s_waitcnt vmcnt(0)" ::: "memory");
        __syncthreads();
        if (lane == 0 && wv == 0) {
            __builtin_amdgcn_fence(__ATOMIC_RELEASE, "agent");
            asm volatile("s_waitcnt vmcnt(0)" ::: "memory");
            __hip_atomic_fetch_add(C.ctl + CW_HA + (l * 32 + bh) * 64, 1u, __ATOMIC_RELAXED, __HIP_MEMORY_SCOPE_AGENT);
        }
    }
}

__device__ __forceinline__ void mixer_phase(const Ctx& C, LAS unsigned char* lds, int l, int tid, int wave, int lane) {
    constexpr int NH = 32 * NSEG / NWAVES;
    constexpr int N_MEM = NB * 4 * 8, N_SWA = NB * 32 * 2;
    unsigned* head = C.ctl + CW_QUEUE + l * 64;
    volatile LAS int* slot = (volatile LAS int*)(lds + LDSCTL_OFF + 256);
    for (;;) {
        __syncthreads();
        if (tid == 0) slot[0] = (int)__hip_atomic_fetch_add(head, 1u, __ATOMIC_RELAXED, __HIP_MEMORY_SCOPE_AGENT);
        __syncthreads();
        int it = __builtin_amdgcn_readfirstlane(slot[0]);
        if (it >= 2 * NH + N_MEM + N_SWA) break;
        int lane_i = lane; asm volatile("" : "+v"(lane_i));
        if (it < NH) { hgrn_item<false>(C, lds, wave, l, it * NWAVES + wave, lane_i); continue; } it -= NH;
        if (it < N_SWA / 2) { attn_item<true>(C, lds, l, it, wave * 64 + lane_i, wave, lane_i); continue; } it -= N_SWA / 2;
        if (it < NH) { hgrn_item<true>(C, lds, wave, l, it * NWAVES + wave, lane_i); continue; } it -= NH;
        if (it < N_SWA / 2) { attn_item<true>(C, lds, l, it + N_SWA / 2, wave * 64 + lane_i, wave, lane_i); continue; } it -= N_SWA / 2;
        attn_item<false>(C, lds, l, it, wave * 64 + lane_i, wave, lane_i);
    }
}

__device__ __forceinline__ float reduce_scatter16(const float (&p)[16], int lane) {
    const bool h5 = (lane & 32) != 0, h4 = (lane & 16) != 0, h3 = (lane & 8) != 0, h2 = (lane & 4) != 0;
    float q8[8], q4[4], q2[2];
#pragma unroll
    for (int i = 0; i < 8; ++i) { const float snd = h5 ? p[i] : p[i + 8], kp = h5 ? p[i + 8] : p[i]; q8[i] = kp + __shfl_xor(snd, 32); }
#pragma unroll
    for (int i = 0; i < 4; ++i) { const float snd = h4 ? q8[i] : q8[i + 4], kp = h4 ? q8[i + 4] : q8[i]; q4[i] = kp + __shfl_xor(snd, 16); }
#pragma unroll
    for (int i = 0; i < 2; ++i) { const float snd = h3 ? q4[i] : q4[i + 2], kp = h3 ? q4[i + 2] : q4[i]; q2[i] = kp + DPPF(snd, 0x128); }
    float q1; { const float snd = h2 ? q2[0] : q2[1], kp = h2 ? q2[1] : q2[0]; q1 = kp + __shfl_xor(snd, 4); }
    q1 += DPPF(q1, 0x4E); q1 += DPPF(q1, 0xB1);
    return q1;
}
__device__ __forceinline__ float reduce_scatter4(const float (&p)[4], int lane) {
    const bool h5 = (lane & 32) != 0, h4 = (lane & 16) != 0;
    float q2[2];
#pragma unroll
    for (int i = 0; i < 2; ++i) { const float snd = h5 ? p[i] : p[i + 2], kp = h5 ? p[i + 2] : p[i]; q2[i] = kp + __shfl_xor(snd, 32); }
    float q1; { const float snd = h4 ? q2[0] : q2[1], kp = h4 ? q2[1] : q2[0]; q1 = kp + __shfl_xor(snd, 16); }
    q1 += DPPF(q1, 0xB1); q1 += DPPF(q1, 0x4E); q1 += DPPF(q1, 0x141); q1 += DPPF(q1, 0x140);
    return q1;
}
__device__ __forceinline__ float reduce_scatter8(const float (&p)[8], int lane) {
    const bool h5 = (lane & 32) != 0, h4 = (lane & 16) != 0, h3 = (lane & 8) != 0;
    float q4[4], q2[2];
#pragma unroll
    for (int i = 0; i < 4; ++i) { const float snd = h5 ? p[i] : p[i + 4], kp = h5 ? p[i + 4] : p[i]; q4[i] = kp + __shfl_xor(snd, 32); }
#pragma unroll
    for (int i = 0; i < 2; ++i) { const float snd = h4 ? q4[i] : q4[i + 2], kp = h4 ? q4[i + 2] : q4[i]; q2[i] = kp + __shfl_xor(snd, 16); }
    float q1; { const float snd = h3 ? q2[0] : q2[1], kp = h3 ? q2[1] : q2[0]; q1 = kp + DPPF(snd, 0x128); }
    q1 += DPPF(q1, 0xB1); q1 += DPPF(q1, 0x4E); q1 += DPPF(q1, 0x141);
    return q1;
}
__device__ __forceinline__ void route_rows16(const LAS float* lg, const float (&rb)[16], LAS unsigned* dec16, int lane) {
    const int r = lane & 15;
    float sel[16], sc[16];
#pragma unroll
    for (int q = 0; q < 4; ++q) { const f32x4 v = *(const LAS f32x4*)(lg + r * 16 + 4 * q);
        sc[4 * q] = frcp(1.f + __expf(-v.x)); sc[4 * q + 1] = frcp(1.f + __expf(-v.y)); sc[4 * q + 2] = frcp(1.f + __expf(-v.z)); sc[4 * q + 3] = frcp(1.f + __expf(-v.w)); }
#pragma unroll
    for (int e = 0; e < 16; ++e) sel[e] = sc[e] + rb[e];
    float bestv = -INFINITY, w1 = 0.f, w2 = 0.f; int e1 = 0, e2 = 1;
#pragma unroll
    for (int gi = 0; gi < 4; ++gi) {
        float m1 = sel[4 * gi], s1 = sc[4 * gi]; int i1 = 0;
#pragma unroll
        for (int i = 1; i < 4; ++i) if (sel[4 * gi + i] > m1) { m1 = sel[4 * gi + i]; s1 = sc[4 * gi + i]; i1 = i; }
        float m2 = -INFINITY, s2v = 0.f; int i2 = 0;
#pragma unroll
        for (int i = 0; i < 4; ++i) if (i != i1 && sel[4 * gi + i] > m2) { m2 = sel[4 * gi + i]; s2v = sc[4 * gi + i]; i2 = i; }
        const float gs = m1 + m2;
        if (gs > bestv) { bestv = gs; e1 = 4 * gi + i1; e2 = 4 * gi + i2; w1 = s1; w2 = s2v; }
    }
    const float wn = 1.f / (w1 + w2);
    if (lane < 16) { u32x4 d; d.x = (unsigned)e1; d.y = (unsigned)e2; d.z = __float_as_uint(w1 * wn); d.w = __float_as_uint(w2 * wn); *(LAS u32x4*)(dec16 + r * 4) = d; }
}
__device__ __forceinline__ void ln_row(const unsigned (&h)[4], const u32x2 (&x)[4], const f32x4 (&gv)[4], const f32x4 (&bv)[4], f32x4 (&v)[4]) {
    float s = 0.f;
#pragma unroll
    for (int j = 0; j < 4; ++j) { v[j] = join_fp8(x[j].x, x[j].y) * ALPHA + dec_fp8x4(h[j]) * 0.015625f;
        s += (v[j].x + v[j].y) + (v[j].z + v[j].w); }
    const float mean = wave_sum(s) * (1.f / DM); float s2 = 0.f;
#pragma unroll
    for (int j = 0; j < 4; ++j) { v[j] = v[j] - mean; s2 += (v[j].x * v[j].x + v[j].y * v[j].y) + (v[j].z * v[j].z + v[j].w * v[j].w); }
    const float rstd = __builtin_amdgcn_rsqf(wave_sum(s2) * (1.f / DM) + LN_EPS);
#pragma unroll
    for (int j = 0; j < 4; ++j) v[j] = v[j] * rstd * gv[j] + bv[j];
}
__device__ __forceinline__ void p4_ln_route(const Ctx& C, LAS unsigned char* lds, int l, int tid, int wave, int lane) {
    LAS float* wr = (LAS float*)lds;
    constexpr int WRP = DM + 4;
    LAS unsigned* dec = (LAS unsigned*)(lds + 66048);
    LAS unsigned* posb = (LAS unsigned*)(lds + 66048 + 2048);
    LAS float* lgw = (LAS float*)(lds + 66048 + 4096) + wave * 256;
    for (int i = tid; i < DM * NE; i += NTHR) { const int d = i >> 4, e = i & 15; wr[e * WRP + d] = C.w_router[i]; }
    f32x4 gv[4], bv[4];
#pragma unroll
    for (int j = 0; j < 4; ++j) { gv[j] = *((const f32x4*)(C.ln1g + l * DM) + lane + 64 * j); bv[j] = *((const f32x4*)(C.ln1b + l * DM) + lane + 64 * j); }
    unsigned* cntl = C.ctl + CW_CNT + (l + C.rep * DEPTH) * 16 * 64;
    __syncthreads();
    for (int blk = C.vcu; blk < NTOK / 128; blk += C.G) {
        const size_t rowb = (size_t)blk * 128 + wave * 16;
        const unsigned char* hp8 = (const unsigned char*)C.hpre; unsigned char* xlo = (unsigned char*)C.xb;
#define P4_LOAD4(H, X, R0) do { _Pragma("unroll") for (int r_ = 0; r_ < 4; ++r_) { const size_t rr_ = (R0) + r_; _Pragma("unroll") for (int j = 0; j < 4; ++j) { \
            H[r_][j] = ((const unsigned*)(hp8 + rr_ * DM) + lane)[64 * j]; X[r_][j].x = ((const unsigned*)(C.xb8 + rr_ * DM) + lane)[64 * j]; X[r_][j].y = ((const unsigned*)(xlo + rr_ * DM) + lane)[64 * j]; } } } while (0)
        unsigned hA[4][4]; u32x2 xA[4][4];
        P4_LOAD4(hA, xA, rowb);
#pragma unroll 1
        for (int st = 0; st < 4; ++st) {
            const size_t row = rowb + 4 * st;
            unsigned hN[4][4]; u32x2 xN[4][4];
            if (st < 3) P4_LOAD4(hN, xN, row + 4);
            f32x4 v[4][4];
#pragma unroll
            for (int r = 0; r < 4; ++r) {
                ln_row(hA[r], xA[r], gv, bv, v[r]);
                unsigned* xl = (unsigned*)(xlo + (row + r) * DM) + lane; unsigned* x8 = (unsigned*)(C.xb8 + (row + r) * DM) + lane;
#pragma unroll
                for (int j = 0; j < 4; ++j) { unsigned hi, lo; split_fp8(v[r][j], hi, lo); x8[64 * j] = hi; xl[64 * j] = lo; }
            }
#pragma unroll
            for (int eh = 0; eh < 4; ++eh) {
                float p[4][4];
#pragma unroll
                for (int e8 = 0; e8 < 4; ++e8) {
                    f32x4 w[4];
#pragma unroll
                    for (int j = 0; j < 4; ++j) w[j] = *((const LAS f32x4*)(wr + (4 * eh + e8) * WRP) + lane + 64 * j);
#pragma unroll
                    for (int r = 0; r < 4; ++r) { f32x2 a = {0.f, 0.f};
#pragma unroll
                        for (int j = 0; j < 4; ++j) { a = __builtin_elementwise_fma((f32x2){v[r][j].x, v[r][j].y}, (f32x2){w[j].x, w[j].y}, a); a = __builtin_elementwise_fma((f32x2){v[r][j].z, v[r][j].w}, (f32x2){w[j].z, w[j].w}, a); }
                        p[r][e8] = a.x + a.y; }
                }
#pragma unroll
                for (int r = 0; r < 4; ++r) { const float q = reduce_scatter4(p[r], lane);
                    if ((lane & 15) == 0) lgw[(4 * st + r) * 16 + 4 * eh + (lane >> 4)] = q; }
                __builtin_amdgcn_sched_barrier(0);
            }
#pragma unroll
            for (int r = 0; r < 4; ++r)
#pragma unroll
                for (int j = 0; j < 4; ++j) { hA[r][j] = hN[r][j]; xA[r][j] = xN[r][j]; }
        }
#undef P4_LOAD4
        float rb[16];
#pragma unroll
        for (int e = 0; e < 16; ++e) rb[e] = C.rbias[e];
        route_rows16(lgw, rb, dec + wave * 16 * 4, lane);
        __syncthreads();
        if (wave == 0) {
            unsigned ea[4], rk[4]; unsigned tot = 0;
#pragma unroll
            for (int i = 0; i < 4; ++i) { const int a = lane + 64 * i; ea[i] = dec[(a >> 1) * 4 + (a & 1)]; rk[i] = 0; }
#pragma unroll
            for (int e = 0; e < 16; ++e) {
                unsigned run = 0;
#pragma unroll
                for (int i = 0; i < 4; ++i) { const unsigned long long m = __ballot(ea[i] == (unsigned)e);
                    const unsigned below = __builtin_amdgcn_mbcnt_hi((unsigned)(m >> 32), __builtin_amdgcn_mbcnt_lo((unsigned)m, 0u));
                    if (ea[i] == (unsigned)e) rk[i] = run + below;
                    run += (unsigned)__popcll(m); }
                if (lane == e) tot = run;
            }
            unsigned base = 0;
            if (lane < 16) base = tot ? atomicAdd(cntl + 64 * lane, tot) : 0u;
#pragma unroll
            for (int i = 0; i < 4; ++i) { const unsigned bs = __shfl(base, (int)ea[i]); const unsigned pos = bs + rk[i]; const int a = lane + 64 * i;
                posb[a] = pos; C.list[(size_t)ea[i] * LCAP + pos] = blk * 128 + (a >> 1); }
        }
        __syncthreads();
        if (tid < 128) { u32x4 rec; rec.x = (dec[tid * 4] << 16) | posb[tid * 2]; rec.y = (dec[tid * 4 + 1] << 16) | posb[tid * 2 + 1]; rec.z = dec[tid * 4 + 2]; rec.w = dec[tid * 4 + 3];
            C.tokrec[(size_t)blk * 128 + tid] = rec; }
        __syncthreads();
    }
}

__device__ __forceinline__ void moe_prefix(const Ctx& C, LAS int* tb, int l, int tid) {
    if (tid == 0) {
        unsigned* cntl = C.ctl + CW_CNT + l * 16 * 64; int acc = 0;
        for (int e = 0; e < 16; ++e) { const int c = (int)__hip_atomic_load(cntl + 64 * e, __ATOMIC_RELAXED, __HIP_MEMORY_SCOPE_AGENT); tb[e] = acc; tb[17 + e] = c; acc += (c + 255) >> 8; }
        tb[16] = acc;
    }
    __syncthreads();
}

__device__ __forceinline__ void p7_combine(const Ctx& C, LAS unsigned char* lds, int l, int tid, int wave, int lane) {
    LAS int* tb = (LAS int*)lds;
    moe_prefix(C, tb, l, tid);
    f32x4 gv[4], bv[4];
#pragma unroll
    for (int j = 0; j < 4; ++j) { gv[j] = *((const f32x4*)(C.ln2g + l * DM) + lane + 64 * j); bv[j] = *((const f32x4*)(C.ln2b + l * DM) + lane + 64 * j); }
    const bool lastl = (l == DEPTH - 1);
    for (int r0 = (C.vcu * NWAVES + wave) * 16; r0 < NTOK; r0 += C.G * NWAVES * 16) {
        u32x4 rec = C.tokrec[r0 + (lane & 15)];
        const unsigned sa_l = (unsigned)tb[rec.x >> 16] * 256u + (rec.x & 0xffffu), sb_l = (unsigned)tb[rec.y >> 16] * 256u + (rec.y & 0xffffu);
#pragma unroll 1
        for (int bq = 0; bq < 2; ++bq) {
            u32x2 xv[8][4]; unsigned av[8][4], bw[8][4]; float wa[8], wb[8];
#pragma unroll
            for (int k = 0; k < 8; ++k) { const int idx = bq * 8 + k;
                const size_t sa = (size_t)__builtin_amdgcn_readlane(sa_l, idx), sb = (size_t)__builtin_amdgcn_readlane(sb_l, idx);
                wa[k] = __uint_as_float(__builtin_amdgcn_readlane(rec.z, idx)) * 0.0625f; wb[k] = __uint_as_float(__builtin_amdgcn_readlane(rec.w, idx)) * 0.0625f;
                const unsigned* xph = (const unsigned*)(C.xb8 + (size_t)(r0 + idx) * DM) + lane; const unsigned* xpl = (const unsigned*)((const unsigned char*)C.xb + (size_t)(r0 + idx) * DM) + lane; const unsigned* ya = (const unsigned*)((const unsigned char*)C.ys + sa * DM) + lane; const unsigned* yb = (const unsigned*)((const unsigned char*)C.ys + sb * DM) + lane;
#pragma unroll
                for (int j = 0; j < 4; ++j) { xv[k][j].x = xph[64 * j]; xv[k][j].y = xpl[64 * j]; av[k][j] = ya[64 * j]; bw[k][j] = yb[64 * j]; } }
#pragma unroll
            for (int k = 0; k < 8; ++k) { const int row = r0 + bq * 8 + k;
                f32x4 v[4]; float s = 0.f;
#pragma unroll
                for (int j = 0; j < 4; ++j) { const u32x2 x2 = xv[k][j];
                    const f32x2 al = __builtin_amdgcn_cvt_pk_f32_fp8((int)av[k][j], false), ah = __builtin_amdgcn_cvt_pk_f32_fp8((int)av[k][j], true);
                    const f32x2 bl = __builtin_amdgcn_cvt_pk_f32_fp8((int)bw[k][j], false), bh = __builtin_amdgcn_cvt_pk_f32_fp8((int)bw[k][j], true);
                    const f32x4 xr = join_fp8(x2.x, x2.y) * ALPHA;
                    v[j].x = xr.x + (al.x * wa[k] + bl.x * wb[k]); v[j].y = xr.y + (al.y * wa[k] + bl.y * wb[k]);
                    v[j].z = xr.z + (ah.x * wa[k] + bh.x * wb[k]); v[j].w = xr.w + (ah.y * wa[k] + bh.y * wb[k]);
                    s += (v[j].x + v[j].y) + (v[j].z + v[j].w); }
                const float mean = wave_sum(s) * (1.f / DM); float s2 = 0.f;
#pragma unroll
                for (int j = 0; j < 4; ++j) { v[j] = v[j] - mean; s2 += (v[j].x * v[j].x + v[j].y * v[j].y) + (v[j].z * v[j].z + v[j].w * v[j].w); }
                const float rstd = __builtin_amdgcn_rsqf(wave_sum(s2) * (1.f / DM) + LN_EPS);
                if (lastl) { f32x4* xo = (f32x4*)(C.xcur + (size_t)row * DM) + lane;
#pragma unroll
                    for (int j = 0; j < 4; ++j) xo[64 * j] = v[j] * rstd * gv[j] + bv[j]; }
                else { unsigned* xlo = (unsigned*)((unsigned char*)C.xb + (size_t)row * DM) + lane; unsigned* x8o = (unsigned*)(C.xb8 + (size_t)row * DM) + lane;
#pragma unroll
                    for (int j = 0; j < 4; ++j) { const f32x4 y = v[j] * rstd * gv[j] + bv[j]; unsigned hi, lo; split_fp8(y, hi, lo); x8o[64 * j] = hi; xlo[64 * j] = lo; } }
            }
        }
    }
}

template <class T> __device__ __forceinline__ T* as_g(T* p) { return (T*)(GAS T*)p; }
typedef const __attribute__((address_space(4))) Args* KArgs;
__device__ __forceinline__ Ctx make_ctx(KArgs ap) {
    asm volatile("" : "+s"(ap));
    Ctx C;
    C.x = as_g(ap->in[0]); C.mem = as_g(ap->in[1]); C.w_in = as_g(ap->in[2]); C.b_in = as_g(ap->in[3]); C.w_mem_kv = as_g(ap->in[4]); C.sinks = as_g(ap->in[5]); C.rel_bias = as_g(ap->in[6]); C.lb_logits = as_g(ap->in[7]);
    C.hnorm = as_g(ap->in[8]); C.w_out = as_g(ap->in[9]); C.ln1g = as_g(ap->in[10]); C.ln1b = as_g(ap->in[11]); C.w_router = as_g(ap->in[12]); C.rbias = as_g(ap->in[13]); C.w_gate = as_g(ap->in[14]); C.w_up = as_g(ap->in[15]);
    C.w_down = as_g(ap->in[16]); C.ln2g = as_g(ap->in[17]); C.ln2b = as_g(ap->in[18]);
    unsigned char* ws = as_g(ap->ws);
    C.xcur = as_g(ap->out); C.ws = ws; C.ctl = (unsigned*)(ws + WS_CTL);
    C.Win = (bf16*)(ws + WS_WIN); C.Wout = (bf16*)(ws + WS_WOUT); C.Wmem = (bf16*)(ws + WS_WMEM); C.W1 = (bf16*)(ws + WS_W1); C.W2 = (bf16*)(ws + WS_W2);
    C.xb = (bf16*)(ws + WS_XB); C.proj = (bf16*)(ws + WS_BIG); C.hpre = (bf16*)(ws + WS_BIG); C.ys = (bf16*)(ws + WS_BIG);
    C.mix = (bf16*)(ws + WS_MIX); C.hmid = (bf16*)(ws + WS_MIX); C.memkv = (bf16*)(ws + WS_MEMKV); C.memb = (bf16*)(ws + WS_MEMB);
    C.biastab = (float*)(ws + WS_TAB); C.lbtab = (float*)(ws + WS_TAB + 4096); C.list = (int*)(ws + WS_LIST); C.tokrec = (u32x4*)(ws + WS_TOKREC); C.hst = (float*)(ws + WS_HST); C.xb8 = ws + WS_XB8;
    C.rep = ap->rep; C.G = gridDim.x; { const int bx = blockIdx.x; C.vcu = (C.G % 8 == 0) ? (bx % 8) * (C.G / 8) + bx / 8 : bx; }
    return C;
}
constexpr int PH_PER_LAYER = 7, N_PHASES = 1 + DEPTH * PH_PER_LAYER;
__global__ void __launch_bounds__(NTHR, 2) trunk_fwd(Args args) {
    extern __shared__ __attribute__((aligned(16))) unsigned char lds_raw[];
    LAS unsigned char* lds = (LAS unsigned char*)lds_raw;
    volatile LAS unsigned* MISC = (volatile LAS unsigned*)(lds + MISC_OFF);
    const int tid0 = threadIdx.x; const int wave0 = __builtin_amdgcn_readfirstlane(tid0 >> 6);
    for (int u = tid0; u < (LDS_BYTES - LDSCTL_OFF) / 4; u += NTHR) ((LAS unsigned*)(lds + LDSCTL_OFF))[u] = 0u;
    __syncthreads();
    KArgs ap = (KArgs)__builtin_amdgcn_kernarg_segment_ptr();
    XcdBarrier bar; bar.bar = (unsigned*)(as_g(args.ws) + WS_CTL) + CW_BAR; bar.x = 0; bar.st = nullptr;
    if (args.use_bar) bar = xcd_barrier_post((unsigned*)(as_g(args.ws) + WS_CTL) + CW_BAR, MISC + 8);
    const int lo = args.ph_lo, hi = args.ph_hi;
#define IN(k) (lo <= (k) && (k) < hi)
#define PHASE_IDS unsigned ones_ = ~0u; asm volatile("" : "+s"(ones_)); int lane = (int)__builtin_amdgcn_mbcnt_hi(ones_, __builtin_amdgcn_mbcnt_lo(ones_, 0u)); asm volatile("" : "+v"(lane)); int wave = wave0; asm volatile("" : "+s"(wave)); const int tid = wave * 64 + lane; (void)tid
#define SEAM(k) do { if (IN(k) && IN((k) + 1)) { XcdBarrier b2_ = bar; unsigned z_ = 0u; asm volatile("" : "+s"(z_)); b2_.bar = bar.bar + z_; xcd_barrier(b2_); } } while (0)

    if (IN(0)) { PHASE_IDS; const Ctx C = make_ctx(ap); p0_prologue(C, lds, wave, lane); }
    SEAM(0);
#pragma unroll 1
    for (int l = 0; l < DEPTH; ++l) {
        const int pb = 1 + l * PH_PER_LAYER;
        if (IN(pb + 0)) {
            PHASE_IDS; const Ctx C = make_ctx(ap);
            DenseSched S; S.A0 = (const char*)C.xb8; S.B0 = (const char*)C.Win + (size_t)l * INW * DM; S.nM0 = NTOK / 256; S.nN0 = INW / 256; S.K0 = DM  ;
            S.A1 = (const char*)C.memb; S.B1 = (const char*)C.Wmem; S.nM1 = (l == 0) ? (NB * MEMLEN) / 256 : 0; S.nN1 = 2048 / 256; S.G = C.G; S.c = (int)blockIdx.x;
            EpiProj E{(unsigned char*)C.proj, C.b_in + l * INW, (unsigned char*)C.memkv};
            pg8::gemm_phase<EpiProj, DenseSched, true>(lds, tid, DM, S, E);
        }
        SEAM(pb + 0);
        if (IN(pb + 1)) { PHASE_IDS; const Ctx C = make_ctx(ap); mixer_phase(C, lds, l, tid, wave, lane); }
        SEAM(pb + 1);
        if (IN(pb + 2)) {
            PHASE_IDS; const Ctx C = make_ctx(ap);
            DenseSched S; S.A0 = (const char*)C.mix; S.B0 = (const char*)C.Wout + (size_t)l * DM * MIXW; S.nM0 = NTOK / 256; S.nN0 = DM / 256; S.K0 = MIXW  ;
            S.A1 = nullptr; S.B1 = nullptr; S.nM1 = 0; S.nN1 = 0; S.G = C.G; S.c = (int)blockIdx.x;
            EpiOut E{(unsigned char*)C.hpre};
            pg8::gemm_phase<EpiOut, DenseSched, true>(lds, tid, MIXW, S, E);
        }
        SEAM(pb + 2);
        if (IN(pb + 3)) { PHASE_IDS; const Ctx C = make_ctx(ap); p4_ln_route(C, lds, l, tid, wave, lane); }
        SEAM(pb + 3);
        if (IN(pb + 4)) {
            PHASE_IDS; const Ctx C = make_ctx(ap);
            LAS int* tb = (LAS int*)(lds + LDSCTL_OFF + 64);
            moe_prefix(C, tb, l, tid);
            const int U = tb[16] * 4;
            MoeSched<true> S; S.A = (const char*)C.xb8; S.Bl = (const char*)C.W1 + (size_t)l * NE * 1024 * DM; S.K = DM  ; S.bstride = (size_t)1024 * DM; S.list = C.list; S.tb = tb;
            S.mode = 0; S.g0 = C.vcu; S.g1 = C.G; S.gU = U < 1024 ? U : 1024;
            EpiG1 E{(unsigned char*)C.hmid};
            pg8::gemm_phase<EpiG1, MoeSched<true>, true>(lds, tid, DM, S, E);
        }
        SEAM(pb + 4);
        if (IN(pb + 5)) {
            PHASE_IDS; const Ctx C = make_ctx(ap);
            LAS int* tb = (LAS int*)(lds + LDSCTL_OFF + 64);
            moe_prefix(C, tb, l, tid);
            const int U = tb[16] * 4, Etail = U > 1024 ? U - 1024 : 0;
            if (C.vcu < Etail) {
                MoeSched<true> S; S.A = (const char*)C.xb8; S.Bl = (const char*)C.W1 + (size_t)l * NE * 1024 * DM; S.K = DM  ; S.bstride = (size_t)1024 * DM; S.list = C.list; S.tb = tb;
                S.mode = 0; S.g0 = 1024 + C.vcu; S.g1 = 1 << 20; S.gU = 1024 + C.vcu + 1;
                EpiG1 E{(unsigned char*)C.hmid};
                pg8::gemm_phase<EpiG1, MoeSched<true>, true>(lds, tid, DM, S, E);
                asm volatile("s_waitcnt vmcnt(0)" ::: "memory");
                __syncthreads();
                if (tid == 0) {
                    unsigned* cnt = C.ctl + CW_TILE + (l * 16 + (C.vcu >> 2)) * 64; unsigned sp = 0;
                    __builtin_amdgcn_fence(__ATOMIC_RELEASE, "agent");
                    asm volatile("s_waitcnt vmcnt(0)" ::: "memory");
                    __hip_atomic_fetch_add(cnt, 1u, __ATOMIC_RELAXED, __HIP_MEMORY_SCOPE_AGENT);
                    while (__hip_atomic_load(cnt, __ATOMIC_RELAXED, __HIP_MEMORY_SCOPE_AGENT) < 4u) { __builtin_amdgcn_s_sleep(2); if (++sp > (1u << 24)) break; }
                    __builtin_amdgcn_fence(__ATOMIC_ACQUIRE, "agent");
                    asm volatile("s_waitcnt vmcnt(0)" ::: "memory");
                }
                __syncthreads();
            }
            MoeSched<false> S; S.A = (const char*)C.hmid; S.Bl = (const char*)C.W2 + (size_t)l * NE * DM * DE; S.K = DE  ; S.bstride = (size_t)DM * DE; S.list = C.list; S.tb = tb;
            S.mode = 1; S.g0 = C.vcu; S.g1 = Etail; S.gU = U < 1024 ? U : 1024;
            EpiG2 E{(unsigned char*)C.ys};
            pg8::gemm_phase<EpiG2, MoeSched<false>, true>(lds, tid, DE, S, E);
        }
        SEAM(pb + 5);
        if (IN(pb + 6)) { PHASE_IDS; const Ctx C = make_ctx(ap); p7_combine(C, lds, l, tid, wave, lane); }
        SEAM(pb + 6);
    }
#undef IN
#undef SEAM
}

#ifndef ONE_LAUNCH
#define ONE_LAUNCH 1
#endif
extern "C" void kernel_launch(void* const* d_in, const int* in_sizes, int n_in, void* d_out, int out_size, void* d_ws, size_t ws_size, hipStream_t stream) {
    static int grid = 0;
    if (grid == 0) {
        if (n_in != 19 || in_sizes[0] != NTOK * DM || out_size != NTOK * DM || ws_size < WS_END) {
            fprintf(stderr, "kernel_launch: unexpected shapes (n_in %d, in0 %d, out %d, ws %zu < %zu); nothing launched\n", n_in, n_in > 0 ? in_sizes[0] : -1, out_size, ws_size, (size_t)WS_END); grid = -1; return; }
        int dev = 0, cus = 0, per_cu = 0;
        if (hipGetDevice(&dev) != hipSuccess || hipDeviceGetAttribute(&cus, hipDeviceAttributeMultiprocessorCount, dev) != hipSuccess) { grid = -1; return; }
        if (hipFuncSetAttribute((const void*)trunk_fwd, hipFuncAttributeMaxDynamicSharedMemorySize, LDS_BYTES) != hipSuccess) { fprintf(stderr, "kernel_launch: hipFuncSetAttribute failed\n"); grid = -1; return; }
        if (hipOccupancyMaxActiveBlocksPerMultiprocessor(&per_cu, (const void*)trunk_fwd, NTHR, LDS_BYTES) != hipSuccess || per_cu < 1) { fprintf(stderr, "kernel_launch: occupancy query says %d\n", per_cu); }
        (void)hipGetLastError();
        grid = cus;
        fprintf(stderr, "kernel_launch: grid %d, occupancy/CU %d, ws %zu\n", grid, per_cu, ws_size);
    }
    if (grid < 0) return;
    (void)hipMemsetAsync((char*)d_ws + WS_CTL, 0, CTL_ZERO_BYTES, stream);
    Args a{};
    for (int i = 0; i < 19; ++i) a.in[i] = (const float*)d_in[i];
    a.out = (float*)d_out; a.ws = (unsigned char*)d_ws;
#if ONE_LAUNCH
    a.ph_lo = 0; a.ph_hi = N_PHASES; a.use_bar = 1;
    void* kargs[] = {&a};
    hipError_t e = hipLaunchCooperativeKernel((const void*)trunk_fwd, dim3(grid), dim3(NTHR), kargs, LDS_BYTES, stream);
    if (e != hipSuccess) fprintf(stderr, "kernel_launch: cooperative launch failed: %s\n", hipGetErrorString(e));
#else
    for (int p = 0; p < N_PHASES; ++p) {
        a.ph_lo = p; a.ph_hi = p + 1; a.use_bar = 0;
        hipLaunchKernelGGL(trunk_fwd, dim3(grid), dim3(NTHR), LDS_BYTES, stream, a);
    }
#endif
}
```

```cpp
#include <hip/hip_runtime.h>
#include <cstdio>
#include <cstdint>

#define LAS __attribute__((address_space(3)))
#define GAS __attribute__((address_space(1)))
typedef unsigned short bf16;
typedef short bf16x8 __attribute__((ext_vector_type(8)));
typedef short s16x4 __attribute__((ext_vector_type(4)));
typedef float f32x4 __attribute__((ext_vector_type(4)));
typedef float f32x2 __attribute__((ext_vector_type(2)));
typedef unsigned u32x4 __attribute__((ext_vector_type(4)));
typedef unsigned u32x2 __attribute__((ext_vector_type(2)));
typedef int i32x4 __attribute__((ext_vector_type(4)));
typedef int i32x8 __attribute__((ext_vector_type(8)));
typedef __bf16 bf16x2_t __attribute__((ext_vector_type(2)));

constexpr int NB = 8, SEQ = 4096, DM = 1024, NTOK = NB * SEQ, DEPTH = 4;
constexpr int INW = 2048, MIXW = 1024, NE = 16, DE = 512, MEMLEN = 256;
constexpr int C_SQ = 0, C_SK = 512, C_SV = 640, C_HQ = 768, C_HF = 1024, C_HI = 1280, C_HG = 1536, C_MQ = 1792;
constexpr float ALPHA = 1.6817928305074290f;
constexpr float LN_EPS = 1e-5f, RMS_EPS = 1e-6f;
constexpr int NSEG = 32, CPS = (SEQ / 16) / NSEG;
constexpr int LCAP = 32768;
constexpr int MAXTILES = NTOK * 2 / 256 + NE;
constexpr int NWAVES = 8, NTHR = 512;

constexpr size_t MiB = 1u << 20;
constexpr size_t WS_CTL = 0, CTL_ZERO_BYTES = 1 * MiB;
constexpr size_t WS_TAB = 1 * MiB;
constexpr size_t WS_WIN = 2 * MiB;
constexpr size_t WS_WOUT = 18 * MiB;
constexpr size_t WS_WMEM = 26 * MiB;
constexpr size_t WS_W1 = 30 * MiB;
constexpr size_t WS_XB8 = 94 * MiB;
constexpr size_t WS_W2 = 158 * MiB;
constexpr size_t WS_XB = 222 * MiB;
constexpr size_t WS_BIG = 286 * MiB;
constexpr size_t WS_MIX = 430 * MiB;
constexpr size_t WS_MEMKV = 502 * MiB;
constexpr size_t WS_MEMB = 510 * MiB;
constexpr size_t WS_LIST = 514 * MiB;
constexpr size_t WS_TOKREC = 516 * MiB;
constexpr size_t WS_HST = 517 * MiB;
constexpr size_t WS_END = 538 * MiB;
constexpr int CW_BAR = 4096;
constexpr int CW_CNT = 16384;
constexpr int CW_QUEUE = 32768;
constexpr int CW_TILE = 57344;
constexpr int CW_HA = 49152;

constexpr int RING_BYTES = 131072;
constexpr int LDSCTL_OFF = RING_BYTES, MISC_OFF = LDSCTL_OFF + 320;
constexpr int LDS_BYTES = 147456;

__device__ __forceinline__ unsigned pk2(float lo, float hi) { f32x2 v = {lo, hi}; bf16x2_t b = __builtin_convertvector(v, bf16x2_t); return __builtin_bit_cast(unsigned, b); }
__device__ __forceinline__ unsigned pk_fp8x4(f32x4 v) { int w = __builtin_amdgcn_cvt_pk_fp8_f32(v.x, v.y, 0, false); w = __builtin_amdgcn_cvt_pk_fp8_f32(v.z, v.w, w, true); return (unsigned)w; }
__device__ __forceinline__ f32x4 dec_fp8x4(unsigned w) { const f32x2 a = __builtin_amdgcn_cvt_pk_f32_fp8((int)w, false), b = __builtin_amdgcn_cvt_pk_f32_fp8((int)w, true); return (f32x4){a.x, a.y, b.x, b.y}; }
__device__ __forceinline__ void split_fp8(f32x4 y, unsigned& hi, unsigned& lo) { const f32x4 y8 = y * 8.f; hi = pk_fp8x4(y8); lo = pk_fp8x4((y8 - dec_fp8x4(hi)) * 16.f); }
__device__ __forceinline__ f32x4 join_fp8(unsigned hi, unsigned lo) { return dec_fp8x4(hi) * 0.125f + dec_fp8x4(lo) * 0.0078125f; }
__device__ __forceinline__ u32x4 fp8x8_to_bf16x8(u32x2 w) { const f32x4 a = dec_fp8x4(w.x), b = dec_fp8x4(w.y); u32x4 o; o.x = pk2(a.x, a.y); o.y = pk2(a.z, a.w); o.z = pk2(b.x, b.y); o.w = pk2(b.z, b.w); return o; }
__device__ __forceinline__ float frcp(float x) { return __builtin_amdgcn_rcpf(x); }
__device__ __forceinline__ float bflo(unsigned w) { return __uint_as_float(w << 16); }
__device__ __forceinline__ float bfhi(unsigned w) { return __uint_as_float(w & 0xffff0000u); }
#define DPPF(v, ctrl) __int_as_float(__builtin_amdgcn_update_dpp(0, __float_as_int(v), (ctrl), 0xf, 0xf, true))
__device__ __forceinline__ float wave_sum(float v) {
    v += DPPF(v, 0xB1);
    v += DPPF(v, 0x4E);
    v += DPPF(v, 0x141);
    v += DPPF(v, 0x140);
    v += __shfl_xor(v, 16); v += __shfl_xor(v, 32);
    return v;
}
__device__ __forceinline__ s16x4 ld_tr(const LAS unsigned char* p) { return __builtin_amdgcn_ds_read_tr16_b64_v4i16((LAS s16x4*)p); }
__device__ __forceinline__ float row_scan16(float x) {
    x += __int_as_float(__builtin_amdgcn_update_dpp(0, __float_as_int(x), 0x111, 0xf, 0xf, true));
    x += __int_as_float(__builtin_amdgcn_update_dpp(0, __float_as_int(x), 0x112, 0xf, 0xf, true));
    x += __int_as_float(__builtin_amdgcn_update_dpp(0, __float_as_int(x), 0x114, 0xf, 0xf, true));
    x += __int_as_float(__builtin_amdgcn_update_dpp(0, __float_as_int(x), 0x118, 0xf, 0xf, true));
    return x;
}
__device__ __forceinline__ bf16x8 mk8(unsigned a, unsigned b, unsigned c, unsigned d) { u32x4 w = {a, b, c, d}; return __builtin_bit_cast(bf16x8, w); }
__device__ __forceinline__ s16x4 mk4(unsigned a, unsigned b) { u32x2 w = {a, b}; return __builtin_bit_cast(s16x4, w); }

namespace pg8 {
constexpr int BM = 256, BK = 64, HALF = 128, HTB = HALF * BK * 2, STAGE_BYTES = 8 * HTB, NXCD = 8, WGM = 8;
constexpr int NXT_SLOT_OFF = 131072 + 2048;
__host__ __device__ __forceinline__ int lds_byte(int r, int c) { const int st = (r >> 4) * 2 + (c >> 5), rr = r & 15, cc = c & 31, ob = rr * 64 + cc * 2; return st * 1024 + (ob ^ (((ob >> 9) & 1) << 5)); }
__host__ __device__ __forceinline__ void stage_rc(int b, int& R, int& C) { const int st = b / 1024, sb = b % 1024, swz = sb ^ (((sb >> 9) & 1) << 5); R = (st >> 1) * 16 + swz / 64; C = (st & 1) * 32 + (swz % 64) / 2; }
__host__ __device__ __forceinline__ int perm32(int rho) { const int n = rho >> 4, i = rho & 15; return 8 * (i >> 2) + 4 * n + (i & 3); }
__host__ __device__ __forceinline__ int perm256(int R) { const int bj = R >> 7, wc = (R >> 5) & 3, n = (R >> 4) & 1, i = R & 15; return 64 * wc + 16 * (i >> 2) + 8 * bj + 4 * n + (i & 3); }

struct Unit {
    const char* A;
    const char* B;
    unsigned a00, a01, a10, a11;
    int row0, col0, aux;
};
__device__ __forceinline__ void tile_order(int L, int nM, int nN, int& pm, int& pn) {
    const int nwg = nM * nN; int wgid = L;
    { const int q = nwg / NXCD, r = nwg % NXCD, xcd = wgid % NXCD, off = wgid / NXCD; wgid = (xcd < r ? xcd * (q + 1) : r * (q + 1) + (xcd - r) * q) + off; }
    const int nig = WGM * nN, gid = wgid / nig, fm = gid * WGM, gsz = (nM - fm) < WGM ? (nM - fm) : WGM;
    pm = fm + ((wgid % nig) % gsz); pn = (wgid % nig) / gsz;
}

template <class Epi, class Sched, bool ALIGN_EPI>
__device__ __forceinline__ void gemm_phase(LAS unsigned char* lds, const int tid, const int RB  , Sched& S, const Epi& E) {
    const int wid = __builtin_amdgcn_readfirstlane(tid >> 6), lane = tid & 63, wr = wid >> 2, wc = wid & 3, fr = lane & 15, fq = lane >> 4;
    const int nt = RB / 128;
    unsigned voffB[2], voffA[2] = {0u, 0u};
    {
        int Ra[2], Ca[2];
#pragma unroll
        for (int i = 0; i < 2; ++i) { int R, C; stage_rc(tid * 16 + i * 8192, R, C); const int Rb = Epi::PERM16 ? perm256(R) : (Epi::PERM ? ((R & ~31) + perm32(R & 31)) : R);
            Ra[i] = R; Ca[i] = C; voffB[i] = (unsigned)(Rb * RB + 2 * C); }
        S.lane_init(Ra[0], Ca[0], Ra[1], Ca[1]);
        if constexpr (!Sched::GATHER) { voffA[0] = (unsigned)(Ra[0] * RB + 2 * Ca[0]); voffA[1] = (unsigned)(Ra[1] * RB + 2 * Ca[1]); }
    }
    const size_t kstep = (size_t)(BK * 2);
    const size_t hstepB = (size_t)HALF * RB;
    const size_t hstepW = Epi::PERM16 ? (size_t)8 * RB : hstepB;
    const unsigned ldsw = (unsigned)wid * 1024u;
    const int aoff = lds_byte(wr * 64 + fr, fq * 8), boff = lds_byte(wc * 32 + fr, fq * 8);
#define PG8_SA(b, h) (((b) * 2 + (h)) * HTB)
#define PG8_SB(b, h) ((4 + (b) * 2 + (h)) * HTB)
#define PG8_STAGE_B(bufoff, gbase) do { _Pragma("unroll") for (int _i = 0; _i < 2; ++_i) \
        __builtin_amdgcn_global_load_lds((const unsigned*)((const char*)(gbase) + voffB[_i]), (LAS unsigned*)(lds + (bufoff) + ldsw + _i * 8192), 16, 0, 0); } while (0)
#define PG8_STAGE_A(bufoff, gbase, hf, o0, o1) do { if constexpr (Sched::GATHER) { \
        __builtin_amdgcn_global_load_lds((const unsigned*)((const char*)(gbase) + (o0)), (LAS unsigned*)(lds + (bufoff) + ldsw), 16, 0, 0); \
        __builtin_amdgcn_global_load_lds((const unsigned*)((const char*)(gbase) + (o1)), (LAS unsigned*)(lds + (bufoff) + ldsw + 8192), 16, 0, 0); } else { \
        __builtin_amdgcn_global_load_lds((const unsigned*)((const char*)(gbase) + (hf) * hstepB + voffA[0]), (LAS unsigned*)(lds + (bufoff) + ldsw), 16, 0, 0); \
        __builtin_amdgcn_global_load_lds((const unsigned*)((const char*)(gbase) + (hf) * hstepB + voffA[1]), (LAS unsigned*)(lds + (bufoff) + ldsw + 8192), 16, 0, 0); } } while (0)
#define PG8_LDA(dst, b, h) do { _Pragma("unroll") for (int m = 0; m < 4; ++m) { dst[m].lo = *(const LAS i32x4*)(lds + PG8_SA(b, h) + aoff + m * 2048); dst[m].hi = *(const LAS i32x4*)(lds + PG8_SA(b, h) + aoff + m * 2048 + 1024); } } while (0)
#define PG8_LDB(dst, b, h) do { _Pragma("unroll") for (int n = 0; n < 2; ++n) { dst[n].lo = *(const LAS i32x4*)(lds + PG8_SB(b, h) + boff + n * 2048); dst[n].hi = *(const LAS i32x4*)(lds + PG8_SB(b, h) + boff + n * 2048 + 1024); } } while (0)
#define PG8_MMA(ai, bj, At, Bt) do { __builtin_amdgcn_s_setprio(1); _Pragma("unroll") for (int m = 0; m < 4; ++m) _Pragma("unroll") for (int n = 0; n < 2; ++n) { \
        if constexpr (Epi::FP8) asm volatile("v_mfma_scale_f32_16x16x128_f8f6f4 %0, %1, %2, %0, %3, %4 op_sel_hi:[0,0,0]" : "+v"(acc[ai][bj][m][n]) : "v"(Bt[n]), "v"(At[m]), "v"(sclw_), "v"(scla_));   \
        else { const i32x4 bl_ = Bt[n].lo, bh_ = Bt[n].hi, al_ = At[m].lo, ah_ = At[m].hi;     \
               acc[ai][bj][m][n] = __builtin_amdgcn_mfma_f32_16x16x32_bf16(__builtin_bit_cast(bf16x8, bl_), __builtin_bit_cast(bf16x8, al_), acc[ai][bj][m][n], 0, 0, 0); \
               acc[ai][bj][m][n] = __builtin_amdgcn_mfma_f32_16x16x32_bf16(__builtin_bit_cast(bf16x8, bh_), __builtin_bit_cast(bf16x8, ah_), acc[ai][bj][m][n], 0, 0, 0); } } __builtin_amdgcn_s_setprio(0); } while (0)
#define PG8_WAIT_V(n) asm volatile("s_waitcnt vmcnt(" #n ")" ::: "memory")
#define PG8_WAIT_L(n) asm volatile("s_waitcnt lgkmcnt(" #n ")" ::: "memory")
#define PG8_BAR __builtin_amdgcn_s_barrier()
#define PG8_SCHED __builtin_amdgcn_sched_barrier(0)
    Unit cur, nxt; int ui = 0;
    if (!S.next(0, cur)) return;
    f32x4 acc[2][2][4][2];
#pragma unroll
    for (int a = 0; a < 2; ++a)
#pragma unroll
        for (int b = 0; b < 2; ++b)
#pragma unroll
            for (int m = 0; m < 4; ++m)
#pragma unroll
                for (int n = 0; n < 2; ++n) acc[a][b][m][n] = (f32x4){0.f, 0.f, 0.f, 0.f};
    i32x8 At[4], B0[2], B1[2];
    int sclw_ = Epi::SCALE_W, scla_ = Epi::SCALE_A; asm volatile("" : "+v"(sclw_), "+v"(scla_));
    PG8_STAGE_B(PG8_SB(0, 0), cur.B); PG8_STAGE_B(PG8_SB(0, 1), cur.B + hstepW); PG8_STAGE_A(PG8_SA(0, 0), cur.A, 0, cur.a00, cur.a01); PG8_STAGE_A(PG8_SA(0, 1), cur.A, 1, cur.a10, cur.a11);
    if (wr == 1) PG8_BAR;
    PG8_WAIT_V(2); PG8_BAR;
    PG8_STAGE_B(PG8_SB(1, 0), cur.B + kstep); PG8_STAGE_A(PG8_SA(1, 0), cur.A + kstep, 0, cur.a00, cur.a01); PG8_STAGE_B(PG8_SB(1, 1), cur.B + hstepW + kstep);
    PG8_WAIT_V(6); PG8_BAR;
    for (;;) {
        const bool has_next = S.next(ui + 1, nxt);
        const char* nA = has_next ? nxt.A : cur.A; const char* nB = has_next ? nxt.B : cur.B;
        if constexpr (Sched::GATHER) {
            u32x4 nv; nv.x = has_next ? nxt.a00 : cur.a00; nv.y = has_next ? nxt.a01 : cur.a01; nv.z = has_next ? nxt.a10 : cur.a10; nv.w = has_next ? nxt.a11 : cur.a11;
            *(LAS u32x4*)(lds + NXT_SLOT_OFF + tid * 16) = nv; nxt.a00 = 0u; nxt.a01 = 0u; nxt.a10 = 0u; nxt.a11 = 0u;
        }
#pragma unroll 1
        for (int t = 0; t < nt; t += 2) {
            const bool last = (t == nt - 2);
            const char* a1 = cur.A + (size_t)(t + 1) * kstep;
            const char* a2 = last ? nA : cur.A + (size_t)(t + 2) * kstep; const char* b2 = last ? nB : cur.B + (size_t)(t + 2) * kstep;
            const char* a3 = a2 + kstep; const char* b3 = b2 + kstep;
            unsigned x00 = cur.a00, x01 = cur.a01, x10 = cur.a10, x11 = cur.a11;
            if constexpr (Sched::GATHER) { if (last) { const u32x4 nv = *(const LAS u32x4*)(lds + NXT_SLOT_OFF + tid * 16); x00 = nv.x; x01 = nv.y; x10 = nv.z; x11 = nv.w; } }
            PG8_LDB(B0, 0, 0); PG8_LDB(B1, 0, 1); PG8_SCHED; PG8_LDA(At, 0, 0); PG8_STAGE_A(PG8_SA(1, 1), a1, 1, cur.a10, cur.a11);
            PG8_WAIT_V(8); PG8_WAIT_L(0); PG8_BAR; PG8_MMA(0, 0, At, B0); PG8_MMA(0, 1, At, B1); PG8_BAR; PG8_SCHED;
            PG8_LDA(At, 0, 1); PG8_STAGE_B(PG8_SB(0, 0), b2); PG8_STAGE_B(PG8_SB(0, 1), b2 + hstepW); PG8_STAGE_A(PG8_SA(0, 0), a2, 0, x00, x01);
            PG8_WAIT_V(8); PG8_WAIT_L(0); PG8_BAR; PG8_MMA(1, 0, At, B0); PG8_MMA(1, 1, At, B1); PG8_BAR; PG8_SCHED;
            PG8_LDB(B0, 1, 0); PG8_LDB(B1, 1, 1); PG8_SCHED; PG8_LDA(At, 1, 0); PG8_STAGE_A(PG8_SA(0, 1), a2, 1, x10, x11);
            PG8_WAIT_V(8); PG8_WAIT_L(0); PG8_BAR; PG8_MMA(0, 0, At, B0); PG8_MMA(0, 1, At, B1); PG8_BAR; PG8_SCHED;
            PG8_LDA(At, 1, 1); PG8_STAGE_B(PG8_SB(1, 0), b3); PG8_STAGE_B(PG8_SB(1, 1), b3 + hstepW); PG8_STAGE_A(PG8_SA(1, 0), a3, 0, x00, x01);
            PG8_WAIT_V(8); PG8_WAIT_L(0); PG8_BAR; PG8_MMA(1, 0, At, B0); PG8_MMA(1, 1, At, B1); PG8_BAR; PG8_SCHED;
        }
        if constexpr (Epi::FP8) asm volatile("s_nop 15\n\ts_nop 7" ::: "memory");
        if constexpr (ALIGN_EPI) { if (wr == 0) PG8_BAR; }
        E(acc, cur, wr, wc, fr, fq);
        if (!has_next) break;
#pragma unroll
        for (int a = 0; a < 2; ++a)
#pragma unroll
            for (int b = 0; b < 2; ++b)
#pragma unroll
                for (int m = 0; m < 4; ++m)
#pragma unroll
                    for (int n = 0; n < 2; ++n) acc[a][b][m][n] = (f32x4){0.f, 0.f, 0.f, 0.f};
        cur = nxt; ++ui;
        if constexpr (Sched::GATHER) { const u32x4 nv = *(const LAS u32x4*)(lds + NXT_SLOT_OFF + tid * 16); cur.a00 = nv.x; cur.a01 = nv.y; cur.a10 = nv.z; cur.a11 = nv.w; }
        if constexpr (ALIGN_EPI) { if (wr == 1) PG8_BAR; }
    }
    PG8_WAIT_V(0);
    if constexpr (!ALIGN_EPI) { if (wr == 0) PG8_BAR; }
    PG8_BAR;
#undef PG8_SA
#undef PG8_SB
#undef PG8_STAGE_A
#undef PG8_STAGE_B
#undef PG8_LDA
#undef PG8_LDB
#undef PG8_MMA
#undef PG8_WAIT_V
#undef PG8_WAIT_L
#undef PG8_BAR
#undef PG8_SCHED
}
}

#define XB_TMO      128
#define XB_XCNT(j)  (256  + 64 * (j))
#define XB_XSUB(j)  (1280 + 64 * (j))
#define XB_XGEN(j)  (2304 + 64 * (j))
#define XB_TOP      3328
#define XB_TOPGEN   3392
#define XCD_BAR_WORDS 3456
#define XB_SPIN_CAP (1u << 22)
__device__ __forceinline__ unsigned xb_ld(unsigned* p)              { return __hip_atomic_load(p, __ATOMIC_RELAXED, __HIP_MEMORY_SCOPE_AGENT); }
__device__ __forceinline__ unsigned xb_add(unsigned* p, unsigned v) { return __hip_atomic_fetch_add(p, v, __ATOMIC_RELAXED, __HIP_MEMORY_SCOPE_AGENT); }
__device__ __forceinline__ unsigned xb_xcc_id() { return (unsigned)__builtin_amdgcn_s_getreg((3 << 11) | 20) & 0xFu; }
#define XB_SPIN(cond, bar) do { unsigned _sp = 0; while (cond) { __builtin_amdgcn_s_sleep(1); \
    if ((++_sp & 255u) == 0u) { if (xb_ld(&(bar)[XB_TMO])) break; if (_sp > XB_SPIN_CAP) { atomicAdd(&(bar)[XB_TMO], 1u); break; } } } } while (0)
struct XcdBarrier { unsigned* bar; unsigned x; volatile LAS unsigned* st; };
__device__ __forceinline__ XcdBarrier xcd_barrier_post(unsigned* bar, volatile LAS unsigned* st) {
    XcdBarrier b; b.bar = bar; b.x = xb_xcc_id(); b.st = st;
    if (threadIdx.x == 0) (void)xb_add(&bar[XB_XCNT(b.x)], 1u);
    return b;
}
__device__ __forceinline__ void xcd_barrier_complete(unsigned* bar, unsigned x, unsigned& nloc, unsigned& nx) {
    const unsigned G = gridDim.x * gridDim.y * gridDim.z;
    unsigned sum, cnt, mine, sp = 0u;
    for (;;) {
        sum = 0u; cnt = 0u; mine = 0u;
#pragma unroll
        for (unsigned j = 0; j < 16; ++j) { const unsigned c = xb_ld(&bar[XB_XCNT(j)]); sum += c; cnt += (c > 0u) ? 1u : 0u; mine = (j == x) ? c : mine; }
        if (sum == G) break;
        __builtin_amdgcn_s_sleep(1);
        if ((++sp & 255u) == 0u) { if (xb_ld(&bar[XB_TMO])) break; if (sp > XB_SPIN_CAP) { atomicAdd(&bar[XB_TMO], 1u); break; } }
    }
    nloc = mine > 0u ? mine : 1u; nx = cnt > 0u ? cnt : 1u;
}
__device__ __forceinline__ void xcd_barrier(const XcdBarrier& b) {
    asm volatile("s_waitcnt vmcnt(0)" ::: "memory");
    __syncthreads();
    if (threadIdx.x == 0) {
        unsigned* bar = b.bar;
        __builtin_amdgcn_s_waitcnt(0);
        unsigned nloc = b.st[0], nx = b.st[1];
        if (nloc == 0u) { xcd_barrier_complete(bar, b.x, nloc, nx); b.st[0] = nloc; b.st[1] = nx; }
        const unsigned old = xb_add(&bar[XB_XSUB(b.x)], 1u);
        const unsigned gen = old / nloc;
        if (old + 1u == (gen + 1u) * nloc) {
            __builtin_amdgcn_fence(__ATOMIC_RELEASE, "agent");
            asm volatile("s_waitcnt vmcnt(0)" ::: "memory");
            const unsigned og = xb_add(&bar[XB_TOP], 1u);
            const unsigned tg = og / nx;
            if (og + 1u == (tg + 1u) * nx) xb_add(&bar[XB_TOPGEN], 1u);
            else XB_SPIN(xb_ld(&bar[XB_TOPGEN]) == tg, bar);
            __builtin_amdgcn_fence(__ATOMIC_ACQUIRE, "agent");
            xb_add(&bar[XB_XGEN(b.x)], 1u);
            asm volatile("s_waitcnt vmcnt(0)" ::: "memory");
        } else {
            XB_SPIN(xb_ld(&bar[XB_XGEN(b.x)]) == gen, bar);
            __builtin_amdgcn_fence(__ATOMIC_ACQUIRE, "agent");
            asm volatile("s_waitcnt vmcnt(0)" ::: "memory");
        }
    }
    __syncthreads();
}

struct Args {
    const float* in[19];
    float* out; unsigned char* ws;
    int ph_lo, ph_hi, use_bar, rep;
};
struct Ctx {
    const float *x, *mem, *w_in, *b_in, *w_mem_kv, *sinks, *rel_bias, *lb_logits, *hnorm, *w_out, *ln1g, *ln1b, *w_router, *rbias, *w_gate, *w_up, *w_down, *ln2g, *ln2b;
    float* xcur;
    unsigned char* ws;
    unsigned* ctl;
    bf16 *Win, *Wout, *Wmem, *W1, *W2, *xb, *proj, *ys, *mix, *hmid, *memkv, *memb;
    bf16* hpre; float* biastab; float* lbtab; int* list; u32x4* tokrec; float* hst; unsigned char* xb8;
    int vcu, G, rep;
};

__constant__ unsigned char T5_BUCKET[128] = {0, 1, 2, 3, 4, 5, 6, 7, 8, 9, 10, 11, 12, 13, 14, 15, 16, 16, 16, 17, 17, 18, 18, 18, 19, 19, 19, 20, 20, 20, 20, 21, 21, 21, 21, 22, 22, 22, 22, 22, 23, 23, 23, 23, 23, 23, 24, 24, 24, 24, 24, 24, 25, 25, 25, 25, 25, 25, 25, 26, 26, 26, 26, 26, 26, 26, 26, 27, 27, 27, 27, 27, 27, 27, 27, 27, 27, 28, 28, 28, 28, 28, 28, 28, 28, 28, 28, 29, 29, 29, 29, 29, 29, 29, 29, 29, 29, 29, 29, 30, 30, 30, 30, 30, 30, 30, 30, 30, 30, 30, 30, 30, 30, 31, 31, 31, 31, 31, 31, 31, 31, 31, 31, 31, 31, 31, 31, 31};

struct TrItem { const float* src; bf16* dst; int N, K; float fp8s; };
__device__ __forceinline__ bool p0_item(const Ctx& C, int it, TrItem& t) {
    constexpr int I_IN = DEPTH * 16 * 64, I_OUT = DEPTH * 16 * 32, I_MEM = DEPTH * 16 * 16, I_G = 64 * 16 * 16, I_D = 64 * 8 * 32;
    constexpr int NITEMS = I_IN + I_OUT + I_MEM + 2 * I_G + I_D;
    if (it >= NITEMS) return false;
    int r = it;
    if (r < I_IN) { const int l = r / 1024, q = r % 1024, kb = q / 64, nb = q % 64; t.fp8s = 32.f; t.N = INW; t.K = DM; t.src = C.w_in + (size_t)l * DM * INW + (size_t)(64 * kb) * INW + 32 * nb; t.dst = (bf16*)((unsigned char*)C.Win + (size_t)l * INW * DM + (size_t)(32 * nb) * DM + 64 * kb); return true; } r -= I_IN;
    if (r < I_OUT) { const int l = r / 512, q = r % 512, kb = q / 32, nb = q % 32; t.fp8s = 64.f; t.N = DM; t.K = MIXW; t.src = C.w_out + (size_t)l * MIXW * DM + (size_t)(64 * kb) * DM + 32 * nb; t.dst = (bf16*)((unsigned char*)C.Wout + (size_t)l * DM * MIXW + (size_t)(32 * nb) * MIXW + 64 * kb); return true; } r -= I_OUT;
    if (r < I_MEM) { const int l = r / 256, q = r % 256, kb = q / 16, nb = q % 16; t.fp8s = 32.f; t.N = 512; t.K = DM; t.src = C.w_mem_kv + (size_t)l * DM * 512 + (size_t)(64 * kb) * 512 + 32 * nb; t.dst = (bf16*)((unsigned char*)C.Wmem + (size_t)l * 512 * DM + (size_t)(32 * nb) * DM + 64 * kb); return true; } r -= I_MEM;
    if (r < 2 * I_G) { const int up = r >= I_G; if (up) r -= I_G; const int le = r / 256, q = r % 256, kb = q / 16, nb = q % 16; const int n0 = 32 * nb;
        t.N = DE; t.K = DM; t.src = (up ? C.w_up : C.w_gate) + (size_t)le * DM * DE + (size_t)(64 * kb) * DE + n0; t.fp8s = 32.f; t.dst = (bf16*)((unsigned char*)C.W1 + (size_t)le * 1024 * DM + (size_t)((n0 >> 7) * 256 + (up ? 128 : 0) + (n0 & 127)) * DM + 64 * kb); return true; } r -= 2 * I_G;
    { const int le = r / 256, q = r % 256, kb = q / 32, nb = q % 32; t.N = DM; t.K = DE; t.src = C.w_down + (size_t)le * DE * DM + (size_t)(64 * kb) * DM + 32 * nb; t.fp8s = 64.f; t.dst = (bf16*)((unsigned char*)C.W2 + (size_t)le * DM * DE + (size_t)(32 * nb) * DE + 64 * kb); }
    return true;
}
__device__ __forceinline__ void p0_prologue(const Ctx& C, LAS unsigned char* lds, int wave, int lane) {
    LAS float* scr = (LAS float*)(lds + wave * 16384);
    const int gw = C.vcu * NWAVES + wave, NGW = C.G * NWAVES;
    {
        TrItem cur, nxt; float va[32], vb[32];
        bool have = p0_item(C, gw, cur);
        if (have) {
#pragma unroll
            for (int i = 0; i < 32; ++i) va[i] = cur.src[(size_t)(2 * i + (lane >> 5)) * cur.N + (lane & 31)];
        }
        for (int it = gw; have; it += NGW) {
            const bool hn = p0_item(C, it + NGW, nxt);
            if (hn) {
#pragma unroll
                for (int i = 0; i < 32; ++i) vb[i] = nxt.src[(size_t)(2 * i + (lane >> 5)) * nxt.N + (lane & 31)];
            }
#pragma unroll
            for (int i = 0; i < 32; ++i) scr[(2 * i + (lane >> 5)) * 33 + (lane & 31)] = va[i];
            const int c = lane & 7;
#pragma unroll
            for (int j = 0; j < 4; ++j) { const int n = (lane >> 3) + 8 * j; const LAS float* s = scr + (8 * c) * 33 + n;
                if (cur.fp8s != 0.f) { const float sc = cur.fp8s;
                    int w0 = __builtin_amdgcn_cvt_pk_fp8_f32(s[0 * 33] * sc, s[1 * 33] * sc, 0, false); w0 = __builtin_amdgcn_cvt_pk_fp8_f32(s[2 * 33] * sc, s[3 * 33] * sc, w0, true);
                    int w1 = __builtin_amdgcn_cvt_pk_fp8_f32(s[4 * 33] * sc, s[5 * 33] * sc, 0, false); w1 = __builtin_amdgcn_cvt_pk_fp8_f32(s[6 * 33] * sc, s[7 * 33] * sc, w1, true);
                    u32x2 o8; o8.x = (unsigned)w0; o8.y = (unsigned)w1;
                    *(u32x2*)((unsigned char*)cur.dst + (size_t)n * cur.K + 8 * c) = o8; }
                else { u32x4 o; o.x = pk2(s[0 * 33], s[1 * 33]); o.y = pk2(s[2 * 33], s[3 * 33]); o.z = pk2(s[4 * 33], s[5 * 33]); o.w = pk2(s[6 * 33], s[7 * 33]);
                    *(u32x4*)(cur.dst + (size_t)n * cur.K + 8 * c) = o; } }
#pragma unroll
            for (int i = 0; i < 32; ++i) va[i] = vb[i];
            cur = nxt; have = hn;
        }
    }
    for (int m = gw; m < NTOK + NB * MEMLEN; m += NGW) {
        const bool ism = m >= NTOK; const int r = ism ? m - NTOK : m;
        const f32x4* src = (const f32x4*)((ism ? C.mem : C.x) + (size_t)r * DM) + lane;
        f32x4 v[4];
#pragma unroll
        for (int j = 0; j < 4; ++j) v[j] = src[64 * j];
        unsigned* q8 = (unsigned*)((ism ? (unsigned char*)C.memb : C.xb8) + (size_t)r * DM) + lane;
        unsigned* ql = (unsigned*)((unsigned char*)C.xb + (size_t)r * DM) + lane;
#pragma unroll
        for (int j = 0; j < 4; ++j) { unsigned hi, lo; split_fp8(v[j], hi, lo); q8[64 * j] = hi; if (!ism) ql[64 * j] = lo; }
    }
    if (blockIdx.x == 0) {
        const int tid = wave * 64 + lane;
        for (int i = tid; i < 8 * 128; i += NTHR) { const int h = i >> 7, d = i & 127; C.biastab[i] = C.rel_bias[(int)T5_BUCKET[d] * 8 + h]; }
        if (tid < 256) { float v0 = C.lb_logits[tid], v1 = C.lb_logits[256 + tid], v2 = C.lb_logits[512 + tid], v3 = C.lb_logits[768 + tid];
            const float mx = fmaxf(fmaxf(v0, v1), fmaxf(v2, v3)); v0 = __expf(v0 - mx); v1 = __expf(v1 - mx); v2 = __expf(v2 - mx); v3 = __expf(v3 - mx);
            const float inv = 1.f / (v0 + v1 + v2 + v3);
            C.lbtab[tid] = 0.f; C.lbtab[256 + tid] = v1 * inv; C.lbtab[512 + tid] = (v1 + v2) * inv; C.lbtab[768 + tid] = (v1 + v2 + v3) * inv; }
    }
}

struct DenseSched {
    static constexpr bool GATHER = false;
    const char* A0; const char* B0; int nM0, nN0, K0;
    const char* A1; const char* B1; int nM1, nN1;
    int G, c;
    __device__ __forceinline__ void lane_init(int, int, int, int) {}
    __device__ __forceinline__ bool next(int i, pg8::Unit& u) const {
        const int n0 = nM0 * nN0; const int L = i * G + c; if (L >= n0 + nM1 * nN1) return false;
        int pm, pn; const char* A; const char* B; int aux;
        if (L < n0) { pg8::tile_order(L, nM0, nN0, pm, pn); A = A0; B = B0; aux = 0; }
        else { pg8::tile_order(L - n0, nM1, nN1, pm, pn); A = A1; B = B1; aux = 1; }
        u.A = A + (size_t)pm * 256 * K0; u.B = B + (size_t)pn * 256 * K0;
        u.a00 = 0u; u.a01 = 0u; u.a10 = 0u; u.a11 = 0u;
        u.row0 = pm * 256; u.col0 = pn * 256; u.aux = aux; return true;
    }
};
template <bool GATHER_> struct MoeSched {
    static constexpr bool GATHER = GATHER_;
    const char* A; const char* Bl; int K; size_t bstride;
    const int* list; const LAS int* tb;
    int g0, g1, gU, mode; int R0, C0, R1, C1;
    __device__ __forceinline__ void lane_init(int r0, int c0, int r1, int c1) { R0 = r0; C0 = c0; R1 = r1; C1 = c1; }
    __device__ __forceinline__ bool next(int i, pg8::Unit& u) const {
        int g;
        if (mode == 0) { g = g0 + i * g1; if (g >= gU) return false; }
        else {
            const int c = g0, E = g1;
            if (c < E) { if (i == 0) g = 1024 + c; else if (i <= 2) g = c + (i - 1) * E; else return false; }
            else { g = 2 * E + (c - E) + i * (256 - E); if (g >= gU) return false; }
        }
        const int tile = g >> 2, pn = g & 3;
        int e = 0;
#pragma unroll
        for (int j = 1; j < 16; ++j) e += (tile >= tb[j]) ? 1 : 0;
        e = __builtin_amdgcn_readfirstlane(e);
        u.B = Bl + (size_t)e * bstride + (size_t)pn * 256 * K;
        u.A = A;
        if (GATHER) {
            const int p0 = (tile - __builtin_amdgcn_readfirstlane(tb[e])) * 256, cnt = __builtin_amdgcn_readfirstlane(tb[17 + e]); const int* le = list + (size_t)e * LCAP;
            const int cm = cnt - 1;
            const int t00 = le[min(p0 + R0, cm)], t01 = le[min(p0 + R1, cm)], t10 = le[min(p0 + 128 + R0, cm)], t11 = le[min(p0 + 128 + R1, cm)];
            u.a00 = (unsigned)t00 * K + 2 * C0; u.a01 = (unsigned)t01 * K + 2 * C1; u.a10 = (unsigned)t10 * K + 2 * C0; u.a11 = (unsigned)t11 * K + 2 * C1;
        } else {
            u.A = A + (size_t)tile * 256 * K; u.a00 = 0u; u.a01 = 0u; u.a10 = 0u; u.a11 = 0u;
        }
        u.row0 = tile * 256; u.col0 = pn * 256; u.aux = e; return true;
    }
};
struct EpiProj {
    static constexpr bool PERM = true, PERM16 = true, FP8 = true; static constexpr int SCALE_W = 0x7A7A7A7A  , SCALE_A = 0x7C7C7C7C  ;
    unsigned char* O0; const float* bias; unsigned char* O1;
    __device__ __forceinline__ void operator()(const f32x4 (&acc)[2][2][4][2], const pg8::Unit& u, int wr, int wc, int fr, int fq) const {
        unsigned char* base = u.aux ? O1 : O0; const int row0 = u.row0 + wr * 64 + fr, col0 = u.col0 + wc * 64 + 16 * fq;
        f32x4 bv[2][2];
#pragma unroll
        for (int bj = 0; bj < 2; ++bj)
#pragma unroll
            for (int n = 0; n < 2; ++n) bv[bj][n] = u.aux ? (f32x4){0.f, 0.f, 0.f, 0.f} : *(const f32x4*)(bias + col0 + 8 * bj + 4 * n);
#pragma unroll
        for (int ai = 0; ai < 2; ++ai)
#pragma unroll
            for (int m = 0; m < 4; ++m) { unsigned char* rowp = base + (size_t)(row0 + ai * 128 + m * 16) * INW + col0;
                u32x4 w; w.x = pk_fp8x4((acc[ai][0][m][0] + bv[0][0]) * 8.f); w.y = pk_fp8x4((acc[ai][0][m][1] + bv[0][1]) * 8.f); w.z = pk_fp8x4((acc[ai][1][m][0] + bv[1][0]) * 8.f); w.w = pk_fp8x4((acc[ai][1][m][1] + bv[1][1]) * 8.f);
                *(u32x4*)rowp = w; }
    }
};
struct EpiOut {
    static constexpr bool PERM = true, PERM16 = true, FP8 = true; static constexpr int SCALE_W = 0x79797979  , SCALE_A = 0x7C7C7C7C  ;
    unsigned char* H;
    __device__ __forceinline__ void operator()(const f32x4 (&acc)[2][2][4][2], const pg8::Unit& u, int wr, int wc, int fr, int fq) const {
        const int row0 = u.row0 + wr * 64 + fr, col0 = u.col0 + wc * 64 + 16 * fq;
#pragma unroll
        for (int ai = 0; ai < 2; ++ai)
#pragma unroll
            for (int m = 0; m < 4; ++m) { const size_t off = (size_t)(row0 + ai * 128 + m * 16) * DM + col0;
                u32x4 w; w.x = pk_fp8x4(acc[ai][0][m][0] * 64.f); w.y = pk_fp8x4(acc[ai][0][m][1] * 64.f); w.z = pk_fp8x4(acc[ai][1][m][0] * 64.f); w.w = pk_fp8x4(acc[ai][1][m][1] * 64.f);
                *(u32x4*)(H + off) = w; }
    }
};
struct EpiG1 {
    static constexpr bool PERM = true, PERM16 = false, FP8 = true; static constexpr int SCALE_W = 0x7A7A7A7A  , SCALE_A = 0x7C7C7C7C  ;
    unsigned char* O;
    __device__ __forceinline__ void operator()(const f32x4 (&acc)[2][2][4][2], const pg8::Unit& u, int wr, int wc, int fr, int fq) const {
        const int row0 = u.row0 + wr * 64 + fr, col0 = (u.col0 >> 1) + wc * 32 + 8 * fq;
#pragma unroll
        for (int ai = 0; ai < 2; ++ai)
#pragma unroll
            for (int m = 0; m < 4; ++m) { unsigned char* rowp = O + (size_t)(row0 + ai * 128 + m * 16) * DE + col0;
                float hv[8];
#pragma unroll
                for (int n = 0; n < 2; ++n)
#pragma unroll
                    for (int j = 0; j < 4; ++j) { const float gte = acc[ai][0][m][n][j], up = acc[ai][1][m][n][j]; hv[n * 4 + j] = gte * frcp(1.f + __expf(-gte)) * up * 8.f; }
                int w0 = __builtin_amdgcn_cvt_pk_fp8_f32(hv[0], hv[1], 0, false); w0 = __builtin_amdgcn_cvt_pk_fp8_f32(hv[2], hv[3], w0, true);
                int w1 = __builtin_amdgcn_cvt_pk_fp8_f32(hv[4], hv[5], 0, false); w1 = __builtin_amdgcn_cvt_pk_fp8_f32(hv[6], hv[7], w1, true);
                u32x2 w; w.x = (unsigned)w0; w.y = (unsigned)w1;
                *(u32x2*)rowp = w; }
    }
};
struct EpiG2 {
    static constexpr bool PERM = true, PERM16 = true, FP8 = true; static constexpr int SCALE_W = 0x79797979  , SCALE_A = 0x7C7C7C7C  ;
    unsigned char* O;
    __device__ __forceinline__ void operator()(const f32x4 (&acc)[2][2][4][2], const pg8::Unit& u, int wr, int wc, int fr, int fq) const {
        const int row0 = u.row0 + wr * 64 + fr, col0 = u.col0 + wc * 64 + 16 * fq;
#pragma unroll
        for (int ai = 0; ai < 2; ++ai)
#pragma unroll
            for (int m = 0; m < 4; ++m) { unsigned char* rowp = O + (size_t)(row0 + ai * 128 + m * 16) * DM + col0;
                u32x4 w; w.x = pk_fp8x4(acc[ai][0][m][0] * 16.f); w.y = pk_fp8x4(acc[ai][0][m][1] * 16.f); w.z = pk_fp8x4(acc[ai][1][m][0] * 16.f); w.w = pk_fp8x4(acc[ai][1][m][1] * 16.f);
                *(u32x4*)rowp = w; }
    }
};

constexpr int AT_KOFF = 0, AT_VOFF = 36864, AT_BOFF = 73728, AT_OOFF = 77824;
template <bool SWA>
__device__ __forceinline__ void attn_item(const Ctx& C, LAS unsigned char* lds, int l, int item, int tid, int wave, int lane) {
    const int tk = lane & 15, g = lane >> 4;
    int b, nb = 0, kvh = 0, hm = 0, qb = 0;
    const unsigned char *Kg, *Vg; size_t kpitch;
    if (SWA) { b = item >> 6; nb = (item >> 1) & 31; kvh = item & 1;
        Kg = (const unsigned char*)C.proj + ((size_t)b * SEQ + (size_t)(nb - 1) * 128) * INW + C_SK + kvh * 64; Vg = Kg + (C_SV - C_SK); kpitch = INW; }
    else { b = item >> 5; hm = (item >> 3) & 3; qb = item & 7;
        Kg = (const unsigned char*)C.memkv + (size_t)b * MEMLEN * 2048 + l * 512 + hm * 64; Vg = Kg + 256; kpitch = 2048; }
    __syncthreads();
#pragma unroll
    for (int i = 0; i < 4; ++i) { const int c = tid + 512 * i, key = c >> 3, part = c & 7;
        u32x2 k8 = {0u, 0u}, v8 = {0u, 0u};
        if (!SWA || nb > 0 || key >= 128) { k8 = *(const u32x2*)(Kg + (size_t)key * kpitch + part * 8); v8 = *(const u32x2*)(Vg + (size_t)key * kpitch + part * 8); }
        *(LAS u32x4*)(lds + AT_KOFF + key * 144 + part * 16) = fp8x8_to_bf16x8(k8); *(LAS u32x4*)(lds + AT_VOFF + key * 144 + part * 16) = fp8x8_to_bf16x8(v8); }
    if (SWA) ((LAS float*)(lds + AT_BOFF))[tid] = C.biastab[(kvh * 4 + (tid >> 7)) * 128 + (tid & 127)] * 1.44269504f;
    __syncthreads();
    int hq = 0; float sink = 0.f; size_t qrow_base; int qcol, ocol, i0w = 0;
    if (SWA) { hq = kvh * 4 + (wave >> 1); sink = C.sinks[l * 8 + hq]; i0w = (wave & 1) * 64; qrow_base = (size_t)b * SEQ + nb * 128 + i0w; qcol = C_SQ + hq * 64; ocol = hq * 64; }
    else { qrow_base = (size_t)b * SEQ + qb * 512 + wave * 64; qcol = C_MQ + hm * 64; ocol = 768 + hm * 64; }
    const LAS float* biasL = (const LAS float*)(lds + AT_BOFF) + (wave >> 1) * 128;
    const LAS unsigned char* kbase = lds + AT_KOFF + tk * 144 + g * 16;
    const LAS unsigned char* vbase = lds + AT_VOFF + (4 * g + (tk >> 2)) * 144 + (tk & 3) * 8;
#pragma unroll 1
    for (int rt = 0; rt < 4; ++rt) {
        const size_t qrow = qrow_base + rt * 16;
        const unsigned char* qp = (const unsigned char*)C.proj + (qrow + tk) * INW + qcol + 8 * g;
        const bf16x8 q0 = __builtin_bit_cast(bf16x8, fp8x8_to_bf16x8(*(const u32x2*)qp)), q1 = __builtin_bit_cast(bf16x8, fp8x8_to_bf16x8(*(const u32x2*)(qp + 32)));
        constexpr int NT = SWA ? 10 : 16;
        const int t0 = SWA ? ((i0w >> 4) + rt) : 0;
        f32x4 st[NT];
#pragma unroll
        for (int t = 0; t < NT; ++t) {
            const int tc = SWA ? min(t0 + t, 15) : t;
            const bf16x8 k0 = *(const LAS bf16x8*)(kbase + tc * 16 * 144), k1 = *(const LAS bf16x8*)(kbase + tc * 16 * 144 + 64);
            f32x4 a = {0.f, 0.f, 0.f, 0.f};
            a = __builtin_amdgcn_mfma_f32_16x16x32_bf16(k0, q0, a, 0, 0, 0);
            st[t] = __builtin_amdgcn_mfma_f32_16x16x32_bf16(k1, q1, a, 0, 0, 0);
        }
        constexpr float C2 = 0.125f * 1.44269504f * (1.f / 64.f);
        float mx2, sum = 0.f;
        if (SWA) {
            const float sink2 = sink * 1.44269504f;
            const int iq = i0w + rt * 16 + tk;
            const int d0 = iq + 128 - 16 * t0 - 4 * g;
            const unsigned lim = (nb > 0) ? 128u : (unsigned)min(128, iq + 1);
            const LAS float* bl = biasL + (d0 - 16 * (NT - 1) - 3);
            float m4[4] = {sink2, sink2, sink2, sink2};
#pragma unroll
            for (int t = 0; t < NT; ++t)
#pragma unroll
                for (int r = 0; r < 4; ++r) {
                    const unsigned dist = (unsigned)(d0 - 16 * t - r);
                    const float xv = (dist < lim) ? __builtin_fmaf(st[t][r], C2, bl[16 * (NT - 1 - t) + (3 - r)]) : -INFINITY;
                    st[t][r] = xv; m4[r] = fmaxf(m4[r], xv);
                }
            mx2 = fmaxf(fmaxf(m4[0], m4[1]), fmaxf(m4[2], m4[3]));
            mx2 = fmaxf(mx2, __shfl_xor(mx2, 16)); mx2 = fmaxf(mx2, __shfl_xor(mx2, 32));
            float s4[4] = {0.f, 0.f, 0.f, 0.f};
#pragma unroll
            for (int t = 0; t < NT; ++t)
#pragma unroll
                for (int r = 0; r < 4; ++r) { const float p = __builtin_amdgcn_exp2f(st[t][r] - mx2); st[t][r] = p; s4[r] += p; }
            sum = (s4[0] + s4[1]) + (s4[2] + s4[3]);
            sum += __shfl_xor(sum, 16); sum += __shfl_xor(sum, 32);
            sum += __builtin_amdgcn_exp2f(sink2 - mx2);
        } else {
            float m4[4] = {st[0][0], st[0][1], st[0][2], st[0][3]};
#pragma unroll
            for (int t = 1; t < NT; ++t)
#pragma unroll
                for (int r = 0; r < 4; ++r) m4[r] = fmaxf(m4[r], st[t][r]);
            float mr = fmaxf(fmaxf(m4[0], m4[1]), fmaxf(m4[2], m4[3]));
            mr = fmaxf(mr, __shfl_xor(mr, 16)); mr = fmaxf(mr, __shfl_xor(mr, 32));
            const float nm = -mr * C2;
            float s4[4] = {0.f, 0.f, 0.f, 0.f};
#pragma unroll
            for (int t = 0; t < NT; ++t)
#pragma unroll
                for (int r = 0; r < 4; ++r) { const float p = __builtin_amdgcn_exp2f(__builtin_fmaf(st[t][r], C2, nm)); st[t][r] = p; s4[r] += p; }
            sum = (s4[0] + s4[1]) + (s4[2] + s4[3]);
            sum += __shfl_xor(sum, 16); sum += __shfl_xor(sum, 32);
        }
        const float inv = frcp(sum);
        f32x4 o[4];
#pragma unroll
        for (int n = 0; n < 4; ++n) o[n] = (f32x4){0.f, 0.f, 0.f, 0.f};
#pragma unroll
        for (int s = 0; s < NT / 2; ++s) {
            const f32x4 pa = st[2 * s] * inv, pb = st[2 * s + 1] * inv;
            const bf16x8 pfrag = mk8(pk2(pa[0], pa[1]), pk2(pa[2], pa[3]), pk2(pb[0], pb[1]), pk2(pb[2], pb[3]));
            const int ta = SWA ? min(t0 + 2 * s, 15) : 2 * s, tb2 = SWA ? min(t0 + 2 * s + 1, 15) : 2 * s + 1;
#pragma unroll
            for (int n = 0; n < 4; ++n) {
                const s16x4 lo = ld_tr(vbase + (16 * ta) * 144 + n * 32), hi = ld_tr(vbase + (16 * tb2) * 144 + n * 32);
                const bf16x8 vf = {lo[0], lo[1], lo[2], lo[3], hi[0], hi[1], hi[2], hi[3]};
                o[n] = __builtin_amdgcn_mfma_f32_16x16x32_bf16(pfrag, vf, o[n], 0, 0, 0);
            }
        }
        LAS unsigned char* ost = lds + AT_OOFF + wave * 2304;
#pragma unroll
        for (int r = 0; r < 4; ++r)
#pragma unroll
            for (int n = 0; n < 4; n += 2) { const unsigned w = (unsigned)__builtin_amdgcn_cvt_pk_fp8_f32(o[n][r], o[n + 1][r], 0, false);
                *(LAS unsigned char*)(ost + (4 * g + r) * 80 + 16 * n + tk) = (unsigned char)(w & 0xffu); *(LAS unsigned char*)(ost + (4 * g + r) * 80 + 16 * (n + 1) + tk) = (unsigned char)((w >> 8) & 0xffu); }
        { const int orow = lane >> 2, part = lane & 3;
            const u32x4 w = *(const LAS u32x4*)(ost + orow * 80 + part * 16);
            *(u32x4*)((unsigned char*)C.mix + (size_t)(qrow + orow) * MIXW + ocol + part * 16) = w; }
    }
}

template <bool PB>
__device__ __forceinline__ void hgrn_item(const Ctx& C, LAS unsigned char* lds, int wv, int l, int witem, int lane) {
    LAS unsigned char* scr = lds + wv * 4608;
    const int tk = lane & 15, g = lane >> 4;
    const int bh = witem / NSEG, seg = witem % NSEG, b = bh >> 2, h = bh & 3;
    float oml[4][4];
#pragma unroll
    for (int c = 0; c < 4; ++c)
#pragma unroll
        for (int i = 0; i < 4; ++i) oml[c][i] = 1.f - C.lbtab[l * 256 + h * 64 + 16 * c + 4 * g + i];
    f32x4 S[4][4];
#pragma unroll
    for (int mt = 0; mt < 4; ++mt)
#pragma unroll
        for (int n = 0; n < 4; ++n) S[mt][n] = (f32x4){0.f, 0.f, 0.f, 0.f};
    float dseg[4][4];
#pragma unroll
    for (int c = 0; c < 4; ++c)
#pragma unroll
        for (int i = 0; i < 4; ++i) dseg[c][i] = 1.f;
    if (PB) {
        if (lane == 0 && wv == 0) {
            unsigned* cnt = C.ctl + CW_HA + (l * 32 + bh) * 64; unsigned sp = 0;
            while (__hip_atomic_load(cnt, __ATOMIC_RELAXED, __HIP_MEMORY_SCOPE_AGENT) < (unsigned)(NSEG / NWAVES)) { __builtin_amdgcn_s_sleep(2); if (++sp > (1u << 24)) break; }
            __builtin_amdgcn_fence(__ATOMIC_ACQUIRE, "agent");
            asm volatile("s_waitcnt vmcnt(0)" ::: "memory");
        }
    }
    if (PB) {
        LAS float* pl = (LAS float*)lds;
        const int seg0 = seg - wv;
        __syncthreads();
#pragma unroll 1
        for (int qq = 0; qq < 8; ++qq) {
            const int q = wv * 8 + qq, dq = 64 + (q >> 4) * 4 + (q & 3);
            const float* base = C.hst + (size_t)bh * NSEG * 80 * 64 + lane;
            float Sx = 0.f;
            for (int j0 = 0; j0 < seg0; j0 += 8) {
                float dv[8], sv[8];
#pragma unroll
                for (int j = 0; j < 8; ++j) { dv[j] = base[((size_t)(j0 + j) * 80 + dq) * 64]; sv[j] = base[((size_t)(j0 + j) * 80 + q) * 64]; }
#pragma unroll
                for (int j = 0; j < 8; ++j) Sx = Sx * dv[j] + sv[j];
            }
            float dv[8], sv[8];
#pragma unroll
            for (int j = 0; j < 8; ++j) { dv[j] = base[((size_t)(seg0 + j) * 80 + dq) * 64]; sv[j] = base[((size_t)(seg0 + j) * 80 + q) * 64]; }
#pragma unroll
            for (int j = 0; j < 8; ++j) { pl[(j * 64 + q) * 64 + lane] = Sx; Sx = Sx * dv[j] + sv[j]; }
        }
        __syncthreads();
#pragma unroll
        for (int mt = 0; mt < 4; ++mt)
#pragma unroll
            for (int n = 0; n < 4; ++n)
#pragma unroll
                for (int r = 0; r < 4; ++r) S[mt][n][r] = pl[(wv * 64 + (mt * 4 + n) * 4 + r) * 64 + lane];
        __syncthreads();
    }
    float nw[4][4];
    if (PB) {
#pragma unroll
        for (int c = 0; c < 4; ++c)
#pragma unroll
            for (int i = 0; i < 4; ++i) nw[c][i] = C.hnorm[l * 64 + 16 * c + 4 * g + i];
    }
    const size_t rowbase = (size_t)b * SEQ + (size_t)seg * CPS * 16;
    LAS unsigned char* sk = scr; LAS unsigned char* sv = scr + 2304;
    const LAS unsigned char* trk = sk + (4 * g + (tk >> 2)) * 144 + (tk & 3) * 8;
    const LAS unsigned char* trv = sv + (4 * g + (tk >> 2)) * 144 + (tk & 3) * 8;
    unsigned nzf[4], nvi[4];
    { const unsigned char* pr = (const unsigned char*)C.proj + (rowbase + tk) * INW + h * 64 + 4 * g;
#pragma unroll
        for (int c = 0; c < 4; ++c) { nzf[c] = *(const unsigned*)(pr + C_HF + 16 * c); nvi[c] = *(const unsigned*)(pr + C_HI + 16 * c); } }
#pragma unroll 1
    for (int ch = 0; ch < CPS; ++ch) {
        const size_t row = rowbase + ch * 16 + tk;
        unsigned zf_[4], vi_[4], zq_[4], gt_[4];
#pragma unroll
        for (int c = 0; c < 4; ++c) { zf_[c] = nzf[c]; vi_[c] = nvi[c]; }
        if (PB) { const unsigned char* pr = (const unsigned char*)C.proj + row * INW + h * 64 + 4 * g;
#pragma unroll
            for (int c = 0; c < 4; ++c) { zq_[c] = *(const unsigned*)(pr + C_HQ + 16 * c); gt_[c] = *(const unsigned*)(pr + C_HG + 16 * c); } }
        { const unsigned char* pr = (const unsigned char*)C.proj + (rowbase + (ch < CPS - 1 ? ch + 1 : ch) * 16 + tk) * INW + h * 64 + 4 * g;
#pragma unroll
            for (int c = 0; c < 4; ++c) { nzf[c] = *(const unsigned*)(pr + C_HF + 16 * c); nvi[c] = *(const unsigned*)(pr + C_HI + 16 * c); } }
        float kk[4][4], bcs[4][4], dreg[4][4];
#pragma unroll
        for (int c = 0; c < 4; ++c) { const f32x4 zf4 = dec_fp8x4(zf_[c]) * (0.125f * 1.44269504f);
#pragma unroll
            for (int i = 0; i < 4; ++i) {
                const float z = zf4[i];
                const float sneg = frcp(1.f + __builtin_amdgcn_exp2f(z));
                const float kv = oml[c][i] * sneg;
                kk[c][i] = kv;
                bcs[c][i] = row_scan16(__builtin_amdgcn_logf(1.f - kv));
            } }
#pragma unroll
        for (int c = 0; c < 4; ++c)
#pragma unroll
            for (int i = 0; i < 4; ++i) { const float bl = __shfl(bcs[c][i], (lane & 48) | 15); dreg[c][i] = __builtin_amdgcn_exp2f(bl); }
        unsigned kop_[4][2];
#pragma unroll
        for (int c = 0; c < 4; ++c) {
            const float e0 = kk[c][0] * __builtin_amdgcn_exp2f(-bcs[c][0]), e1 = kk[c][1] * __builtin_amdgcn_exp2f(-bcs[c][1]), e2 = kk[c][2] * __builtin_amdgcn_exp2f(-bcs[c][2]), e3 = kk[c][3] * __builtin_amdgcn_exp2f(-bcs[c][3]);
            kop_[c][0] = pk2(e0, e1); kop_[c][1] = pk2(e2, e3);
            u32x2 w; w.x = kop_[c][0]; w.y = kop_[c][1];
            *(LAS u32x2*)(sk + tk * 144 + (16 * c + 4 * g) * 2) = w;
            { const f32x4 vv = dec_fp8x4(vi_[c]) * 0.125f; u32x2 wv; wv.x = pk2(vv.x, vv.y); wv.y = pk2(vv.z, vv.w); *(LAS u32x2*)(sv + tk * 144 + (16 * c + 4 * g) * 2) = wv; }
        }
        s16x4 kT[4], vT[4];
#pragma unroll
        for (int m = 0; m < 4; ++m) { kT[m] = ld_tr(trk + m * 32); vT[m] = ld_tr(trv + m * 32); }
        f32x4 o[4];
        if (PB) {
            unsigned qop_[4][2];
#pragma unroll
            for (int c = 0; c < 4; ++c) {
                float qv[4]; const f32x4 zq4 = dec_fp8x4(zq_[c]) * 0.125f;
#pragma unroll
                for (int i = 0; i < 4; ++i) { const float z = zq4[i];
                    qv[i] = z * frcp(1.f + __expf(-z)) * 0.125f * __builtin_amdgcn_exp2f(bcs[c][i]); }
                qop_[c][0] = pk2(qv[0], qv[1]); qop_[c][1] = pk2(qv[2], qv[3]);
            }
            const bf16x8 qa = mk8(qop_[0][0], qop_[0][1], qop_[1][0], qop_[1][1]), qb2 = mk8(qop_[2][0], qop_[2][1], qop_[3][0], qop_[3][1]);
            const bf16x8 ka = mk8(kop_[0][0], kop_[0][1], kop_[1][0], kop_[1][1]), kb2 = mk8(kop_[2][0], kop_[2][1], kop_[3][0], kop_[3][1]);
            f32x4 sT = {0.f, 0.f, 0.f, 0.f};
            sT = __builtin_amdgcn_mfma_f32_16x16x32_bf16(ka, qa, sT, 0, 0, 0);
            sT = __builtin_amdgcn_mfma_f32_16x16x32_bf16(kb2, qb2, sT, 0, 0, 0);
#pragma unroll
            for (int r = 0; r < 4; ++r) if (4 * g + r > tk) sT[r] = 0.f;
            const s16x4 sT4 = mk4(pk2(sT[0], sT[1]), pk2(sT[2], sT[3]));
#pragma unroll
            for (int n = 0; n < 4; ++n) {
                f32x4 a = {0.f, 0.f, 0.f, 0.f};
                a = __builtin_amdgcn_mfma_f32_16x16x16bf16_1k(vT[n], sT4, a, 0, 0, 0);
                const bf16x8 s0 = mk8(pk2(S[0][n][0], S[0][n][1]), pk2(S[0][n][2], S[0][n][3]), pk2(S[1][n][0], S[1][n][1]), pk2(S[1][n][2], S[1][n][3]));
                const bf16x8 s1 = mk8(pk2(S[2][n][0], S[2][n][1]), pk2(S[2][n][2], S[2][n][3]), pk2(S[3][n][0], S[3][n][1]), pk2(S[3][n][2], S[3][n][3]));
                f32x4 a2 = {0.f, 0.f, 0.f, 0.f};
                a2 = __builtin_amdgcn_mfma_f32_16x16x32_bf16(s0, qa, a2, 0, 0, 0);
                a2 = __builtin_amdgcn_mfma_f32_16x16x32_bf16(s1, qb2, a2, 0, 0, 0);
                o[n] = a + a2;
            }
        }
#pragma unroll
        for (int mt = 0; mt < 4; ++mt)
#pragma unroll
            for (int n = 0; n < 4; ++n) {
                f32x4 a = __builtin_amdgcn_mfma_f32_16x16x16bf16_1k(kT[mt], vT[n], S[mt][n], 0, 0, 0);
#pragma unroll
                for (int r = 0; r < 4; ++r) a[r] *= dreg[mt][r];
                S[mt][n] = a;
            }
        if (PB) {
            float ss = 0.f;
#pragma unroll
            for (int n = 0; n < 4; ++n)
#pragma unroll
                for (int r = 0; r < 4; ++r) ss += o[n][r] * o[n][r];
            ss += __shfl_xor(ss, 16); ss += __shfl_xor(ss, 32);
            const float rinv = __builtin_amdgcn_rsqf(ss * (1.f / 64.f) + RMS_EPS);
            unsigned char* op = (unsigned char*)C.mix + row * MIXW + 512 + h * 64 + 4 * g;
#pragma unroll
            for (int n = 0; n < 4; ++n) {
                float ov[4]; const f32x4 gz4 = dec_fp8x4(gt_[n]) * 0.125f;
#pragma unroll
                for (int r = 0; r < 4; ++r) { const float z = gz4[r];
                    ov[r] = __builtin_amdgcn_fmed3f(o[n][r] * rinv * nw[n][r] * (z * frcp(1.f + __expf(-z))) * 8.f, -448.f, 448.f); }
                *(unsigned*)(op + 16 * n) = pk_fp8x4((f32x4){ov[0], ov[1], ov[2], ov[3]});
            }
        } else {
#pragma unroll
            for (int c = 0; c < 4; ++c)
#pragma unroll
                for (int i = 0; i < 4; ++i) dseg[c][i] *= dreg[c][i];
        }
    }
    if (!PB) {
        float* sl = C.hst + ((size_t)witem * 80) * 64 + lane;
#pragma unroll
        for (int mt = 0; mt < 4; ++mt)
#pragma unroll
            for (int n = 0; n < 4; ++n)
#pragma unroll
                for (int r = 0; r < 4; ++r) sl[((mt * 4 + n) * 4 + r) * 64] = S[mt][n][r];
#pragma unroll
        for (int c = 0; c < 4; ++c)
#pragma unroll
            for (int i = 0; i < 4; ++i) sl[(64 + c * 4 + i) * 64] = dseg[c][i];
        asm volatile("s_waitcnt vmcnt(0)" ::: "memory");
        __syncthreads();
        if (lane == 0 && wv == 0) {
            __builtin_amdgcn_fence(__ATOMIC_RELEASE, "agent");
            asm volatile("s_waitcnt vmcnt(0)" ::: "memory");
            __hip_atomic_fetch_add(C.ctl + CW_HA + (l * 32 + bh) * 64, 1u, __ATOMIC_RELAXED, __HIP_MEMORY_SCOPE_AGENT);
        }
    }
}

__device__ __forceinline__ void mixer_phase(const Ctx& C, LAS unsigned char* lds, int l, int tid, int wave, int lane) {
    constexpr int NH = 32 * NSEG / NWAVES;
    constexpr int N_MEM = NB * 4 * 8, N_SWA = NB * 32 * 2;
    unsigned* head = C.ctl + CW_QUEUE + l * 64;
    volatile LAS int* slot = (volatile LAS int*)(lds + LDSCTL_OFF + 256);
    for (;;) {
        __syncthreads();
        if (tid == 0) slot[0] = (int)__hip_atomic_fetch_add(head, 1u, __ATOMIC_RELAXED, __HIP_MEMORY_SCOPE_AGENT);
        __syncthreads();
        int it = __builtin_amdgcn_readfirstlane(slot[0]);
        if (it >= 2 * NH + N_MEM + N_SWA) break;
        int lane_i = lane; asm volatile("" : "+v"(lane_i));
        if (it < NH) { hgrn_item<false>(C, lds, wave, l, it * NWAVES + wave, lane_i); continue; } it -= NH;
        if (it < N_SWA / 2) { attn_item<true>(C, lds, l, it, wave * 64 + lane_i, wave, lane_i); continue; } it -= N_SWA / 2;
        if (it < NH) { hgrn_item<true>(C, lds, wave, l, it * NWAVES + wave, lane_i); continue; } it -= NH;
        if (it < N_SWA / 2) { attn_item<true>(C, lds, l, it + N_SWA / 2, wave * 64 + lane_i, wave, lane_i); continue; } it -= N_SWA / 2;
        attn_item<false>(C, lds, l, it, wave * 64 + lane_i, wave, lane_i);
    }
}

__device__ __forceinline__ float reduce_scatter16(const float (&p)[16], int lane) {
    const bool h5 = (lane & 32) != 0, h4 = (lane & 16) != 0, h3 = (lane & 8) != 0, h2 = (lane & 4) != 0;
    float q8[8], q4[4], q2[2];
#pragma unroll
    for (int i = 0; i < 8; ++i) { const float snd = h5 ? p[i] : p[i + 8], kp = h5 ? p[i + 8] : p[i]; q8[i] = kp + __shfl_xor(snd, 32); }
#pragma unroll
    for (int i = 0; i < 4; ++i) { const float snd = h4 ? q8[i] : q8[i + 4], kp = h4 ? q8[i + 4] : q8[i]; q4[i] = kp + __shfl_xor(snd, 16); }
#pragma unroll
    for (int i = 0; i < 2; ++i) { const float snd = h3 ? q4[i] : q4[i + 2], kp = h3 ? q4[i + 2] : q4[i]; q2[i] = kp + DPPF(snd, 0x128); }
    float q1; { const float snd = h2 ? q2[0] : q2[1], kp = h2 ? q2[1] : q2[0]; q1 = kp + __shfl_xor(snd, 4); }
    q1 += DPPF(q1, 0x4E); q1 += DPPF(q1, 0xB1);
    return q1;
}
__device__ __forceinline__ float reduce_scatter4(const float (&p)[4], int lane) {
    const bool h5 = (lane & 32) != 0, h4 = (lane & 16) != 0;
    float q2[2];
#pragma unroll
    for (int i = 0; i < 2; ++i) { const float snd = h5 ? p[i] : p[i + 2], kp = h5 ? p[i + 2] : p[i]; q2[i] = kp + __shfl_xor(snd, 32); }
    float q1; { const float snd = h4 ? q2[0] : q2[1], kp = h4 ? q2[1] : q2[0]; q1 = kp + __shfl_xor(snd, 16); }
    q1 += DPPF(q1, 0xB1); q1 += DPPF(q1, 0x4E); q1 += DPPF(q1, 0x141); q1 += DPPF(q1, 0x140);
    return q1;
}
__device__ __forceinline__ float reduce_scatter8(const float (&p)[8], int lane) {
    const bool h5 = (lane & 32) != 0, h4 = (lane & 16) != 0, h3 = (lane & 8) != 0;
    float q4[4], q2[2];
#pragma unroll
    for (int i = 0; i < 4; ++i) { const float snd = h5 ? p[i] : p[i + 4], kp = h5 ? p[i + 4] : p[i]; q4[i] = kp + __shfl_xor(snd, 32); }
#pragma unroll
    for (int i = 0; i < 2; ++i) { const float snd = h4 ? q4[i] : q4[i + 2], kp = h4 ? q4[i + 2] : q4[i]; q2[i] = kp + __shfl_xor(snd, 16); }
    float q1; { const float snd = h3 ? q2[0] : q2[1], kp = h3 ? q2[1] : q2[0]; q1 = kp + DPPF(snd, 0x128); }
    q1 += DPPF(q1, 0xB1); q1 += DPPF(q1, 0x4E); q1 += DPPF(q1, 0x141);
    return q1;
}
__device__ __forceinline__ void route_rows16(const LAS float* lg, const float (&rb)[16], LAS unsigned* dec16, int lane) {
    const int r = lane & 15;
    float sel[16], sc[16];
#pragma unroll
    for (int q = 0; q < 4; ++q) { const f32x4 v = *(const LAS f32x4*)(lg + r * 16 + 4 * q);
        sc[4 * q] = frcp(1.f + __expf(-v.x)); sc[4 * q + 1] = frcp(1.f + __expf(-v.y)); sc[4 * q + 2] = frcp(1.f + __expf(-v.z)); sc[4 * q + 3] = frcp(1.f + __expf(-v.w)); }
#pragma unroll
    for (int e = 0; e < 16; ++e) sel[e] = sc[e] + rb[e];
    float bestv = -INFINITY, w1 = 0.f, w2 = 0.f; int e1 = 0, e2 = 1;
#pragma unroll
    for (int gi = 0; gi < 4; ++gi) {
        float m1 = sel[4 * gi], s1 = sc[4 * gi]; int i1 = 0;
#pragma unroll
        for (int i = 1; i < 4; ++i) if (sel[4 * gi + i] > m1) { m1 = sel[4 * gi + i]; s1 = sc[4 * gi + i]; i1 = i; }
        float m2 = -INFINITY, s2v = 0.f; int i2 = 0;
#pragma unroll
        for (int i = 0; i < 4; ++i) if (i != i1 && sel[4 * gi + i] > m2) { m2 = sel[4 * gi + i]; s2v = sc[4 * gi + i]; i2 = i; }
        const float gs = m1 + m2;
        if (gs > bestv) { bestv = gs; e1 = 4 * gi + i1; e2 = 4 * gi + i2; w1 = s1; w2 = s2v; }
    }
    const float wn = 1.f / (w1 + w2);
    if (lane < 16) { u32x4 d; d.x = (unsigned)e1; d.y = (unsigned)e2; d.z = __float_as_uint(w1 * wn); d.w = __float_as_uint(w2 * wn); *(LAS u32x4*)(dec16 + r * 4) = d; }
}
__device__ __forceinline__ void ln_row(const unsigned (&h)[4], const u32x2 (&x)[4], const f32x4 (&gv)[4], const f32x4 (&bv)[4], f32x4 (&v)[4]) {
    float s = 0.f;
#pragma unroll
    for (int j = 0; j < 4; ++j) { v[j] = join_fp8(x[j].x, x[j].y) * ALPHA + dec_fp8x4(h[j]) * 0.015625f;
        s += (v[j].x + v[j].y) + (v[j].z + v[j].w); }
    const float mean = wave_sum(s) * (1.f / DM); float s2 = 0.f;
#pragma unroll
    for (int j = 0; j < 4; ++j) { v[j] = v[j] - mean; s2 += (v[j].x * v[j].x + v[j].y * v[j].y) + (v[j].z * v[j].z + v[j].w * v[j].w); }
    const float rstd = __builtin_amdgcn_rsqf(wave_sum(s2) * (1.f / DM) + LN_EPS);
#pragma unroll
    for (int j = 0; j < 4; ++j) v[j] = v[j] * rstd * gv[j] + bv[j];
}
__device__ __forceinline__ void p4_ln_route(const Ctx& C, LAS unsigned char* lds, int l, int tid, int wave, int lane) {
    LAS float* wr = (LAS float*)lds;
    constexpr int WRP = DM + 4;
    LAS unsigned* dec = (LAS unsigned*)(lds + 66048);
    LAS unsigned* posb = (LAS unsigned*)(lds + 66048 + 2048);
    LAS float* lgw = (LAS float*)(lds + 66048 + 4096) + wave * 256;
    for (int i = tid; i < DM * NE; i += NTHR) { const int d = i >> 4, e = i & 15; wr[e * WRP + d] = C.w_router[i]; }
    f32x4 gv[4], bv[4];
#pragma unroll
    for (int j = 0; j < 4; ++j) { gv[j] = *((const f32x4*)(C.ln1g + l * DM) + lane + 64 * j); bv[j] = *((const f32x4*)(C.ln1b + l * DM) + lane + 64 * j); }
    unsigned* cntl = C.ctl + CW_CNT + (l + C.rep * DEPTH) * 16 * 64;
    __syncthreads();
    for (int blk = C.vcu; blk < NTOK / 128; blk += C.G) {
        const size_t rowb = (size_t)blk * 128 + wave * 16;
        const unsigned char* hp8 = (const unsigned char*)C.hpre; unsigned char* xlo = (unsigned char*)C.xb;
#define P4_LOAD4(H, X, R0) do { _Pragma("unroll") for (int r_ = 0; r_ < 4; ++r_) { const size_t rr_ = (R0) + r_; _Pragma("unroll") for (int j = 0; j < 4; ++j) { \
            H[r_][j] = ((const unsigned*)(hp8 + rr_ * DM) + lane)[64 * j]; X[r_][j].x = ((const unsigned*)(C.xb8 + rr_ * DM) + lane)[64 * j]; X[r_][j].y = ((const unsigned*)(xlo + rr_ * DM) + lane)[64 * j]; } } } while (0)
        unsigned hA[4][4]; u32x2 xA[4][4];
        P4_LOAD4(hA, xA, rowb);
#pragma unroll 1
        for (int st = 0; st < 4; ++st) {
            const size_t row = rowb + 4 * st;
            unsigned hN[4][4]; u32x2 xN[4][4];
            if (st < 3) P4_LOAD4(hN, xN, row + 4);
            f32x4 v[4][4];
#pragma unroll
            for (int r = 0; r < 4; ++r) {
                ln_row(hA[r], xA[r], gv, bv, v[r]);
                unsigned* xl = (unsigned*)(xlo + (row + r) * DM) + lane; unsigned* x8 = (unsigned*)(C.xb8 + (row + r) * DM) + lane;
#pragma unroll
                for (int j = 0; j < 4; ++j) { unsigned hi, lo; split_fp8(v[r][j], hi, lo); x8[64 * j] = hi; xl[64 * j] = lo; }
            }
#pragma unroll
            for (int eh = 0; eh < 4; ++eh) {
                float p[4][4];
#pragma unroll
                for (int e8 = 0; e8 < 4; ++e8) {
                    f32x4 w[4];
#pragma unroll
                    for (int j = 0; j < 4; ++j) w[j] = *((const LAS f32x4*)(wr + (4 * eh + e8) * WRP) + lane + 64 * j);
#pragma unroll
                    for (int r = 0; r < 4; ++r) { f32x2 a = {0.f, 0.f};
#pragma unroll
                        for (int j = 0; j < 4; ++j) { a = __builtin_elementwise_fma((f32x2){v[r][j].x, v[r][j].y}, (f32x2){w[j].x, w[j].y}, a); a = __builtin_elementwise_fma((f32x2){v[r][j].z, v[r][j].w}, (f32x2){w[j].z, w[j].w}, a); }
                        p[r][e8] = a.x + a.y; }
                }
#pragma unroll
                for (int r = 0; r < 4; ++r) { const float q = reduce_scatter4(p[r], lane);
                    if ((lane & 15) == 0) lgw[(4 * st + r) * 16 + 4 * eh + (lane >> 4)] = q; }
                __builtin_amdgcn_sched_barrier(0);
            }
#pragma unroll
            for (int r = 0; r < 4; ++r)
#pragma unroll
                for (int j = 0; j < 4; ++j) { hA[r][j] = hN[r][j]; xA[r][j] = xN[r][j]; }
        }
#undef P4_LOAD4
        float rb[16];
#pragma unroll
        for (int e = 0; e < 16; ++e) rb[e] = C.rbias[e];
        route_rows16(lgw, rb, dec + wave * 16 * 4, lane);
        __syncthreads();
        if (wave == 0) {
            unsigned ea[4], rk[4]; unsigned tot = 0;
#pragma unroll
            for (int i = 0; i < 4; ++i) { const int a = lane + 64 * i; ea[i] = dec[(a >> 1) * 4 + (a & 1)]; rk[i] = 0; }
#pragma unroll
            for (int e = 0; e < 16; ++e) {
                unsigned run = 0;
#pragma unroll
                for (int i = 0; i < 4; ++i) { const unsigned long long m = __ballot(ea[i] == (unsigned)e);
                    const unsigned below = __builtin_amdgcn_mbcnt_hi((unsigned)(m >> 32), __builtin_amdgcn_mbcnt_lo((unsigned)m, 0u));
                    if (ea[i] == (unsigned)e) rk[i] = run + below;
                    run += (unsigned)__popcll(m); }
                if (lane == e) tot = run;
            }
            unsigned base = 0;
            if (lane < 16) base = tot ? atomicAdd(cntl + 64 * lane, tot) : 0u;
#pragma unroll
            for (int i = 0; i < 4; ++i) { const unsigned bs = __shfl(base, (int)ea[i]); const unsigned pos = bs + rk[i]; const int a = lane + 64 * i;
                posb[a] = pos; C.list[(size_t)ea[i] * LCAP + pos] = blk * 128 + (a >> 1); }
        }
        __syncthreads();
        if (tid < 128) { u32x4 rec; rec.x = (dec[tid * 4] << 16) | posb[tid * 2]; rec.y = (dec[tid * 4 + 1] << 16) | posb[tid * 2 + 1]; rec.z = dec[tid * 4 + 2]; rec.w = dec[tid * 4 + 3];
            C.tokrec[(size_t)blk * 128 + tid] = rec; }
        __syncthreads();
    }
}

__device__ __forceinline__ void moe_prefix(const Ctx& C, LAS int* tb, int l, int tid) {
    if (tid == 0) {
        unsigned* cntl = C.ctl + CW_CNT + l * 16 * 64; int acc = 0;
        for (int e = 0; e < 16; ++e) { const int c = (int)__hip_atomic_load(cntl + 64 * e, __ATOMIC_RELAXED, __HIP_MEMORY_SCOPE_AGENT); tb[e] = acc; tb[17 + e] = c; acc += (c + 255) >> 8; }
        tb[16] = acc;
    }
    __syncthreads();
}

__device__ __forceinline__ void p7_combine(const Ctx& C, LAS unsigned char* lds, int l, int tid, int wave, int lane) {
    LAS int* tb = (LAS int*)lds;
    moe_prefix(C, tb, l, tid);
    f32x4 gv[4], bv[4];
#pragma unroll
    for (int j = 0; j < 4; ++j) { gv[j] = *((const f32x4*)(C.ln2g + l * DM) + lane + 64 * j); bv[j] = *((const f32x4*)(C.ln2b + l * DM) + lane + 64 * j); }
    const bool lastl = (l == DEPTH - 1);
    for (int r0 = (C.vcu * NWAVES + wave) * 16; r0 < NTOK; r0 += C.G * NWAVES * 16) {
        u32x4 rec = C.tokrec[r0 + (lane & 15)];
        const unsigned sa_l = (unsigned)tb[rec.x >> 16] * 256u + (rec.x & 0xffffu), sb_l = (unsigned)tb[rec.y >> 16] * 256u + (rec.y & 0xffffu);
#pragma unroll 1
        for (int bq = 0; bq < 2; ++bq) {
            u32x2 xv[8][4]; unsigned av[8][4], bw[8][4]; float wa[8], wb[8];
#pragma unroll
            for (int k = 0; k < 8; ++k) { const int idx = bq * 8 + k;
                const size_t sa = (size_t)__builtin_amdgcn_readlane(sa_l, idx), sb = (size_t)__builtin_amdgcn_readlane(sb_l, idx);
                wa[k] = __uint_as_float(__builtin_amdgcn_readlane(rec.z, idx)) * 0.0625f; wb[k] = __uint_as_float(__builtin_amdgcn_readlane(rec.w, idx)) * 0.0625f;
                const unsigned* xph = (const unsigned*)(C.xb8 + (size_t)(r0 + idx) * DM) + lane; const unsigned* xpl = (const unsigned*)((const unsigned char*)C.xb + (size_t)(r0 + idx) * DM) + lane; const unsigned* ya = (const unsigned*)((const unsigned char*)C.ys + sa * DM) + lane; const unsigned* yb = (const unsigned*)((const unsigned char*)C.ys + sb * DM) + lane;
#pragma unroll
                for (int j = 0; j < 4; ++j) { xv[k][j].x = xph[64 * j]; xv[k][j].y = xpl[64 * j]; av[k][j] = ya[64 * j]; bw[k][j] = yb[64 * j]; } }
#pragma unroll
            for (int k = 0; k < 8; ++k) { const int row = r0 + bq * 8 + k;
                f32x4 v[4]; float s = 0.f;
#pragma unroll
                for (int j = 0; j < 4; ++j) { const u32x2 x2 = xv[k][j];
                    const f32x2 al = __builtin_amdgcn_cvt_pk_f32_fp8((int)av[k][j], false), ah = __builtin_amdgcn_cvt_pk_f32_fp8((int)av[k][j], true);
                    const f32x2 bl = __builtin_amdgcn_cvt_pk_f32_fp8((int)bw[k][j], false), bh = __builtin_amdgcn_cvt_pk_f32_fp8((int)bw[k][j], true);
                    const f32x4 xr = join_fp8(x2.x, x2.y) * ALPHA;
                    v[j].x = xr.x + (al.x * wa[k] + bl.x * wb[k]); v[j].y = xr.y + (al.y * wa[k] + bl.y * wb[k]);
                    v[j].z = xr.z + (ah.x * wa[k] + bh.x * wb[k]); v[j].w = xr.w + (ah.y * wa[k] + bh.y * wb[k]);
                    s += (v[j].x + v[j].y) + (v[j].z + v[j].w); }
                const float mean = wave_sum(s) * (1.f / DM); float s2 = 0.f;
#pragma unroll
                for (int j = 0; j < 4; ++j) { v[j] = v[j] - mean; s2 += (v[j].x * v[j].x + v[j].y * v[j].y) + (v[j].z * v[j].z + v[j].w * v[j].w); }
                const float rstd = __builtin_amdgcn_rsqf(wave_sum(s2) * (1.f / DM) + LN_EPS);
                if (lastl) { f32x4* xo = (f32x4*)(C.xcur + (size_t)row * DM) + lane;
#pragma unroll
                    for (int j = 0; j < 4; ++j) xo[64 * j] = v[j] * rstd * gv[j] + bv[j]; }
                else { unsigned* xlo = (unsigned*)((unsigned char*)C.xb + (size_t)row * DM) + lane; unsigned* x8o = (unsigned*)(C.xb8 + (size_t)row * DM) + lane;
#pragma unroll
                    for (int j = 0; j < 4; ++j) { const f32x4 y = v[j] * rstd * gv[j] + bv[j]; unsigned hi, lo; split_fp8(y, hi, lo); x8o[64 * j] = hi; xlo[64 * j] = lo; } }
            }
        }
    }
}

template <class T> __device__ __forceinline__ T* as_g(T* p) { return (T*)(GAS T*)p; }
typedef const __attribute__((address_space(4))) Args* KArgs;
__device__ __forceinline__ Ctx make_ctx(KArgs ap) {
    asm volatile("" : "+s"(ap));
    Ctx C;
    C.x = as_g(ap->in[0]); C.mem = as_g(ap->in[1]); C.w_in = as_g(ap->in[2]); C.b_in = as_g(ap->in[3]); C.w_mem_kv = as_g(ap->in[4]); C.sinks = as_g(ap->in[5]); C.rel_bias = as_g(ap->in[6]); C.lb_logits = as_g(ap->in[7]);
    C.hnorm = as_g(ap->in[8]); C.w_out = as_g(ap->in[9]); C.ln1g = as_g(ap->in[10]); C.ln1b = as_g(ap->in[11]); C.w_router = as_g(ap->in[12]); C.rbias = as_g(ap->in[13]); C.w_gate = as_g(ap->in[14]); C.w_up = as_g(ap->in[15]);
    C.w_down = as_g(ap->in[16]); C.ln2g = as_g(ap->in[17]); C.ln2b = as_g(ap->in[18]);
    unsigned char* ws = as_g(ap->ws);
    C.xcur = as_g(ap->out); C.ws = ws; C.ctl = (unsigned*)(ws + WS_CTL);
    C.Win = (bf16*)(ws + WS_WIN); C.Wout = (bf16*)(ws + WS_WOUT); C.Wmem = (bf16*)(ws + WS_WMEM); C.W1 = (bf16*)(ws + WS_W1); C.W2 = (bf16*)(ws + WS_W2);
    C.xb = (bf16*)(ws + WS_XB); C.proj = (bf16*)(ws + WS_BIG); C.hpre = (bf16*)(ws + WS_BIG); C.ys = (bf16*)(ws + WS_BIG);
    C.mix = (bf16*)(ws + WS_MIX); C.hmid = (bf16*)(ws + WS_MIX); C.memkv = (bf16*)(ws + WS_MEMKV); C.memb = (bf16*)(ws + WS_MEMB);
    C.biastab = (float*)(ws + WS_TAB); C.lbtab = (float*)(ws + WS_TAB + 4096); C.list = (int*)(ws + WS_LIST); C.tokrec = (u32x4*)(ws + WS_TOKREC); C.hst = (float*)(ws + WS_HST); C.xb8 = ws + WS_XB8;
    C.rep = ap->rep; C.G = gridDim.x; { const int bx = blockIdx.x; C.vcu = (C.G % 8 == 0) ? (bx % 8) * (C.G / 8) + bx / 8 : bx; }
    return C;
}
constexpr int PH_PER_LAYER = 7, N_PHASES = 1 + DEPTH * PH_PER_LAYER;
__global__ void __launch_bounds__(NTHR, 2) trunk_fwd(Args args) {
    extern __shared__ __attribute__((aligned(16))) unsigned char lds_raw[];
    LAS unsigned char* lds = (LAS unsigned char*)lds_raw;
    volatile LAS unsigned* MISC = (volatile LAS unsigned*)(lds + MISC_OFF);
    const int tid0 = threadIdx.x; const int wave0 = __builtin_amdgcn_readfirstlane(tid0 >> 6);
    for (int u = tid0; u < (LDS_BYTES - LDSCTL_OFF) / 4; u += NTHR) ((LAS unsigned*)(lds + LDSCTL_OFF))[u] = 0u;
    __syncthreads();
    KArgs ap = (KArgs)__builtin_amdgcn_kernarg_segment_ptr();
    XcdBarrier bar; bar.bar = (unsigned*)(as_g(args.ws) + WS_CTL) + CW_BAR; bar.x = 0; bar.st = nullptr;
    if (args.use_bar) bar = xcd_barrier_post((unsigned*)(as_g(args.ws) + WS_CTL) + CW_BAR, MISC + 8);
    const int lo = args.ph_lo, hi = args.ph_hi;
#define IN(k) (lo <= (k) && (k) < hi)
#define PHASE_IDS unsigned ones_ = ~0u; asm volatile("" : "+s"(ones_)); int lane = (int)__builtin_amdgcn_mbcnt_hi(ones_, __builtin_amdgcn_mbcnt_lo(ones_, 0u)); asm volatile("" : "+v"(lane)); int wave = wave0; asm volatile("" : "+s"(wave)); const int tid = wave * 64 + lane; (void)tid
#define SEAM(k) do { if (IN(k) && IN((k) + 1)) { XcdBarrier b2_ = bar; unsigned z_ = 0u; asm volatile("" : "+s"(z_)); b2_.bar = bar.bar + z_; xcd_barrier(b2_); } } while (0)

    if (IN(0)) { PHASE_IDS; const Ctx C = make_ctx(ap); p0_prologue(C, lds, wave, lane); }
    SEAM(0);
#pragma unroll 1
    for (int l = 0; l < DEPTH; ++l) {
        const int pb = 1 + l * PH_PER_LAYER;
        if (IN(pb + 0)) {
            PHASE_IDS; const Ctx C = make_ctx(ap);
            DenseSched S; S.A0 = (const char*)C.xb8; S.B0 = (const char*)C.Win + (size_t)l * INW * DM; S.nM0 = NTOK / 256; S.nN0 = INW / 256; S.K0 = DM  ;
            S.A1 = (const char*)C.memb; S.B1 = (const char*)C.Wmem; S.nM1 = (l == 0) ? (NB * MEMLEN) / 256 : 0; S.nN1 = 2048 / 256; S.G = C.G; S.c = (int)blockIdx.x;
            EpiProj E{(unsigned char*)C.proj, C.b_in + l * INW, (unsigned char*)C.memkv};
            pg8::gemm_phase<EpiProj, DenseSched, true>(lds, tid, DM, S, E);
        }
        SEAM(pb + 0);
        if (IN(pb + 1)) { PHASE_IDS; const Ctx C = make_ctx(ap); mixer_phase(C, lds, l, tid, wave, lane); }
        SEAM(pb + 1);
        if (IN(pb + 2)) {
            PHASE_IDS; const Ctx C = make_ctx(ap);
            DenseSched S; S.A0 = (const char*)C.mix; S.B0 = (const char*)C.Wout + (size_t)l * DM * MIXW; S.nM0 = NTOK / 256; S.nN0 = DM / 256; S.K0 = MIXW  ;
            S.A1 = nullptr; S.B1 = nullptr; S.nM1 = 0; S.nN1 = 0; S.G = C.G; S.c = (int)blockIdx.x;
            EpiOut E{(unsigned char*)C.hpre};
            pg8::gemm_phase<EpiOut, DenseSched, true>(lds, tid, MIXW, S, E);
        }
        SEAM(pb + 2);
        if (IN(pb + 3)) { PHASE_IDS; const Ctx C = make_ctx(ap); p4_ln_route(C, lds, l, tid, wave, lane); }
        SEAM(pb + 3);
        if (IN(pb + 4)) {
            PHASE_IDS; const Ctx C = make_ctx(ap);
            LAS int* tb = (LAS int*)(lds + LDSCTL_OFF + 64);
            moe_prefix(C, tb, l, tid);
            const int U = tb[16] * 4;
            MoeSched<true> S; S.A = (const char*)C.xb8; S.Bl = (const char*)C.W1 + (size_t)l * NE * 1024 * DM; S.K = DM  ; S.bstride = (size_t)1024 * DM; S.list = C.list; S.tb = tb;
            S.mode = 0; S.g0 = C.vcu; S.g1 = C.G; S.gU = U < 1024 ? U : 1024;
            EpiG1 E{(unsigned char*)C.hmid};
            pg8::gemm_phase<EpiG1, MoeSched<true>, true>(lds, tid, DM, S, E);
        }
        SEAM(pb + 4);
        if (IN(pb + 5)) {
            PHASE_IDS; const Ctx C = make_ctx(ap);
            LAS int* tb = (LAS int*)(lds + LDSCTL_OFF + 64);
            moe_prefix(C, tb, l, tid);
            const int U = tb[16] * 4, Etail = U > 1024 ? U - 1024 : 0;
            if (C.vcu < Etail) {
                MoeSched<true> S; S.A = (const char*)C.xb8; S.Bl = (const char*)C.W1 + (size_t)l * NE * 1024 * DM; S.K = DM  ; S.bstride = (size_t)1024 * DM; S.list = C.list; S.tb = tb;
                S.mode = 0; S.g0 = 1024 + C.vcu; S.g1 = 1 << 20; S.gU = 1024 + C.vcu + 1;
                EpiG1 E{(unsigned char*)C.hmid};
                pg8::gemm_phase<EpiG1, MoeSched<true>, true>(lds, tid, DM, S, E);
                asm volatile("s_waitcnt vmcnt(0)" ::: "memory");
                __syncthreads();
                if (tid == 0) {
                    unsigned* cnt = C.ctl + CW_TILE + (l * 16 + (C.vcu >> 2)) * 64; unsigned sp = 0;
                    __builtin_amdgcn_fence(__ATOMIC_RELEASE, "agent");
                    asm volatile("s_waitcnt vmcnt(0)" ::: "memory");
                    __hip_atomic_fetch_add(cnt, 1u, __ATOMIC_RELAXED, __HIP_MEMORY_SCOPE_AGENT);
                    while (__hip_atomic_load(cnt, __ATOMIC_RELAXED, __HIP_MEMORY_SCOPE_AGENT) < 4u) { __builtin_amdgcn_s_sleep(2); if (++sp > (1u << 24)) break; }
                    __builtin_amdgcn_fence(__ATOMIC_ACQUIRE, "agent");
                    asm volatile("s_waitcnt vmcnt(0)" ::: "memory");
                }
                __syncthreads();
            }
            MoeSched<false> S; S.A = (const char*)C.hmid; S.Bl = (const char*)C.W2 + (size_t)l * NE * DM * DE; S.K = DE  ; S.bstride = (size_t)DM * DE; S.list = C.list; S.tb = tb;
            S.mode = 1; S.g0 = C.vcu; S.g1 = Etail; S.gU = U < 1024 ? U : 1024;
            EpiG2 E{(unsigned char*)C.ys};
            pg8::gemm_phase<EpiG2, MoeSched<false>, true>(lds, tid, DE, S, E);
        }
        SEAM(pb + 5);
        if (IN(pb + 6)) { PHASE_IDS; const Ctx C = make_ctx(ap); p7_combine(C, lds, l, tid, wave, lane); }
        SEAM(pb + 6);
    }
#undef IN
#undef SEAM
}

#ifndef ONE_LAUNCH
#define ONE_LAUNCH 1
#endif
extern "C" void kernel_launch(void* const* d_in, const int* in_sizes, int n_in, void* d_out, int out_size, void* d_ws, size_t ws_size, hipStream_t stream) {
    static int grid = 0;
    if (grid == 0) {
        if (n_in != 19 || in_sizes[0] != NTOK * DM || out_size != NTOK * DM || ws_size < WS_END) {
            fprintf(stderr, "kernel_launch: unexpected shapes (n_in %d, in0 %d, out %d, ws %zu < %zu); nothing launched\n", n_in, n_in > 0 ? in_sizes[0] : -1, out_size, ws_size, (size_t)WS_END); grid = -1; return; }
        int dev = 0, cus = 0, per_cu = 0;
        if (hipGetDevice(&dev) != hipSuccess || hipDeviceGetAttribute(&cus, hipDeviceAttributeMultiprocessorCount, dev) != hipSuccess) { grid = -1; return; }
        if (hipFuncSetAttribute((const void*)trunk_fwd, hipFuncAttributeMaxDynamicSharedMemorySize, LDS_BYTES) != hipSuccess) { fprintf(stderr, "kernel_launch: hipFuncSetAttribute failed\n"); grid = -1; return; }
        if (hipOccupancyMaxActiveBlocksPerMultiprocessor(&per_cu, (const void*)trunk_fwd, NTHR, LDS_BYTES) != hipSuccess || per_cu < 1) { fprintf(stderr, "kernel_launch: occupancy query says %d\n", per_cu); }
        (void)hipGetLastError();
        grid = cus;
        fprintf(stderr, "kernel_launch: grid %d, occupancy/CU %d, ws %zu\n", grid, per_cu, ws_size);
    }
    if (grid < 0) return;
    (void)hipMemsetAsync((char*)d_ws + WS_CTL, 0, CTL_ZERO_BYTES, stream);
    Args a{};
    for (int i = 0; i < 19; ++i) a.in[i] = (const float*)d_in[i];
    a.out = (float*)d_out; a.ws = (unsigned char*)d_ws;
#if ONE_LAUNCH
    a.ph_lo = 0; a.ph_hi = N_PHASES; a.use_bar = 1;
    void* kargs[] = {&a};
    hipError_t e = hipLaunchCooperativeKernel((const void*)trunk_fwd, dim3(grid), dim3(NTHR), kargs, LDS_BYTES, stream);
    if (e != hipSuccess) fprintf(stderr, "kernel_launch: cooperative launch failed: %s\n", hipGetErrorString(e));
#else
    for (int p = 0; p < N_PHASES; ++p) {
        a.ph_lo = p; a.ph_hi = p + 1; a.use_bar = 0;
        hipLaunchKernelGGL(trunk_fwd, dim3(grid), dim3(NTHR), LDS_BYTES, stream, a);
    }
#endif
}
```

```cpp
#include <hip/hip_runtime.h>
#include <cstdio>
#include <cstdint>

#define LAS __attribute__((address_space(3)))
#define GAS __attribute__((address_space(1)))
typedef unsigned short bf16;
typedef short bf16x8 __attribute__((ext_vector_type(8)));
typedef short s16x4 __attribute__((ext_vector_type(4)));
typedef float f32x4 __attribute__((ext_vector_type(4)));
typedef float f32x2 __attribute__((ext_vector_type(2)));
typedef unsigned u32x4 __attribute__((ext_vector_type(4)));
typedef unsigned u32x2 __attribute__((ext_vector_type(2)));
typedef int i32x4 __attribute__((ext_vector_type(4)));
typedef int i32x8 __attribute__((ext_vector_type(8)));
typedef __bf16 bf16x2_t __attribute__((ext_vector_type(2)));

constexpr int NB = 8, SEQ = 4096, DM = 1024, NTOK = NB * SEQ, DEPTH = 4;
constexpr int INW = 2048, MIXW = 1024, NE = 16, DE = 512, MEMLEN = 256;
constexpr int C_SQ = 0, C_SK = 512, C_SV = 640, C_HQ = 768, C_HF = 1024, C_HI = 1280, C_HG = 1536, C_MQ = 1792;
constexpr float ALPHA = 1.6817928305074290f;
constexpr float LN_EPS = 1e-5f, RMS_EPS = 1e-6f;
constexpr int NSEG = 32, CPS = (SEQ / 16) / NSEG;
constexpr int LCAP = 32768;
constexpr int MAXTILES = NTOK * 2 / 256 + NE;
constexpr int NWAVES = 8, NTHR = 512;

constexpr size_t MiB = 1u << 20;
constexpr size_t WS_CTL = 0, CTL_ZERO_BYTES = 1 * MiB;
constexpr size_t WS_TAB = 1 * MiB;
constexpr size_t WS_WIN = 2 * MiB;
constexpr size_t WS_WOUT = 18 * MiB;
constexpr size_t WS_WMEM = 26 * MiB;
constexpr size_t WS_W1 = 30 * MiB;
constexpr size_t WS_XB8 = 94 * MiB;
constexpr size_t WS_W2 = 158 * MiB;
constexpr size_t WS_XB = 222 * MiB;
constexpr size_t WS_BIG = 286 * MiB;
constexpr size_t WS_MIX = 430 * MiB;
constexpr size_t WS_MEMKV = 502 * MiB;
constexpr size_t WS_MEMB = 510 * MiB;
constexpr size_t WS_LIST = 514 * MiB;
constexpr size_t WS_TOKREC = 516 * MiB;
constexpr size_t WS_HST = 517 * MiB;
constexpr size_t WS_END = 538 * MiB;
constexpr int CW_BAR = 4096;
constexpr int CW_CNT = 16384;
constexpr int CW_QUEUE = 32768;
constexpr int CW_TILE = 57344;
constexpr int CW_HA = 49152;

constexpr int RING_BYTES = 131072;
constexpr int LDSCTL_OFF = RING_BYTES, MISC_OFF = LDSCTL_OFF + 320;
constexpr int LDS_BYTES = 147456;

__device__ __forceinline__ unsigned pk2(float lo, float hi) { f32x2 v = {lo, hi}; bf16x2_t b = __builtin_convertvector(v, bf16x2_t); return __builtin_bit_cast(unsigned, b); }
__device__ __forceinline__ unsigned pk_fp8x4(f32x4 v) { int w = __builtin_amdgcn_cvt_pk_fp8_f32(v.x, v.y, 0, false); w = __builtin_amdgcn_cvt_pk_fp8_f32(v.z, v.w, w, true); return (unsigned)w; }
__device__ __forceinline__ f32x4 dec_fp8x4(unsigned w) { const f32x2 a = __builtin_amdgcn_cvt_pk_f32_fp8((int)w, false), b = __builtin_amdgcn_cvt_pk_f32_fp8((int)w, true); return (f32x4){a.x, a.y, b.x, b.y}; }
__device__ __forceinline__ void split_fp8(f32x4 y, unsigned& hi, unsigned& lo) { const f32x4 y8 = y * 8.f; hi = pk_fp8x4(y8); lo = pk_fp8x4((y8 - dec_fp8x4(hi)) * 16.f); }
__device__ __forceinline__ f32x4 join_fp8(unsigned hi, unsigned lo) { return dec_fp8x4(hi) * 0.125f + dec_fp8x4(lo) * 0.0078125f; }
__device__ __forceinline__ u32x4 fp8x8_to_bf16x8(u32x2 w) { const f32x4 a = dec_fp8x4(w.x), b = dec_fp8x4(w.y); u32x4 o; o.x = pk2(a.x, a.y); o.y = pk2(a.z, a.w); o.z = pk2(b.x, b.y); o.w = pk2(b.z, b.w); return o; }
__device__ __forceinline__ float frcp(float x) { return __builtin_amdgcn_rcpf(x); }
__device__ __forceinline__ float bflo(unsigned w) { return __uint_as_float(w << 16); }
__device__ __forceinline__ float bfhi(unsigned w) { return __uint_as_float(w & 0xffff0000u); }
#define DPPF(v, ctrl) __int_as_float(__builtin_amdgcn_update_dpp(0, __float_as_int(v), (ctrl), 0xf, 0xf, true))
__device__ __forceinline__ float wave_sum(float v) {
    v += DPPF(v, 0xB1);
    v += DPPF(v, 0x4E);
    v += DPPF(v, 0x141);
    v += DPPF(v, 0x140);
    v += __shfl_xor(v, 16); v += __shfl_xor(v, 32);
    return v;
}
__device__ __forceinline__ s16x4 ld_tr(const LAS unsigned char* p) { return __builtin_amdgcn_ds_read_tr16_b64_v4i16((LAS s16x4*)p); }
__device__ __forceinline__ float row_scan16(float x) {
    x += __int_as_float(__builtin_amdgcn_update_dpp(0, __float_as_int(x), 0x111, 0xf, 0xf, true));
    x += __int_as_float(__builtin_amdgcn_update_dpp(0, __float_as_int(x), 0x112, 0xf, 0xf, true));
    x += __int_as_float(__builtin_amdgcn_update_dpp(0, __float_as_int(x), 0x114, 0xf, 0xf, true));
    x += __int_as_float(__builtin_amdgcn_update_dpp(0, __float_as_int(x), 0x118, 0xf, 0xf, true));
    return x;
}
__device__ __forceinline__ bf16x8 mk8(unsigned a, unsigned b, unsigned c, unsigned d) { u32x4 w = {a, b, c, d}; return __builtin_bit_cast(bf16x8, w); }
__device__ __forceinline__ s16x4 mk4(unsigned a, unsigned b) { u32x2 w = {a, b}; return __builtin_bit_cast(s16x4, w); }

namespace pg8 {
constexpr int BM = 256, BK = 64, HALF = 128, HTB = HALF * BK * 2, STAGE_BYTES = 8 * HTB, NXCD = 8, WGM = 8;
constexpr int NXT_SLOT_OFF = 131072 + 2048;
__host__ __device__ __forceinline__ int lds_byte(int r, int c) { const int st = (r >> 4) * 2 + (c >> 5), rr = r & 15, cc = c & 31, ob = rr * 64 + cc * 2; return st * 1024 + (ob ^ (((ob >> 9) & 1) << 5)); }
__host__ __device__ __forceinline__ void stage_rc(int b, int& R, int& C) { const int st = b / 1024, sb = b % 1024, swz = sb ^ (((sb >> 9) & 1) << 5); R = (st >> 1) * 16 + swz / 64; C = (st & 1) * 32 + (swz % 64) / 2; }
__host__ __device__ __forceinline__ int perm32(int rho) { const int n = rho >> 4, i = rho & 15; return 8 * (i >> 2) + 4 * n + (i & 3); }
__host__ __device__ __forceinline__ int perm256(int R) { const int bj = R >> 7, wc = (R >> 5) & 3, n = (R >> 4) & 1, i = R & 15; return 64 * wc + 16 * (i >> 2) + 8 * bj + 4 * n + (i & 3); }

struct Unit {
    const char* A;
    const char* B;
    unsigned a00, a01, a10, a11;
    int row0, col0, aux;
};
__device__ __forceinline__ void tile_order(int L, int nM, int nN, int& pm, int& pn) {
    const int nwg = nM * nN; int wgid = L;
    { const int q = nwg / NXCD, r = nwg % NXCD, xcd = wgid % NXCD, off = wgid / NXCD; wgid = (xcd < r ? xcd * (q + 1) : r * (q + 1) + (xcd - r) * q) + off; }
    const int nig = WGM * nN, gid = wgid / nig, fm = gid * WGM, gsz = (nM - fm) < WGM ? (nM - fm) : WGM;
    pm = fm + ((wgid % nig) % gsz); pn = (wgid % nig) / gsz;
}

template <class Epi, class Sched, bool ALIGN_EPI>
__device__ __forceinline__ void gemm_phase(LAS unsigned char* lds, const int tid, const int RB  , Sched& S, const Epi& E) {
    const int wid = __builtin_amdgcn_readfirstlane(tid >> 6), lane = tid & 63, wr = wid >> 2, wc = wid & 3, fr = lane & 15, fq = lane >> 4;
    const int nt = RB / 128;
    unsigned voffB[2], voffA[2] = {0u, 0u};
    {
        int Ra[2], Ca[2];
#pragma unroll
        for (int i = 0; i < 2; ++i) { int R, C; stage_rc(tid * 16 + i * 8192, R, C); const int Rb = Epi::PERM16 ? perm256(R) : (Epi::PERM ? ((R & ~31) + perm32(R & 31)) : R);
            Ra[i] = R; Ca[i] = C; voffB[i] = (unsigned)(Rb * RB + 2 * C); }
        S.lane_init(Ra[0], Ca[0], Ra[1], Ca[1]);
        if constexpr (!Sched::GATHER) { voffA[0] = (unsigned)(Ra[0] * RB + 2 * Ca[0]); voffA[1] = (unsigned)(Ra[1] * RB + 2 * Ca[1]); }
    }
    const size_t kstep = (size_t)(BK * 2);
    const size_t hstepB = (size_t)HALF * RB;
    const size_t hstepW = Epi::PERM16 ? (size_t)8 * RB : hstepB;
    const unsigned ldsw = (unsigned)wid * 1024u;
    const int aoff = lds_byte(wr * 64 + fr, fq * 8), boff = lds_byte(wc * 32 + fr, fq * 8);
#define PG8_SA(b, h) (((b) * 2 + (h)) * HTB)
#define PG8_SB(b, h) ((4 + (b) * 2 + (h)) * HTB)
#define PG8_STAGE_B(bufoff, gbase) do { _Pragma("unroll") for (int _i = 0; _i < 2; ++_i) \
        __builtin_amdgcn_global_load_lds((const unsigned*)((const char*)(gbase) + voffB[_i]), (LAS unsigned*)(lds + (bufoff) + ldsw + _i * 8192), 16, 0, 0); } while (0)
#define PG8_STAGE_A(bufoff, gbase, hf, o0, o1) do { if constexpr (Sched::GATHER) { \
        __builtin_amdgcn_global_load_lds((const unsigned*)((const char*)(gbase) + (o0)), (LAS unsigned*)(lds + (bufoff) + ldsw), 16, 0, 0); \
        __builtin_amdgcn_global_load_lds((const unsigned*)((const char*)(gbase) + (o1)), (LAS unsigned*)(lds + (bufoff) + ldsw + 8192), 16, 0, 0); } else { \
        __builtin_amdgcn_global_load_lds((const unsigned*)((const char*)(gbase) + (hf) * hstepB + voffA[0]), (LAS unsigned*)(lds + (bufoff) + ldsw), 16, 0, 0); \
        __builtin_amdgcn_global_load_lds((const unsigned*)((const char*)(gbase) + (hf) * hstepB + voffA[1]), (LAS unsigned*)(lds + (bufoff) + ldsw + 8192), 16, 0, 0); } } while (0)
#define PG8_LDA(dst, b, h) do { _Pragma("unroll") for (int m = 0; m < 4; ++m) { dst[m].lo = *(const LAS i32x4*)(lds + PG8_SA(b, h) + aoff + m * 2048); dst[m].hi = *(const LAS i32x4*)(lds + PG8_SA(b, h) + aoff + m * 2048 + 1024); } } while (0)
#define PG8_LDB(dst, b, h) do { _Pragma("unroll") for (int n = 0; n < 2; ++n) { dst[n].lo = *(const LAS i32x4*)(lds + PG8_SB(b, h) + boff + n * 2048); dst[n].hi = *(const LAS i32x4*)(lds + PG8_SB(b, h) + boff + n * 2048 + 1024); } } while (0)
#define PG8_MMA(ai, bj, At, Bt) do { __builtin_amdgcn_s_setprio(1); _Pragma("unroll") for (int m = 0; m < 4; ++m) _Pragma("unroll") for (int n = 0; n < 2; ++n) { \
        if constexpr (Epi::FP8) asm volatile("v_mfma_scale_f32_16x16x128_f8f6f4 %0, %1, %2, %0, %3, %4 op_sel_hi:[0,0,0]" : "+v"(acc[ai][bj][m][n]) : "v"(Bt[n]), "v"(At[m]), "v"(sclw_), "v"(scla_));   \
        else { const i32x4 bl_ = Bt[n].lo, bh_ = Bt[n].hi, al_ = At[m].lo, ah_ = At[m].hi;     \
               acc[ai][bj][m][n] = __builtin_amdgcn_mfma_f32_16x16x32_bf16(__builtin_bit_cast(bf16x8, bl_), __builtin_bit_cast(bf16x8, al_), acc[ai][bj][m][n], 0, 0, 0); \
               acc[ai][bj][m][n] = __builtin_amdgcn_mfma_f32_16x16x32_bf16(__builtin_bit_cast(bf16x8, bh_), __builtin_bit_cast(bf16x8, ah_), acc[ai][bj][m][n], 0, 0, 0); } } __builtin_amdgcn_s_setprio(0); } while (0)
#define PG8_WAIT_V(n) asm volatile("s_waitcnt vmcnt(" #n ")" ::: "memory")
#define PG8_WAIT_L(n) asm volatile("s_waitcnt lgkmcnt(" #n ")" ::: "memory")
#define PG8_BAR __builtin_amdgcn_s_barrier()
#define PG8_SCHED __builtin_amdgcn_sched_barrier(0)
    Unit cur, nxt; int ui = 0;
    if (!S.next(0, cur)) return;
    f32x4 acc[2][2][4][2];
#pragma unroll
    for (int a = 0; a < 2; ++a)
#pragma unroll
        for (int b = 0; b < 2; ++b)
#pragma unroll
            for (int m = 0; m < 4; ++m)
#pragma unroll
                for (int n = 0; n < 2; ++n) acc[a][b][m][n] = (f32x4){0.f, 0.f, 0.f, 0.f};
    i32x8 At[4], B0[2], B1[2];
    int sclw_ = Epi::SCALE_W, scla_ = Epi::SCALE_A; asm volatile("" : "+v"(sclw_), "+v"(scla_));
    PG8_STAGE_B(PG8_SB(0, 0), cur.B); PG8_STAGE_B(PG8_SB(0, 1), cur.B + hstepW); PG8_STAGE_A(PG8_SA(0, 0), cur.A, 0, cur.a00, cur.a01); PG8_STAGE_A(PG8_SA(0, 1), cur.A, 1, cur.a10, cur.a11);
    if (wr == 1) PG8_BAR;
    PG8_WAIT_V(2); PG8_BAR;
    PG8_STAGE_B(PG8_SB(1, 0), cur.B + kstep); PG8_STAGE_A(PG8_SA(1, 0), cur.A + kstep, 0, cur.a00, cur.a01); PG8_STAGE_B(PG8_SB(1, 1), cur.B + hstepW + kstep);
    PG8_WAIT_V(6); PG8_BAR;
    for (;;) {
        const bool has_next = S.next(ui + 1, nxt);
        const char* nA = has_next ? nxt.A : cur.A; const char* nB = has_next ? nxt.B : cur.B;
        if constexpr (Sched::GATHER) {
            u32x4 nv; nv.x = has_next ? nxt.a00 : cur.a00; nv.y = has_next ? nxt.a01 : cur.a01; nv.z = has_next ? nxt.a10 : cur.a10; nv.w = has_next ? nxt.a11 : cur.a11;
            *(LAS u32x4*)(lds + NXT_SLOT_OFF + tid * 16) = nv; nxt.a00 = 0u; nxt.a01 = 0u; nxt.a10 = 0u; nxt.a11 = 0u;
        }
#pragma unroll 1
        for (int t = 0; t < nt; t += 2) {
            const bool last = (t == nt - 2);
            const char* a1 = cur.A + (size_t)(t + 1) * kstep;
            const char* a2 = last ? nA : cur.A + (size_t)(t + 2) * kstep; const char* b2 = last ? nB : cur.B + (size_t)(t + 2) * kstep;
            const char* a3 = a2 + kstep; const char* b3 = b2 + kstep;
            unsigned x00 = cur.a00, x01 = cur.a01, x10 = cur.a10, x11 = cur.a11;
            if constexpr (Sched::GATHER) { if (last) { const u32x4 nv = *(const LAS u32x4*)(lds + NXT_SLOT_OFF + tid * 16); x00 = nv.x; x01 = nv.y; x10 = nv.z; x11 = nv.w; } }
            PG8_LDB(B0, 0, 0); PG8_LDB(B1, 0, 1); PG8_SCHED; PG8_LDA(At, 0, 0); PG8_STAGE_A(PG8_SA(1, 1), a1, 1, cur.a10, cur.a11);
            PG8_WAIT_V(8); PG8_WAIT_L(0); PG8_BAR; PG8_MMA(0, 0, At, B0); PG8_MMA(0, 1, At, B1); PG8_BAR; PG8_SCHED;
            PG8_LDA(At, 0, 1); PG8_STAGE_B(PG8_SB(0, 0), b2); PG8_STAGE_B(PG8_SB(0, 1), b2 + hstepW); PG8_STAGE_A(PG8_SA(0, 0), a2, 0, x00, x01);
            PG8_WAIT_V(8); PG8_WAIT_L(0); PG8_BAR; PG8_MMA(1, 0, At, B0); PG8_MMA(1, 1, At, B1); PG8_BAR; PG8_SCHED;
            PG8_LDB(B0, 1, 0); PG8_LDB(B1, 1, 1); PG8_SCHED; PG8_LDA(At, 1, 0); PG8_STAGE_A(PG8_SA(0, 1), a2, 1, x10, x11);
            PG8_WAIT_V(8); PG8_WAIT_L(0); PG8_BAR; PG8_MMA(0, 0, At, B0); PG8_MMA(0, 1, At, B1); PG8_BAR; PG8_SCHED;
            PG8_LDA(At, 1, 1); PG8_STAGE_B(PG8_SB(1, 0), b3); PG8_STAGE_B(PG8_SB(1, 1), b3 + hstepW); PG8_STAGE_A(PG8_SA(1, 0), a3, 0, x00, x01);
            PG8_WAIT_V(8); PG8_WAIT_L(0); PG8_BAR; PG8_MMA(1, 0, At, B0); PG8_MMA(1, 1, At, B1); PG8_BAR; PG8_SCHED;
        }
        if constexpr (Epi::FP8) asm volatile("s_nop 15\n\ts_nop 7" ::: "memory");
        if constexpr (ALIGN_EPI) { if (wr == 0) PG8_BAR; }
        E(acc, cur, wr, wc, fr, fq);
        if (!has_next) break;
#pragma unroll
        for (int a = 0; a < 2; ++a)
#pragma unroll
            for (int b = 0; b < 2; ++b)
#pragma unroll
                for (int m = 0; m < 4; ++m)
#pragma unroll
                    for (int n = 0; n < 2; ++n) acc[a][b][m][n] = (f32x4){0.f, 0.f, 0.f, 0.f};
        cur = nxt; ++ui;
        if constexpr (Sched::GATHER) { const u32x4 nv = *(const LAS u32x4*)(lds + NXT_SLOT_OFF + tid * 16); cur.a00 = nv.x; cur.a01 = nv.y; cur.a10 = nv.z; cur.a11 = nv.w; }
        if constexpr (ALIGN_EPI) { if (wr == 1) PG8_BAR; }
    }
    PG8_WAIT_V(0);
    if constexpr (!ALIGN_EPI) { if (wr == 0) PG8_BAR; }
    PG8_BAR;
#undef PG8_SA
#undef PG8_SB
#undef PG8_STAGE_A
#undef PG8_STAGE_B
#undef PG8_LDA
#undef PG8_LDB
#undef PG8_MMA
#undef PG8_WAIT_V
#undef PG8_WAIT_L
#undef PG8_BAR
#undef PG8_SCHED
}
}

#define XB_TMO      128
#define XB_XCNT(j)  (256  + 64 * (j))
#define XB_XSUB(j)  (1280 + 64 * (j))
#define XB_XGEN(j)  (2304 + 64 * (j))
#define XB_TOP      3328
#define XB_TOPGEN   3392
#define XCD_BAR_WORDS 3456
#define XB_SPIN_CAP (1u << 22)
__device__ __forceinline__ unsigned xb_ld(unsigned* p)              { return __hip_atomic_load(p, __ATOMIC_RELAXED, __HIP_MEMORY_SCOPE_AGENT); }
__device__ __forceinline__ unsigned xb_add(unsigned* p, unsigned v) { return __hip_atomic_fetch_add(p, v, __ATOMIC_RELAXED, __HIP_MEMORY_SCOPE_AGENT); }
__device__ __forceinline__ unsigned xb_xcc_id() { return (unsigned)__builtin_amdgcn_s_getreg((3 << 11) | 20) & 0xFu; }
#define XB_SPIN(cond, bar) do { unsigned _sp = 0; while (cond) { __builtin_amdgcn_s_sleep(1); \
    if ((++_sp & 255u) == 0u) { if (xb_ld(&(bar)[XB_TMO])) break; if (_sp > XB_SPIN_CAP) { atomicAdd(&(bar)[XB_TMO], 1u); break; } } } } while (0)
struct XcdBarrier { unsigned* bar; unsigned x; volatile LAS unsigned* st; };
__device__ __forceinline__ XcdBarrier xcd_barrier_post(unsigned* bar, volatile LAS unsigned* st) {
    XcdBarrier b; b.bar = bar; b.x = xb_xcc_id(); b.st = st;
    if (threadIdx.x == 0) (void)xb_add(&bar[XB_XCNT(b.x)], 1u);
    return b;
}
__device__ __forceinline__ void xcd_barrier_complete(unsigned* bar, unsigned x, unsigned& nloc, unsigned& nx) {
    const unsigned G = gridDim.x * gridDim.y * gridDim.z;
    unsigned sum, cnt, mine, sp = 0u;
    for (;;) {
        sum = 0u; cnt = 0u; mine = 0u;
#pragma unroll
        for (unsigned j = 0; j < 16; ++j) { const unsigned c = xb_ld(&bar[XB_XCNT(j)]); sum += c; cnt += (c > 0u) ? 1u : 0u; mine = (j == x) ? c : mine; }
        if (sum == G) break;
        __builtin_amdgcn_s_sleep(1);
        if ((++sp & 255u) == 0u) { if (xb_ld(&bar[XB_TMO])) break; if (sp > XB_SPIN_CAP) { atomicAdd(&bar[XB_TMO], 1u); break; } }
    }
    nloc = mine > 0u ? mine : 1u; nx = cnt > 0u ? cnt : 1u;
}
__device__ __forceinline__ void xcd_barrier(const XcdBarrier& b) {
    asm volatile("s_waitcnt vmcnt(0)" ::: "memory");
    __syncthreads();
    if (threadIdx.x == 0) {
        unsigned* bar = b.bar;
        __builtin_amdgcn_s_waitcnt(0);
        unsigned nloc = b.st[0], nx = b.st[1];
        if (nloc == 0u) { xcd_barrier_complete(bar, b.x, nloc, nx); b.st[0] = nloc; b.st[1] = nx; }
        const unsigned old = xb_add(&bar[XB_XSUB(b.x)], 1u);
        const unsigned gen = old / nloc;
        if (old + 1u == (gen + 1u) * nloc) {
            __builtin_amdgcn_fence(__ATOMIC_RELEASE, "agent");
            asm volatile("s_waitcnt vmcnt(0)" ::: "memory");
            const unsigned og = xb_add(&bar[XB_TOP], 1u);
            const unsigned tg = og / nx;
            if (og + 1u == (tg + 1u) * nx) xb_add(&bar[XB_TOPGEN], 1u);
            else XB_SPIN(xb_ld(&bar[XB_TOPGEN]) == tg, bar);
            __builtin_amdgcn_fence(__ATOMIC_ACQUIRE, "agent");
            xb_add(&bar[XB_XGEN(b.x)], 1u);
            asm volatile("s_waitcnt vmcnt(0)" ::: "memory");
        } else {
            XB_SPIN(xb_ld(&bar[XB_XGEN(b.x)]) == gen, bar);
            __builtin_amdgcn_fence(__ATOMIC_ACQUIRE, "agent");
            asm volatile("s_waitcnt vmcnt(0)" ::: "memory");
        }
    }
    __syncthreads();
}

struct Args {
    const float* in[19];
    float* out; unsigned char* ws;
    int ph_lo, ph_hi, use_bar, rep;
};
struct Ctx {
    const float *x, *mem, *w_in, *b_in, *w_mem_kv, *sinks, *rel_bias, *lb_logits, *hnorm, *w_out, *ln1g, *ln1b, *w_router, *rbias, *w_gate, *w_up, *w_down, *ln2g, *ln2b;
    float* xcur;
    unsigned char* ws;
    unsigned* ctl;
    bf16 *Win, *Wout, *Wmem, *W1, *W2, *xb, *proj, *ys, *mix, *hmid, *memkv, *memb;
    bf16* hpre; float* biastab; float* lbtab; int* list; u32x4* tokrec; float* hst; unsigned char* xb8;
    int vcu, G, rep;
};

__constant__ unsigned char T5_BUCKET[128] = {0, 1, 2, 3, 4, 5, 6, 7, 8, 9, 10, 11, 12, 13, 14, 15, 16, 16, 16, 17, 17, 18, 18, 18, 19, 19, 19, 20, 20, 20, 20, 21, 21, 21, 21, 22, 22, 22, 22, 22, 23, 23, 23, 23, 23, 23, 24, 24, 24, 24, 24, 24, 25, 25, 25, 25, 25, 25, 25, 26, 26, 26, 26, 26, 26, 26, 26, 27, 27, 27, 27, 27, 27, 27, 27, 27, 27, 28, 28, 28, 28, 28, 28, 28, 28, 28, 28, 29, 29, 29, 29, 29, 29, 29, 29, 29, 29, 29, 29, 30, 30, 30, 30, 30, 30, 30, 30, 30, 30, 30, 30, 30, 30, 31, 31, 31, 31, 31, 31, 31, 31, 31, 31, 31, 31, 31, 31, 31};

struct TrItem { const float* src; bf16* dst; int N, K; float fp8s; };
__device__ __forceinline__ bool p0_item(const Ctx& C, int it, TrItem& t) {
    constexpr int I_IN = DEPTH * 16 * 64, I_OUT = DEPTH * 16 * 32, I_MEM = DEPTH * 16 * 16, I_G = 64 * 16 * 16, I_D = 64 * 8 * 32;
    constexpr int NITEMS = I_IN + I_OUT + I_MEM + 2 * I_G + I_D;
    if (it >= NITEMS) return false;
    int r = it;
    if (r < I_IN) { const int l = r / 1024, q = r % 1024, kb = q / 64, nb = q % 64; t.fp8s = 32.f; t.N = INW; t.K = DM; t.src = C.w_in + (size_t)l * DM * INW + (size_t)(64 * kb) * INW + 32 * nb; t.dst = (bf16*)((unsigned char*)C.Win + (size_t)l * INW * DM + (size_t)(32 * nb) * DM + 64 * kb); return true; } r -= I_IN;
    if (r < I_OUT) { const int l = r / 512, q = r % 512, kb = q / 32, nb = q % 32; t.fp8s = 64.f; t.N = DM; t.K = MIXW; t.src = C.w_out + (size_t)l * MIXW * DM + (size_t)(64 * kb) * DM + 32 * nb; t.dst = (bf16*)((unsigned char*)C.Wout + (size_t)l * DM * MIXW + (size_t)(32 * nb) * MIXW + 64 * kb); return true; } r -= I_OUT;
    if (r < I_MEM) { const int l = r / 256, q = r % 256, kb = q / 16, nb = q % 16; t.fp8s = 32.f; t.N = 512; t.K = DM; t.src = C.w_mem_kv + (size_t)l * DM * 512 + (size_t)(64 * kb) * 512 + 32 * nb; t.dst = (bf16*)((unsigned char*)C.Wmem + (size_t)l * 512 * DM + (size_t)(32 * nb) * DM + 64 * kb); return true; } r -= I_MEM;
    if (r < 2 * I_G) { const int up = r >= I_G; if (up) r -= I_G; const int le = r / 256, q = r % 256, kb = q / 16, nb = q % 16; const int n0 = 32 * nb;
        t.N = DE; t.K = DM; t.src = (up ? C.w_up : C.w_gate) + (size_t)le * DM * DE + (size_t)(64 * kb) * DE + n0; t.fp8s = 32.f; t.dst = (bf16*)((unsigned char*)C.W1 + (size_t)le * 1024 * DM + (size_t)((n0 >> 7) * 256 + (up ? 128 : 0) + (n0 & 127)) * DM + 64 * kb); return true; } r -= 2 * I_G;
    { const int le = r / 256, q = r % 256, kb = q / 32, nb = q % 32; t.N = DM; t.K = DE; t.src = C.w_down + (size_t)le * DE * DM + (size_t)(64 * kb) * DM + 32 * nb; t.fp8s = 64.f; t.dst = (bf16*)((unsigned char*)C.W2 + (size_t)le * DM * DE + (size_t)(32 * nb) * DE + 64 * kb); }
    return true;
}
__device__ __forceinline__ void p0_prologue(const Ctx& C, LAS unsigned char* lds, int wave, int lane) {
    LAS float* scr = (LAS float*)(lds + wave * 16384);
    const int gw = C.vcu * NWAVES + wave, NGW = C.G * NWAVES;
    {
        TrItem cur, nxt; float va[32], vb[32];
        bool have = p0_item(C, gw, cur);
        if (have) {
#pragma unroll
            for (int i = 0; i < 32; ++i) va[i] = cur.src[(size_t)(2 * i + (lane >> 5)) * cur.N + (lane & 31)];
        }
        for (int it = gw; have; it += NGW) {
            const bool hn = p0_item(C, it + NGW, nxt);
            if (hn) {
#pragma unroll
                for (int i = 0; i < 32; ++i) vb[i] = nxt.src[(size_t)(2 * i + (lane >> 5)) * nxt.N + (lane & 31)];
            }
#pragma unroll
            for (int i = 0; i < 32; ++i) scr[(2 * i + (lane >> 5)) * 33 + (lane & 31)] = va[i];
            const int c = lane & 7;
#pragma unroll
            for (int j = 0; j < 4; ++j) { const int n = (lane >> 3) + 8 * j; const LAS float* s = scr + (8 * c) * 33 + n;
                if (cur.fp8s != 0.f) { const float sc = cur.fp8s;
                    int w0 = __builtin_amdgcn_cvt_pk_fp8_f32(s[0 * 33] * sc, s[1 * 33] * sc, 0, false); w0 = __builtin_amdgcn_cvt_pk_fp8_f32(s[2 * 33] * sc, s[3 * 33] * sc, w0, true);
                    int w1 = __builtin_amdgcn_cvt_pk_fp8_f32(s[4 * 33] * sc, s[5 * 33] * sc, 0, false); w1 = __builtin_amdgcn_cvt_pk_fp8_f32(s[6 * 33] * sc, s[7 * 33] * sc, w1, true);
                    u32x2 o8; o8.x = (unsigned)w0; o8.y = (unsigned)w1;
                    *(u32x2*)((unsigned char*)cur.dst + (size_t)n * cur.K + 8 * c) = o8; }
                else { u32x4 o; o.x = pk2(s[0 * 33], s[1 * 33]); o.y = pk2(s[2 * 33], s[3 * 33]); o.z = pk2(s[4 * 33], s[5 * 33]); o.w = pk2(s[6 * 33], s[7 * 33]);
                    *(u32x4*)(cur.dst + (size_t)n * cur.K + 8 * c) = o; } }
#pragma unroll
            for (int i = 0; i < 32; ++i) va[i] = vb[i];
            cur = nxt; have = hn;
        }
    }
    for (int m = gw; m < NTOK + NB * MEMLEN; m += NGW) {
        const bool ism = m >= NTOK; const int r = ism ? m - NTOK : m;
        const f32x4* src = (const f32x4*)((ism ? C.mem : C.x) + (size_t)r * DM) + lane;
        f32x4 v[4];
#pragma unroll
        for (int j = 0; j < 4; ++j) v[j] = src[64 * j];
        unsigned* q8 = (unsigned*)((ism ? (unsigned char*)C.memb : C.xb8) + (size_t)r * DM) + lane;
        unsigned* ql = (unsigned*)((unsigned char*)C.xb + (size_t)r * DM) + lane;
#pragma unroll
        for (int j = 0; j < 4; ++j) { unsigned hi, lo; split_fp8(v[j], hi, lo); q8[64 * j] = hi; if (!ism) ql[64 * j] = lo; }
    }
    if (blockIdx.x == 0) {
        const int tid = wave * 64 + lane;
        for (int i = tid; i < 8 * 128; i += NTHR) { const int h = i >> 7, d = i & 127; C.biastab[i] = C.rel_bias[(int)T5_BUCKET[d] * 8 + h]; }
        if (tid < 256) { float v0 = C.lb_logits[tid], v1 = C.lb_logits[256 + tid], v2 = C.lb_logits[512 + tid], v3 = C.lb_logits[768 + tid];
            const float mx = fmaxf(fmaxf(v0, v1), fmaxf(v2, v3)); v0 = __expf(v0 - mx); v1 = __expf(v1 - mx); v2 = __expf(v2 - mx); v3 = __expf(v3 - mx);
            const float inv = 1.f / (v0 + v1 + v2 + v3);
            C.lbtab[tid] = 0.f; C.lbtab[256 + tid] = v1 * inv; C.lbtab[512 + tid] = (v1 + v2) * inv; C.lbtab[768 + tid] = (v1 + v2 + v3) * inv; }
    }
}

struct DenseSched {
    static constexpr bool GATHER = false;
    const char* A0; const char* B0; int nM0, nN0, K0;
    const char* A1; const char* B1; int nM1, nN1;
    int G, c;
    __device__ __forceinline__ void lane_init(int, int, int, int) {}
    __device__ __forceinline__ bool next(int i, pg8::Unit& u) const {
        const int n0 = nM0 * nN0; const int L = i * G + c; if (L >= n0 + nM1 * nN1) return false;
        int pm, pn; const char* A; const char* B; int aux;
        if (L < n0) { pg8::tile_order(L, nM0, nN0, pm, pn); A = A0; B = B0; aux = 0; }
        else { pg8::tile_order(L - n0, nM1, nN1, pm, pn); A = A1; B = B1; aux = 1; }
        u.A = A + (size_t)pm * 256 * K0; u.B = B + (size_t)pn * 256 * K0;
        u.a00 = 0u; u.a01 = 0u; u.a10 = 0u; u.a11 = 0u;
        u.row0 = pm * 256; u.col0 = pn * 256; u.aux = aux; return true;
    }
};
template <bool GATHER_> struct MoeSched {
    static constexpr bool GATHER = GATHER_;
    const char* A; const char* Bl; int K; size_t bstride;
    const int* list; const LAS int* tb;
    int g0, g1, gU, mode; int R0, C0, R1, C1;
    __device__ __forceinline__ void lane_init(int r0, int c0, int r1, int c1) { R0 = r0; C0 = c0; R1 = r1; C1 = c1; }
    __device__ __forceinline__ bool next(int i, pg8::Unit& u) const {
        int g;
        if (mode == 0) { g = g0 + i * g1; if (g >= gU) return false; }
        else {
            const int c = g0, E = g1;
            if (c < E) { if (i == 0) g = 1024 + c; else if (i <= 2) g = c + (i - 1) * E; else return false; }
            else { g = 2 * E + (c - E) + i * (256 - E); if (g >= gU) return false; }
        }
        const int tile = g >> 2, pn = g & 3;
        int e = 0;
#pragma unroll
        for (int j = 1; j < 16; ++j) e += (tile >= tb[j]) ? 1 : 0;
        e = __builtin_amdgcn_readfirstlane(e);
        u.B = Bl + (size_t)e * bstride + (size_t)pn * 256 * K;
        u.A = A;
        if (GATHER) {
            const int p0 = (tile - __builtin_amdgcn_readfirstlane(tb[e])) * 256, cnt = __builtin_amdgcn_readfirstlane(tb[17 + e]); const int* le = list + (size_t)e * LCAP;
            const int cm = cnt - 1;
            const int t00 = le[min(p0 + R0, cm)], t01 = le[min(p0 + R1, cm)], t10 = le[min(p0 + 128 + R0, cm)], t11 = le[min(p0 + 128 + R1, cm)];
            u.a00 = (unsigned)t00 * K + 2 * C0; u.a01 = (unsigned)t01 * K + 2 * C1; u.a10 = (unsigned)t10 * K + 2 * C0; u.a11 = (unsigned)t11 * K + 2 * C1;
        } else {
            u.A = A + (size_t)tile * 256 * K; u.a00 = 0u; u.a01 = 0u; u.a10 = 0u; u.a11 = 0u;
        }
        u.row0 = tile * 256; u.col0 = pn * 256; u.aux = e; return true;
    }
};
struct EpiProj {
    static constexpr bool PERM = true, PERM16 = true, FP8 = true; static constexpr int SCALE_W = 0x7A7A7A7A  , SCALE_A = 0x7C7C7C7C  ;
    unsigned char* O0; const float* bias; unsigned char* O1;
    __device__ __forceinline__ void operator()(const f32x4 (&acc)[2][2][4][2], const pg8::Unit& u, int wr, int wc, int fr, int fq) const {
        unsigned char* base = u.aux ? O1 : O0; const int row0 = u.row0 + wr * 64 + fr, col0 = u.col0 + wc * 64 + 16 * fq;
        f32x4 bv[2][2];
#pragma unroll
        for (int bj = 0; bj < 2; ++bj)
#pragma unroll
            for (int n = 0; n < 2; ++n) bv[bj][n] = u.aux ? (f32x4){0.f, 0.f, 0.f, 0.f} : *(const f32x4*)(bias + col0 + 8 * bj + 4 * n);
#pragma unroll
        for (int ai = 0; ai < 2; ++ai)
#pragma unroll
            for (int m = 0; m < 4; ++m) { unsigned char* rowp = base + (size_t)(row0 + ai * 128 + m * 16) * INW + col0;
                u32x4 w; w.x = pk_fp8x4((acc[ai][0][m][0] + bv[0][0]) * 8.f); w.y = pk_fp8x4((acc[ai][0][m][1] + bv[0][1]) * 8.f); w.z = pk_fp8x4((acc[ai][1][m][0] + bv[1][0]) * 8.f); w.w = pk_fp8x4((acc[ai][1][m][1] + bv[1][1]) * 8.f);
                *(u32x4*)rowp = w; }
    }
};
struct EpiOut {
    static constexpr bool PERM = true, PERM16 = true, FP8 = true; static constexpr int SCALE_W = 0x79797979  , SCALE_A = 0x7C7C7C7C  ;
    unsigned char* H;
    __device__ __forceinline__ void operator()(const f32x4 (&acc)[2][2][4][2], const pg8::Unit& u, int wr, int wc, int fr, int fq) const {
        const int row0 = u.row0 + wr * 64 + fr, col0 = u.col0 + wc * 64 + 16 * fq;
#pragma unroll
        for (int ai = 0; ai < 2; ++ai)
#pragma unroll
            for (int m = 0; m < 4; ++m) { const size_t off = (size_t)(row0 + ai * 128 + m * 16) * DM + col0;
                u32x4 w; w.x = pk_fp8x4(acc[ai][0][m][0] * 64.f); w.y = pk_fp8x4(acc[ai][0][m][1] * 64.f); w.z = pk_fp8x4(acc[ai][1][m][0] * 64.f); w.w = pk_fp8x4(acc[ai][1][m][1] * 64.f);
                *(u32x4*)(H + off) = w; }
    }
};
struct EpiG1 {
    static constexpr bool PERM = true, PERM16 = false, FP8 = true; static constexpr int SCALE_W = 0x7A7A7A7A  , SCALE_A = 0x7C7C7C7C  ;
    unsigned char* O;
    __device__ __forceinline__ void operator()(const f32x4 (&acc)[2][2][4][2], const pg8::Unit& u, int wr, int wc, int fr, int fq) const {
        const int row0 = u.row0 + wr * 64 + fr, col0 = (u.col0 >> 1) + wc * 32 + 8 * fq;
#pragma unroll
        for (int ai = 0; ai < 2; ++ai)
#pragma unroll
            for (int m = 0; m < 4; ++m) { unsigned char* rowp = O + (size_t)(row0 + ai * 128 + m * 16) * DE + col0;
                float hv[8];
#pragma unroll
                for (int n = 0; n < 2; ++n)
#pragma unroll
                    for (int j = 0; j < 4; ++j) { const float gte = acc[ai][0][m][n][j], up = acc[ai][1][m][n][j]; hv[n * 4 + j] = gte * frcp(1.f + __expf(-gte)) * up * 8.f; }
                int w0 = __builtin_amdgcn_cvt_pk_fp8_f32(hv[0], hv[1], 0, false); w0 = __builtin_amdgcn_cvt_pk_fp8_f32(hv[2], hv[3], w0, true);
                int w1 = __builtin_amdgcn_cvt_pk_fp8_f32(hv[4], hv[5], 0, false); w1 = __builtin_amdgcn_cvt_pk_fp8_f32(hv[6], hv[7], w1, true);
                u32x2 w; w.x = (unsigned)w0; w.y = (unsigned)w1;
                *(u32x2*)rowp = w; }
    }
};
struct EpiG2 {
    static constexpr bool PERM = true, PERM16 = true, FP8 = true; static constexpr int SCALE_W = 0x79797979  , SCALE_A = 0x7C7C7C7C  ;
    unsigned char* O;
    __device__ __forceinline__ void operator()(const f32x4 (&acc)[2][2][4][2], const pg8::Unit& u, int wr, int wc, int fr, int fq) const {
        const int row0 = u.row0 + wr * 64 + fr, col0 = u.col0 + wc * 64 + 16 * fq;
#pragma unroll
        for (int ai = 0; ai < 2; ++ai)
#pragma unroll
            for (int m = 0; m < 4; ++m) { unsigned char* rowp = O + (size_t)(row0 + ai * 128 + m * 16) * DM + col0;
                u32x4 w; w.x = pk_fp8x4(acc[ai][0][m][0] * 16.f); w.y = pk_fp8x4(acc[ai][0][m][1] * 16.f); w.z = pk_fp8x4(acc[ai][1][m][0] * 16.f); w.w = pk_fp8x4(acc[ai][1][m][1] * 16.f);
                *(u32x4*)rowp = w; }
    }
};

constexpr int AT_KOFF = 0, AT_VOFF = 36864, AT_BOFF = 73728, AT_OOFF = 77824;
template <bool SWA>
__device__ __forceinline__ void attn_item(const Ctx& C, LAS unsigned char* lds, int l, int item, int tid, int wave, int lane) {
    const int tk = lane & 15, g = lane >> 4;
    int b, nb = 0, kvh = 0, hm = 0, qb = 0;
    const unsigned char *Kg, *Vg; size_t kpitch;
    if (SWA) { b = item >> 6; nb = (item >> 1) & 31; kvh = item & 1;
        Kg = (const unsigned char*)C.proj + ((size_t)b * SEQ + (size_t)(nb - 1) * 128) * INW + C_SK + kvh * 64; Vg = Kg + (C_SV - C_SK); kpitch = INW; }
    else { b = item >> 5; hm = (item >> 3) & 3; qb = item & 7;
        Kg = (const unsigned char*)C.memkv + (size_t)b * MEMLEN * 2048 + l * 512 + hm * 64; Vg = Kg + 256; kpitch = 2048; }
    __syncthreads();
#pragma unroll
    for (int i = 0; i < 4; ++i) { const int c = tid + 512 * i, key = c >> 3, part = c & 7;
        u32x2 k8 = {0u, 0u}, v8 = {0u, 0u};
        if (!SWA || nb > 0 || key >= 128) { k8 = *(const u32x2*)(Kg + (size_t)key * kpitch + part * 8); v8 = *(const u32x2*)(Vg + (size_t)key * kpitch + part * 8); }
        *(LAS u32x4*)(lds + AT_KOFF + key * 144 + part * 16) = fp8x8_to_bf16x8(k8); *(LAS u32x4*)(lds + AT_VOFF + key * 144 + part * 16) = fp8x8_to_bf16x8(v8); }
    if (SWA) ((LAS float*)(lds + AT_BOFF))[tid] = C.biastab[(kvh * 4 + (tid >> 7)) * 128 + (tid & 127)] * 1.44269504f;
    __syncthreads();
    int hq = 0; float sink = 0.f; size_t qrow_base; int qcol, ocol, i0w = 0;
    if (SWA) { hq = kvh * 4 + (wave >> 1); sink = C.sinks[l * 8 + hq]; i0w = (wave & 1) * 64; qrow_base = (size_t)b * SEQ + nb * 128 + i0w; qcol = C_SQ + hq * 64; ocol = hq * 64; }
    else { qrow_base = (size_t)b * SEQ + qb * 512 + wave * 64; qcol = C_MQ + hm * 64; ocol = 768 + hm * 64; }
    const LAS float* biasL = (const LAS float*)(lds + AT_BOFF) + (wave >> 1) * 128;
    const LAS unsigned char* kbase = lds + AT_KOFF + tk * 144 + g * 16;
    const LAS unsigned char* vbase = lds + AT_VOFF + (4 * g + (tk >> 2)) * 144 + (tk & 3) * 8;
#pragma unroll 1
    for (int rt = 0; rt < 4; ++rt) {
        const size_t qrow = qrow_base + rt * 16;
        const unsigned char* qp = (const unsigned char*)C.proj + (qrow + tk) * INW + qcol + 8 * g;
        const bf16x8 q0 = __builtin_bit_cast(bf16x8, fp8x8_to_bf16x8(*(const u32x2*)qp)), q1 = __builtin_bit_cast(bf16x8, fp8x8_to_bf16x8(*(const u32x2*)(qp + 32)));
        constexpr int NT = SWA ? 10 : 16;
        const int t0 = SWA ? ((i0w >> 4) + rt) : 0;
        f32x4 st[NT];
#pragma unroll
        for (int t = 0; t < NT; ++t) {
            const int tc = SWA ? min(t0 + t, 15) : t;
            const bf16x8 k0 = *(const LAS bf16x8*)(kbase + tc * 16 * 144), k1 = *(const LAS bf16x8*)(kbase + tc * 16 * 144 + 64);
            f32x4 a = {0.f, 0.f, 0.f, 0.f};
            a = __builtin_amdgcn_mfma_f32_16x16x32_bf16(k0, q0, a, 0, 0, 0);
            st[t] = __builtin_amdgcn_mfma_f32_16x16x32_bf16(k1, q1, a, 0, 0, 0);
        }
        constexpr float C2 = 0.125f * 1.44269504f * (1.f / 64.f);
        float mx2, sum = 0.f;
        if (SWA) {
            const float sink2 = sink * 1.44269504f;
            const int iq = i0w + rt * 16 + tk;
            const int d0 = iq + 128 - 16 * t0 - 4 * g;
            const unsigned lim = (nb > 0) ? 128u : (unsigned)min(128, iq + 1);
            const LAS float* bl = biasL + (d0 - 16 * (NT - 1) - 3);
            float m4[4] = {sink2, sink2, sink2, sink2};
#pragma unroll
            for (int t = 0; t < NT; ++t)
#pragma unroll
                for (int r = 0; r < 4; ++r) {
                    const unsigned dist = (unsigned)(d0 - 16 * t - r);
                    const float xv = (dist < lim) ? __builtin_fmaf(st[t][r], C2, bl[16 * (NT - 1 - t) + (3 - r)]) : -INFINITY;
                    st[t][r] = xv; m4[r] = fmaxf(m4[r], xv);
                }
            mx2 = fmaxf(fmaxf(m4[0], m4[1]), fmaxf(m4[2], m4[3]));
            mx2 = fmaxf(mx2, __shfl_xor(mx2, 16)); mx2 = fmaxf(mx2, __shfl_xor(mx2, 32));
            float s4[4] = {0.f, 0.f, 0.f, 0.f};
#pragma unroll
            for (int t = 0; t < NT; ++t)
#pragma unroll
                for (int r = 0; r < 4; ++r) { const float p = __builtin_amdgcn_exp2f(st[t][r] - mx2); st[t][r] = p; s4[r] += p; }
            sum = (s4[0] + s4[1]) + (s4[2] + s4[3]);
            sum += __shfl_xor(sum, 16); sum += __shfl_xor(sum, 32);
            sum += __builtin_amdgcn_exp2f(sink2 - mx2);
        } else {
            float m4[4] = {st[0][0], st[0][1], st[0][2], st[0][3]};
#pragma unroll
            for (int t = 1; t < NT; ++t)
#pragma unroll
                for (int r = 0; r < 4; ++r) m4[r] = fmaxf(m4[r], st[t][r]);
            float mr = fmaxf(fmaxf(m4[0], m4[1]), fmaxf(m4[2], m4[3]));
            mr = fmaxf(mr, __shfl_xor(mr, 16)); mr = fmaxf(mr, __shfl_xor(mr, 32));
            const float nm = -mr * C2;
            float s4[4] = {0.f, 0.f, 0.f, 0.f};
#pragma unroll
            for (int t = 0; t < NT; ++t)
#pragma unroll
                for (int r = 0; r < 4; ++r) { const float p = __builtin_amdgcn_exp2f(__builtin_fmaf(st[t][r], C2, nm)); st[t][r] = p; s4[r] += p; }
            sum = (s4[0] + s4[1]) + (s4[2] + s4[3]);
            sum += __shfl_xor(sum, 16); sum += __shfl_xor(sum, 32);
        }
        const float inv = frcp(sum);
        f32x4 o[4];
#pragma unroll
        for (int n = 0; n < 4; ++n) o[n] = (f32x4){0.f, 0.f, 0.f, 0.f};
#pragma unroll
        for (int s = 0; s < NT / 2; ++s) {
            const f32x4 pa = st[2 * s] * inv, pb = st[2 * s + 1] * inv;
            const bf16x8 pfrag = mk8(pk2(pa[0], pa[1]), pk2(pa[2], pa[3]), pk2(pb[0], pb[1]), pk2(pb[2], pb[3]));
            const int ta = SWA ? min(t0 + 2 * s, 15) : 2 * s, tb2 = SWA ? min(t0 + 2 * s + 1, 15) : 2 * s + 1;
#pragma unroll
            for (int n = 0; n < 4; ++n) {
                const s16x4 lo = ld_tr(vbase + (16 * ta) * 144 + n * 32), hi = ld_tr(vbase + (16 * tb2) * 144 + n * 32);
                const bf16x8 vf = {lo[0], lo[1], lo[2], lo[3], hi[0], hi[1], hi[2], hi[3]};
                o[n] = __builtin_amdgcn_mfma_f32_16x16x32_bf16(pfrag, vf, o[n], 0, 0, 0);
            }
        }
        LAS unsigned char* ost = lds + AT_OOFF + wave * 2304;
#pragma unroll
        for (int r = 0; r < 4; ++r)
#pragma unroll
            for (int n = 0; n < 4; n += 2) { const unsigned w = (unsigned)__builtin_amdgcn_cvt_pk_fp8_f32(o[n][r], o[n + 1][r], 0, false);
                *(LAS unsigned char*)(ost + (4 * g + r) * 80 + 16 * n + tk) = (unsigned char)(w & 0xffu); *(LAS unsigned char*)(ost + (4 * g + r) * 80 + 16 * (n + 1) + tk) = (unsigned char)((w >> 8) & 0xffu); }
        { const int orow = lane >> 2, part = lane & 3;
            const u32x4 w = *(const LAS u32x4*)(ost + orow * 80 + part * 16);
            *(u32x4*)((unsigned char*)C.mix + (size_t)(qrow + orow) * MIXW + ocol + part * 16) = w; }
    }
}

template <bool PB>
__device__ __forceinline__ void hgrn_item(const Ctx& C, LAS unsigned char* lds, int wv, int l, int witem, int lane) {
    LAS unsigned char* scr = lds + wv * 4608;
    const int tk = lane & 15, g = lane >> 4;
    const int bh = witem / NSEG, seg = witem % NSEG, b = bh >> 2, h = bh & 3;
    float oml[4][4];
#pragma unroll
    for (int c = 0; c < 4; ++c)
#pragma unroll
        for (int i = 0; i < 4; ++i) oml[c][i] = 1.f - C.lbtab[l * 256 + h * 64 + 16 * c + 4 * g + i];
    f32x4 S[4][4];
#pragma unroll
    for (int mt = 0; mt < 4; ++mt)
#pragma unroll
        for (int n = 0; n < 4; ++n) S[mt][n] = (f32x4){0.f, 0.f, 0.f, 0.f};
    float dseg[4][4];
#pragma unroll
    for (int c = 0; c < 4; ++c)
#pragma unroll
        for (int i = 0; i < 4; ++i) dseg[c][i] = 1.f;
    if (PB) {
        if (lane == 0 && wv == 0) {
            unsigned* cnt = C.ctl + CW_HA + (l * 32 + bh) * 64; unsigned sp = 0;
            while (__hip_atomic_load(cnt, __ATOMIC_RELAXED, __HIP_MEMORY_SCOPE_AGENT) < (unsigned)(NSEG / NWAVES)) { __builtin_amdgcn_s_sleep(2); if (++sp > (1u << 24)) break; }
            __builtin_amdgcn_fence(__ATOMIC_ACQUIRE, "agent");
            asm volatile("s_waitcnt vmcnt(0)" ::: "memory");
        }
    }
    if (PB) {
        LAS float* pl = (LAS float*)lds;
        const int seg0 = seg - wv;
        __syncthreads();
#pragma unroll 1
        for (int qq = 0; qq < 8; ++qq) {
            const int q = wv * 8 + qq, dq = 64 + (q >> 4) * 4 + (q & 3);
            const float* base = C.hst + (size_t)bh * NSEG * 80 * 64 + lane;
            float Sx = 0.f;
            for (int j0 = 0; j0 < seg0; j0 += 8) {
                float dv[8], sv[8];
#pragma unroll
                for (int j = 0; j < 8; ++j) { dv[j] = base[((size_t)(j0 + j) * 80 + dq) * 64]; sv[j] = base[((size_t)(j0 + j) * 80 + q) * 64]; }
#pragma unroll
                for (int j = 0; j < 8; ++j) Sx = Sx * dv[j] + sv[j];
            }
            float dv[8], sv[8];
#pragma unroll
            for (int j = 0; j < 8; ++j) { dv[j] = base[((size_t)(seg0 + j) * 80 + dq) * 64]; sv[j] = base[((size_t)(seg0 + j) * 80 + q) * 64]; }
#pragma unroll
            for (int j = 0; j < 8; ++j) { pl[(j * 64 + q) * 64 + lane] = Sx; Sx = Sx * dv[j] + sv[j]; }
        }
        __syncthreads();
#pragma unroll
        for (int mt = 0; mt < 4; ++mt)
#pragma unroll
            for (int n = 0; n < 4; ++n)
#pragma unroll
                for (int r = 0; r < 4; ++r) S[mt][n][r] = pl[(wv * 64 + (mt * 4 + n) * 4 + r) * 64 + lane];
        __syncthreads();
    }
    float nw[4][4];
    if (PB) {
#pragma unroll
        for (int c = 0; c < 4; ++c)
#pragma unroll
            for (int i = 0; i < 4; ++i) nw[c][i] = C.hnorm[l * 64 + 16 * c + 4 * g + i];
    }
    const size_t rowbase = (size_t)b * SEQ + (size_t)seg * CPS * 16;
    LAS unsigned char* sk = scr; LAS unsigned char* sv = scr + 2304;
    const LAS unsigned char* trk = sk + (4 * g + (tk >> 2)) * 144 + (tk & 3) * 8;
    const LAS unsigned char* trv = sv + (4 * g + (tk >> 2)) * 144 + (tk & 3) * 8;
    unsigned nzf[4], nvi[4];
    { const unsigned char* pr = (const unsigned char*)C.proj + (rowbase + tk) * INW + h * 64 + 4 * g;
#pragma unroll
        for (int c = 0; c < 4; ++c) { nzf[c] = *(const unsigned*)(pr + C_HF + 16 * c); nvi[c] = *(const unsigned*)(pr + C_HI + 16 * c); } }
#pragma unroll 1
    for (int ch = 0; ch < CPS; ++ch) {
        const size_t row = rowbase + ch * 16 + tk;
        unsigned zf_[4], vi_[4], zq_[4], gt_[4];
#pragma unroll
        for (int c = 0; c < 4; ++c) { zf_[c] = nzf[c]; vi_[c] = nvi[c]; }
        if (PB) { const unsigned char* pr = (const unsigned char*)C.proj + row * INW + h * 64 + 4 * g;
#pragma unroll
            for (int c = 0; c < 4; ++c) { zq_[c] = *(const unsigned*)(pr + C_HQ + 16 * c); gt_[c] = *(const unsigned*)(pr + C_HG + 16 * c); } }
        { const unsigned char* pr = (const unsigned char*)C.proj + (rowbase + (ch < CPS - 1 ? ch + 1 : ch) * 16 + tk) * INW + h * 64 + 4 * g;
#pragma unroll
            for (int c = 0; c < 4; ++c) { nzf[c] = *(const unsigned*)(pr + C_HF + 16 * c); nvi[c] = *(const unsigned*)(pr + C_HI + 16 * c); } }
        float kk[4][4], bcs[4][4], dreg[4][4];
#pragma unroll
        for (int c = 0; c < 4; ++c) { const f32x4 zf4 = dec_fp8x4(zf_[c]) * (0.125f * 1.44269504f);
#pragma unroll
            for (int i = 0; i < 4; ++i) {
                const float z = zf4[i];
                const float sneg = frcp(1.f + __builtin_amdgcn_exp2f(z));
                const float kv = oml[c][i] * sneg;
                kk[c][i] = kv;
                bcs[c][i] = row_scan16(__builtin_amdgcn_logf(__builtin_fmaf(-oml[c][i], sneg, 1.f)));
            } }
#pragma unroll
        for (int c = 0; c < 4; ++c)
#pragma unroll
            for (int i = 0; i < 4; ++i) { const float bl = DPPF(bcs[c][i], 0x15F); dreg[c][i] = __builtin_amdgcn_exp2f(bl); }
        unsigned kop_[4][2];
#pragma unroll
        for (int c = 0; c < 4; ++c) {
            const float e0 = kk[c][0] * __builtin_amdgcn_exp2f(-bcs[c][0]), e1 = kk[c][1] * __builtin_amdgcn_exp2f(-bcs[c][1]), e2 = kk[c][2] * __builtin_amdgcn_exp2f(-bcs[c][2]), e3 = kk[c][3] * __builtin_amdgcn_exp2f(-bcs[c][3]);
            kop_[c][0] = pk2(e0, e1); kop_[c][1] = pk2(e2, e3);
            u32x2 w; w.x = kop_[c][0]; w.y = kop_[c][1];
            *(LAS u32x2*)(sk + tk * 144 + (16 * c + 4 * g) * 2) = w;
            { const f32x4 vv = dec_fp8x4(vi_[c]) * 0.125f; u32x2 wv; wv.x = pk2(vv.x, vv.y); wv.y = pk2(vv.z, vv.w); *(LAS u32x2*)(sv + tk * 144 + (16 * c + 4 * g) * 2) = wv; }
        }
        s16x4 kT[4], vT[4];
#pragma unroll
        for (int m = 0; m < 4; ++m) { kT[m] = ld_tr(trk + m * 32); vT[m] = ld_tr(trv + m * 32); }
        f32x4 o[4];
        if (PB) {
            unsigned qop_[4][2];
#pragma unroll
            for (int c = 0; c < 4; ++c) {
                float qv[4]; const f32x4 zq8 = dec_fp8x4(zq_[c]);
#pragma unroll
                for (int i = 0; i < 4; ++i)
                    qv[i] = (zq8[i] * 0.015625f) * frcp(1.f + __builtin_amdgcn_exp2f(zq8[i] * (-0.125f * 1.44269504f))) * __builtin_amdgcn_exp2f(bcs[c][i]);
                qop_[c][0] = pk2(qv[0], qv[1]); qop_[c][1] = pk2(qv[2], qv[3]);
            }
            const bf16x8 qa = mk8(qop_[0][0], qop_[0][1], qop_[1][0], qop_[1][1]), qb2 = mk8(qop_[2][0], qop_[2][1], qop_[3][0], qop_[3][1]);
            const bf16x8 ka = mk8(kop_[0][0], kop_[0][1], kop_[1][0], kop_[1][1]), kb2 = mk8(kop_[2][0], kop_[2][1], kop_[3][0], kop_[3][1]);
            f32x4 sT = {0.f, 0.f, 0.f, 0.f};
            sT = __builtin_amdgcn_mfma_f32_16x16x32_bf16(ka, qa, sT, 0, 0, 0);
            sT = __builtin_amdgcn_mfma_f32_16x16x32_bf16(kb2, qb2, sT, 0, 0, 0);
#pragma unroll
            for (int r = 0; r < 4; ++r) if (4 * g + r > tk) sT[r] = 0.f;
            const s16x4 sT4 = mk4(pk2(sT[0], sT[1]), pk2(sT[2], sT[3]));
#pragma unroll
            for (int n = 0; n < 4; ++n) {
                f32x4 a = {0.f, 0.f, 0.f, 0.f};
                a = __builtin_amdgcn_mfma_f32_16x16x16bf16_1k(vT[n], sT4, a, 0, 0, 0);
                const bf16x8 s0 = mk8(pk2(S[0][n][0], S[0][n][1]), pk2(S[0][n][2], S[0][n][3]), pk2(S[1][n][0], S[1][n][1]), pk2(S[1][n][2], S[1][n][3]));
                const bf16x8 s1 = mk8(pk2(S[2][n][0], S[2][n][1]), pk2(S[2][n][2], S[2][n][3]), pk2(S[3][n][0], S[3][n][1]), pk2(S[3][n][2], S[3][n][3]));
                f32x4 a2 = {0.f, 0.f, 0.f, 0.f};
                a2 = __builtin_amdgcn_mfma_f32_16x16x32_bf16(s0, qa, a2, 0, 0, 0);
                a2 = __builtin_amdgcn_mfma_f32_16x16x32_bf16(s1, qb2, a2, 0, 0, 0);
                o[n] = a + a2;
            }
        }
#pragma unroll
        for (int mt = 0; mt < 4; ++mt)
#pragma unroll
            for (int n = 0; n < 4; ++n) {
                f32x4 a = __builtin_amdgcn_mfma_f32_16x16x16bf16_1k(kT[mt], vT[n], S[mt][n], 0, 0, 0);
#pragma unroll
                for (int r = 0; r < 4; ++r) a[r] *= dreg[mt][r];
                S[mt][n] = a;
            }
        if (PB) {
            float ss = 0.f;
#pragma unroll
            for (int n = 0; n < 4; ++n)
#pragma unroll
                for (int r = 0; r < 4; ++r) ss += o[n][r] * o[n][r];
            ss += __shfl_xor(ss, 16); ss += __shfl_xor(ss, 32);
            const float rinv = __builtin_amdgcn_rsqf(ss * (1.f / 64.f) + RMS_EPS);
            unsigned char* op = (unsigned char*)C.mix + row * MIXW + 512 + h * 64 + 4 * g;
#pragma unroll
            for (int n = 0; n < 4; ++n) {
                float ov[4]; const f32x4 gz8 = dec_fp8x4(gt_[n]);
#pragma unroll
                for (int r = 0; r < 4; ++r)
                    ov[r] = __builtin_amdgcn_fmed3f(o[n][r] * rinv * nw[n][r] * (gz8[r] * frcp(1.f + __builtin_amdgcn_exp2f(gz8[r] * (-0.125f * 1.44269504f)))), -448.f, 448.f);
                *(unsigned*)(op + 16 * n) = pk_fp8x4((f32x4){ov[0], ov[1], ov[2], ov[3]});
            }
        } else {
#pragma unroll
            for (int c = 0; c < 4; ++c)
#pragma unroll
                for (int i = 0; i < 4; ++i) dseg[c][i] *= dreg[c][i];
        }
    }
    if (!PB) {
        float* sl = C.hst + ((size_t)witem * 80) * 64 + lane;
#pragma unroll
        for (int mt = 0; mt < 4; ++mt)
#pragma unroll
            for (int n = 0; n < 4; ++n)
#pragma unroll
                for (int r = 0; r < 4; ++r) sl[((mt * 4 + n) * 4 + r) * 64] = S[mt][n][r];
#pragma unroll
        for (int c = 0; c < 4; ++c)
#pragma unroll
            for (int i = 0; i < 4; ++i) sl[(64 + c * 4 + i) * 64] = dseg[c][i];
        asm volatile("s_waitcnt vmcnt(0)" ::: "memory");
        __syncthreads();
        if (lane == 0 && wv == 0) {
            __builtin_amdgcn_fence(__ATOMIC_RELEASE, "agent");
            asm volatile("s_waitcnt vmcnt(0)" ::: "memory");
            __hip_atomic_fetch_add(C.ctl + CW_HA + (l * 32 + bh) * 64, 1u, __ATOMIC_RELAXED, __HIP_MEMORY_SCOPE_AGENT);
        }
    }
}

__device__ __forceinline__ void mixer_phase(const Ctx& C, LAS unsigned char* lds, int l, int tid, int wave, int lane) {
    constexpr int NH = 32 * NSEG / NWAVES;
    constexpr int N_MEM = NB * 4 * 8, N_SWA = NB * 32 * 2;
    unsigned* head = C.ctl + CW_QUEUE + l * 64;
    volatile LAS int* slot = (volatile LAS int*)(lds + LDSCTL_OFF + 256);
    for (;;) {
        __syncthreads();
        if (tid == 0) slot[0] = (int)__hip_atomic_fetch_add(head, 1u, __ATOMIC_RELAXED, __HIP_MEMORY_SCOPE_AGENT);
        __syncthreads();
        int it = __builtin_amdgcn_readfirstlane(slot[0]);
        if (it >= 2 * NH + N_MEM + N_SWA) break;
        int lane_i = lane; asm volatile("" : "+v"(lane_i));
        if (it < NH) { hgrn_item<false>(C, lds, wave, l, it * NWAVES + wave, lane_i); continue; } it -= NH;
        if (it < N_SWA / 2) { attn_item<true>(C, lds, l, it, wave * 64 + lane_i, wave, lane_i); continue; } it -= N_SWA / 2;
        if (it < NH) { hgrn_item<true>(C, lds, wave, l, it * NWAVES + wave, lane_i); continue; } it -= NH;
        if (it < N_SWA / 2) { attn_item<true>(C, lds, l, it + N_SWA / 2, wave * 64 + lane_i, wave, lane_i); continue; } it -= N_SWA / 2;
        attn_item<false>(C, lds, l, it, wave * 64 + lane_i, wave, lane_i);
    }
}

__device__ __forceinline__ float reduce_scatter16(const float (&p)[16], int lane) {
    const bool h5 = (lane & 32) != 0, h4 = (lane & 16) != 0, h3 = (lane & 8) != 0, h2 = (lane & 4) != 0;
    float q8[8], q4[4], q2[2];
#pragma unroll
    for (int i = 0; i < 8; ++i) { const float snd = h5 ? p[i] : p[i + 8], kp = h5 ? p[i + 8] : p[i]; q8[i] = kp + __shfl_xor(snd, 32); }
#pragma unroll
    for (int i = 0; i < 4; ++i) { const float snd = h4 ? q8[i] : q8[i + 4], kp = h4 ? q8[i + 4] : q8[i]; q4[i] = kp + __shfl_xor(snd, 16); }
#pragma unroll
    for (int i = 0; i < 2; ++i) { const float snd = h3 ? q4[i] : q4[i + 2], kp = h3 ? q4[i + 2] : q4[i]; q2[i] = kp + DPPF(snd, 0x128); }
    float q1; { const float snd = h2 ? q2[0] : q2[1], kp = h2 ? q2[1] : q2[0]; q1 = kp + __shfl_xor(snd, 4); }
    q1 += DPPF(q1, 0x4E); q1 += DPPF(q1, 0xB1);
    return q1;
}
__device__ __forceinline__ float reduce_scatter4(const float (&p)[4], int lane) {
    const bool h5 = (lane & 32) != 0, h4 = (lane & 16) != 0;
    float q2[2];
#pragma unroll
    for (int i = 0; i < 2; ++i) { const float snd = h5 ? p[i] : p[i + 2], kp = h5 ? p[i + 2] : p[i]; q2[i] = kp + __shfl_xor(snd, 32); }
    float q1; { const float snd = h4 ? q2[0] : q2[1], kp = h4 ? q2[1] : q2[0]; q1 = kp + __shfl_xor(snd, 16); }
    q1 += DPPF(q1, 0xB1); q1 += DPPF(q1, 0x4E); q1 += DPPF(q1, 0x141); q1 += DPPF(q1, 0x140);
    return q1;
}
__device__ __forceinline__ float reduce_scatter8(const float (&p)[8], int lane) {
    const bool h5 = (lane & 32) != 0, h4 = (lane & 16) != 0, h3 = (lane & 8) != 0;
    float q4[4], q2[2];
#pragma unroll
    for (int i = 0; i < 4; ++i) { const float snd = h5 ? p[i] : p[i + 4], kp = h5 ? p[i + 4] : p[i]; q4[i] = kp + __shfl_xor(snd, 32); }
#pragma unroll
    for (int i = 0; i < 2; ++i) { const float snd = h4 ? q4[i] : q4[i + 2], kp = h4 ? q4[i + 2] : q4[i]; q2[i] = kp + __shfl_xor(snd, 16); }
    float q1; { const float snd = h3 ? q2[0] : q2[1], kp = h3 ? q2[1] : q2[0]; q1 = kp + DPPF(snd, 0x128); }
    q1 += DPPF(q1, 0xB1); q1 += DPPF(q1, 0x4E); q1 += DPPF(q1, 0x141);
    return q1;
}
__device__ __forceinline__ void route_rows16(const LAS float* lg, const float (&rb)[16], LAS unsigned* dec16, int lane) {
    const int r = lane & 15;
    float sel[16], sc[16];
#pragma unroll
    for (int q = 0; q < 4; ++q) { const f32x4 v = *(const LAS f32x4*)(lg + r * 16 + 4 * q);
        sc[4 * q] = frcp(1.f + __expf(-v.x)); sc[4 * q + 1] = frcp(1.f + __expf(-v.y)); sc[4 * q + 2] = frcp(1.f + __expf(-v.z)); sc[4 * q + 3] = frcp(1.f + __expf(-v.w)); }
#pragma unroll
    for (int e = 0; e < 16; ++e) sel[e] = sc[e] + rb[e];
    float bestv = -INFINITY, w1 = 0.f, w2 = 0.f; int e1 = 0, e2 = 1;
#pragma unroll
    for (int gi = 0; gi < 4; ++gi) {
        float m1 = sel[4 * gi], s1 = sc[4 * gi]; int i1 = 0;
#pragma unroll
        for (int i = 1; i < 4; ++i) if (sel[4 * gi + i] > m1) { m1 = sel[4 * gi + i]; s1 = sc[4 * gi + i]; i1 = i; }
        float m2 = -INFINITY, s2v = 0.f; int i2 = 0;
#pragma unroll
        for (int i = 0; i < 4; ++i) if (i != i1 && sel[4 * gi + i] > m2) { m2 = sel[4 * gi + i]; s2v = sc[4 * gi + i]; i2 = i; }
        const float gs = m1 + m2;
        if (gs > bestv) { bestv = gs; e1 = 4 * gi + i1; e2 = 4 * gi + i2; w1 = s1; w2 = s2v; }
    }
    const float wn = 1.f / (w1 + w2);
    if (lane < 16) { u32x4 d; d.x = (unsigned)e1; d.y = (unsigned)e2; d.z = __float_as_uint(w1 * wn); d.w = __float_as_uint(w2 * wn); *(LAS u32x4*)(dec16 + r * 4) = d; }
}
__device__ __forceinline__ void ln_row(const unsigned (&h)[4], const u32x2 (&x)[4], const f32x4 (&gv)[4], const f32x4 (&bv)[4], f32x4 (&v)[4]) {
    float s = 0.f;
#pragma unroll
    for (int j = 0; j < 4; ++j) { v[j] = join_fp8(x[j].x, x[j].y) * ALPHA + dec_fp8x4(h[j]) * 0.015625f;
        s += (v[j].x + v[j].y) + (v[j].z + v[j].w); }
    const float mean = wave_sum(s) * (1.f / DM); float s2 = 0.f;
#pragma unroll
    for (int j = 0; j < 4; ++j) { v[j] = v[j] - mean; s2 += (v[j].x * v[j].x + v[j].y * v[j].y) + (v[j].z * v[j].z + v[j].w * v[j].w); }
    const float rstd = __builtin_amdgcn_rsqf(wave_sum(s2) * (1.f / DM) + LN_EPS);
#pragma unroll
    for (int j = 0; j < 4; ++j) v[j] = v[j] * rstd * gv[j] + bv[j];
}
__device__ __forceinline__ void p4_ln_route(const Ctx& C, LAS unsigned char* lds, int l, int tid, int wave, int lane) {
    LAS float* wr = (LAS float*)lds;
    constexpr int WRP = DM + 4;
    LAS unsigned* dec = (LAS unsigned*)(lds + 66048);
    LAS unsigned* posb = (LAS unsigned*)(lds + 66048 + 2048);
    LAS float* lgw = (LAS float*)(lds + 66048 + 4096) + wave * 256;
    for (int i = tid; i < DM * NE; i += NTHR) { const int d = i >> 4, e = i & 15; wr[e * WRP + d] = C.w_router[i]; }
    f32x4 gv[4], bv[4];
#pragma unroll
    for (int j = 0; j < 4; ++j) { gv[j] = *((const f32x4*)(C.ln1g + l * DM) + lane + 64 * j); bv[j] = *((const f32x4*)(C.ln1b + l * DM) + lane + 64 * j); }
    unsigned* cntl = C.ctl + CW_CNT + (l + C.rep * DEPTH) * 16 * 64;
    __syncthreads();
    for (int blk = C.vcu; blk < NTOK / 128; blk += C.G) {
        const size_t rowb = (size_t)blk * 128 + wave * 16;
        const unsigned char* hp8 = (const unsigned char*)C.hpre; unsigned char* xlo = (unsigned char*)C.xb;
#define P4_LOAD4(H, X, R0) do { _Pragma("unroll") for (int r_ = 0; r_ < 4; ++r_) { const size_t rr_ = (R0) + r_; _Pragma("unroll") for (int j = 0; j < 4; ++j) { \
            H[r_][j] = ((const unsigned*)(hp8 + rr_ * DM) + lane)[64 * j]; X[r_][j].x = ((const unsigned*)(C.xb8 + rr_ * DM) + lane)[64 * j]; X[r_][j].y = ((const unsigned*)(xlo + rr_ * DM) + lane)[64 * j]; } } } while (0)
        unsigned hA[4][4]; u32x2 xA[4][4];
        P4_LOAD4(hA, xA, rowb);
#pragma unroll 1
        for (int st = 0; st < 4; ++st) {
            const size_t row = rowb + 4 * st;
            unsigned hN[4][4]; u32x2 xN[4][4];
            if (st < 3) P4_LOAD4(hN, xN, row + 4);
            f32x4 v[4][4];
#pragma unroll
            for (int r = 0; r < 4; ++r) {
                ln_row(hA[r], xA[r], gv, bv, v[r]);
                unsigned* xl = (unsigned*)(xlo + (row + r) * DM) + lane; unsigned* x8 = (unsigned*)(C.xb8 + (row + r) * DM) + lane;
#pragma unroll
                for (int j = 0; j < 4; ++j) { unsigned hi, lo; split_fp8(v[r][j], hi, lo); x8[64 * j] = hi; xl[64 * j] = lo; }
            }
#pragma unroll
            for (int eh = 0; eh < 4; ++eh) {
                float p[4][4];
#pragma unroll
                for (int e8 = 0; e8 < 4; ++e8) {
                    f32x4 w[4];
#pragma unroll
                    for (int j = 0; j < 4; ++j) w[j] = *((const LAS f32x4*)(wr + (4 * eh + e8) * WRP) + lane + 64 * j);
#pragma unroll
                    for (int r = 0; r < 4; ++r) { f32x2 a = {0.f, 0.f};
#pragma unroll
                        for (int j = 0; j < 4; ++j) { a = __builtin_elementwise_fma((f32x2){v[r][j].x, v[r][j].y}, (f32x2){w[j].x, w[j].y}, a); a = __builtin_elementwise_fma((f32x2){v[r][j].z, v[r][j].w}, (f32x2){w[j].z, w[j].w}, a); }
                        p[r][e8] = a.x + a.y; }
                }
#pragma unroll
                for (int r = 0; r < 4; ++r) { const float q = reduce_scatter4(p[r], lane);
                    if ((lane & 15) == 0) lgw[(4 * st + r) * 16 + 4 * eh + (lane >> 4)] = q; }
                __builtin_amdgcn_sched_barrier(0);
            }
#pragma unroll
            for (int r = 0; r < 4; ++r)
#pragma unroll
                for (int j = 0; j < 4; ++j) { hA[r][j] = hN[r][j]; xA[r][j] = xN[r][j]; }
        }
#undef P4_LOAD4
        float rb[16];
#pragma unroll
        for (int e = 0; e < 16; ++e) rb[e] = C.rbias[e];
        route_rows16(lgw, rb, dec + wave * 16 * 4, lane);
        __syncthreads();
        if (wave == 0) {
            unsigned ea[4], rk[4]; unsigned tot = 0;
#pragma unroll
            for (int i = 0; i < 4; ++i) { const int a = lane + 64 * i; ea[i] = dec[(a >> 1) * 4 + (a & 1)]; rk[i] = 0; }
#pragma unroll
            for (int e = 0; e < 16; ++e) {
                unsigned run = 0;
#pragma unroll
                for (int i = 0; i < 4; ++i) { const unsigned long long m = __ballot(ea[i] == (unsigned)e);
                    const unsigned below = __builtin_amdgcn_mbcnt_hi((unsigned)(m >> 32), __builtin_amdgcn_mbcnt_lo((unsigned)m, 0u));
                    if (ea[i] == (unsigned)e) rk[i] = run + below;
                    run += (unsigned)__popcll(m); }
                if (lane == e) tot = run;
            }
            unsigned base = 0;
            if (lane < 16) base = tot ? atomicAdd(cntl + 64 * lane, tot) : 0u;
#pragma unroll
            for (int i = 0; i < 4; ++i) { const unsigned bs = __shfl(base, (int)ea[i]); const unsigned pos = bs + rk[i]; const int a = lane + 64 * i;
                posb[a] = pos; C.list[(size_t)ea[i] * LCAP + pos] = blk * 128 + (a >> 1); }
        }
        __syncthreads();
        if (tid < 128) { u32x4 rec; rec.x = (dec[tid * 4] << 16) | posb[tid * 2]; rec.y = (dec[tid * 4 + 1] << 16) | posb[tid * 2 + 1]; rec.z = dec[tid * 4 + 2]; rec.w = dec[tid * 4 + 3];
            C.tokrec[(size_t)blk * 128 + tid] = rec; }
        __syncthreads();
    }
}

__device__ __forceinline__ void moe_prefix(const Ctx& C, LAS int* tb, int l, int tid) {
    if (tid == 0) {
        unsigned* cntl = C.ctl + CW_CNT + l * 16 * 64; int acc = 0;
        for (int e = 0; e < 16; ++e) { const int c = (int)__hip_atomic_load(cntl + 64 * e, __ATOMIC_RELAXED, __HIP_MEMORY_SCOPE_AGENT); tb[e] = acc; tb[17 + e] = c; acc += (c + 255) >> 8; }
        tb[16] = acc;
    }
    __syncthreads();
}

__device__ __forceinline__ void p7_combine(const Ctx& C, LAS unsigned char* lds, int l, int tid, int wave, int lane) {
    LAS int* tb = (LAS int*)lds;
    moe_prefix(C, tb, l, tid);
    f32x4 gv[4], bv[4];
#pragma unroll
    for (int j = 0; j < 4; ++j) { gv[j] = *((const f32x4*)(C.ln2g + l * DM) + lane + 64 * j); bv[j] = *((const f32x4*)(C.ln2b + l * DM) + lane + 64 * j); }
    const bool lastl = (l == DEPTH - 1);
    for (int r0 = (C.vcu * NWAVES + wave) * 16; r0 < NTOK; r0 += C.G * NWAVES * 16) {
        u32x4 rec = C.tokrec[r0 + (lane & 15)];
        const unsigned sa_l = (unsigned)tb[rec.x >> 16] * 256u + (rec.x & 0xffffu), sb_l = (unsigned)tb[rec.y >> 16] * 256u + (rec.y & 0xffffu);
#pragma unroll 1
        for (int bq = 0; bq < 2; ++bq) {
            u32x2 xv[8][4]; unsigned av[8][4], bw[8][4]; float wa[8], wb[8];
#pragma unroll
            for (int k = 0; k < 8; ++k) { const int idx = bq * 8 + k;
                const size_t sa = (size_t)__builtin_amdgcn_readlane(sa_l, idx), sb = (size_t)__builtin_amdgcn_readlane(sb_l, idx);
                wa[k] = __uint_as_float(__builtin_amdgcn_readlane(rec.z, idx)) * 0.0625f; wb[k] = __uint_as_float(__builtin_amdgcn_readlane(rec.w, idx)) * 0.0625f;
                const unsigned* xph = (const unsigned*)(C.xb8 + (size_t)(r0 + idx) * DM) + lane; const unsigned* xpl = (const unsigned*)((const unsigned char*)C.xb + (size_t)(r0 + idx) * DM) + lane; const unsigned* ya = (const unsigned*)((const unsigned char*)C.ys + sa * DM) + lane; const unsigned* yb = (const unsigned*)((const unsigned char*)C.ys + sb * DM) + lane;
#pragma unroll
                for (int j = 0; j < 4; ++j) { xv[k][j].x = xph[64 * j]; xv[k][j].y = xpl[64 * j]; av[k][j] = ya[64 * j]; bw[k][j] = yb[64 * j]; } }
#pragma unroll
            for (int k = 0; k < 8; ++k) { const int row = r0 + bq * 8 + k;
                f32x4 v[4]; float s = 0.f;
#pragma unroll
                for (int j = 0; j < 4; ++j) { const u32x2 x2 = xv[k][j];
                    const f32x2 al = __builtin_amdgcn_cvt_pk_f32_fp8((int)av[k][j], false), ah = __builtin_amdgcn_cvt_pk_f32_fp8((int)av[k][j], true);
                    const f32x2 bl = __builtin_amdgcn_cvt_pk_f32_fp8((int)bw[k][j], false), bh = __builtin_amdgcn_cvt_pk_f32_fp8((int)bw[k][j], true);
                    const f32x4 xr = join_fp8(x2.x, x2.y) * ALPHA;
                    v[j].x = xr.x + (al.x * wa[k] + bl.x * wb[k]); v[j].y = xr.y + (al.y * wa[k] + bl.y * wb[k]);
                    v[j].z = xr.z + (ah.x * wa[k] + bh.x * wb[k]); v[j].w = xr.w + (ah.y * wa[k] + bh.y * wb[k]);
                    s += (v[j].x + v[j].y) + (v[j].z + v[j].w); }
                const float mean = wave_sum(s) * (1.f / DM); float s2 = 0.f;
#pragma unroll
                for (int j = 0; j < 4; ++j) { v[j] = v[j] - mean; s2 += (v[j].x * v[j].x + v[j].y * v[j].y) + (v[j].z * v[j].z + v[j].w * v[j].w); }
                const float rstd = __builtin_amdgcn_rsqf(wave_sum(s2) * (1.f / DM) + LN_EPS);
                if (lastl) { f32x4* xo = (f32x4*)(C.xcur + (size_t)row * DM) + lane;
#pragma unroll
                    for (int j = 0; j < 4; ++j) xo[64 * j] = v[j] * rstd * gv[j] + bv[j]; }
                else { unsigned* xlo = (unsigned*)((unsigned char*)C.xb + (size_t)row * DM) + lane; unsigned* x8o = (unsigned*)(C.xb8 + (size_t)row * DM) + lane;
#pragma unroll
                    for (int j = 0; j < 4; ++j) { const f32x4 y = v[j] * rstd * gv[j] + bv[j]; unsigned hi, lo; split_fp8(y, hi, lo); x8o[64 * j] = hi; xlo[64 * j] = lo; } }
            }
        }
    }
}

template <class T> __device__ __forceinline__ T* as_g(T* p) { return (T*)(GAS T*)p; }
typedef const __attribute__((address_space(4))) Args* KArgs;
__device__ __forceinline__ Ctx make_ctx(KArgs ap) {
    asm volatile("" : "+s"(ap));
    Ctx C;
    C.x = as_g(ap->in[0]); C.mem = as_g(ap->in[1]); C.w_in = as_g(ap->in[2]); C.b_in = as_g(ap->in[3]); C.w_mem_kv = as_g(ap->in[4]); C.sinks = as_g(ap->in[5]); C.rel_bias = as_g(ap->in[6]); C.lb_logits = as_g(ap->in[7]);
    C.hnorm = as_g(ap->in[8]); C.w_out = as_g(ap->in[9]); C.ln1g = as_g(ap->in[10]); C.ln1b = as_g(ap->in[11]); C.w_router = as_g(ap->in[12]); C.rbias = as_g(ap->in[13]); C.w_gate = as_g(ap->in[14]); C.w_up = as_g(ap->in[15]);
    C.w_down = as_g(ap->in[16]); C.ln2g = as_g(ap->in[17]); C.ln2b = as_g(ap->in[18]);
    unsigned char* ws = as_g(ap->ws);
    C.xcur = as_g(ap->out); C.ws = ws; C.ctl = (unsigned*)(ws + WS_CTL);
    C.Win = (bf16*)(ws + WS_WIN); C.Wout = (bf16*)(ws + WS_WOUT); C.Wmem = (bf16*)(ws + WS_WMEM); C.W1 = (bf16*)(ws + WS_W1); C.W2 = (bf16*)(ws + WS_W2);
    C.xb = (bf16*)(ws + WS_XB); C.proj = (bf16*)(ws + WS_BIG); C.hpre = (bf16*)(ws + WS_BIG); C.ys = (bf16*)(ws + WS_BIG);
    C.mix = (bf16*)(ws + WS_MIX); C.hmid = (bf16*)(ws + WS_MIX); C.memkv = (bf16*)(ws + WS_MEMKV); C.memb = (bf16*)(ws + WS_MEMB);
    C.biastab = (float*)(ws + WS_TAB); C.lbtab = (float*)(ws + WS_TAB + 4096); C.list = (int*)(ws + WS_LIST); C.tokrec = (u32x4*)(ws + WS_TOKREC); C.hst = (float*)(ws + WS_HST); C.xb8 = ws + WS_XB8;
    C.rep = ap->rep; C.G = gridDim.x; { const int bx = blockIdx.x; C.vcu = (C.G % 8 == 0) ? (bx % 8) * (C.G / 8) + bx / 8 : bx; }
    return C;
}
constexpr int PH_PER_LAYER = 7, N_PHASES = 1 + DEPTH * PH_PER_LAYER;
__global__ void __launch_bounds__(NTHR, 2) trunk_fwd(Args args) {
    extern __shared__ __attribute__((aligned(16))) unsigned char lds_raw[];
    LAS unsigned char* lds = (LAS unsigned char*)lds_raw;
    volatile LAS unsigned* MISC = (volatile LAS unsigned*)(lds + MISC_OFF);
    const int tid0 = threadIdx.x; const int wave0 = __builtin_amdgcn_readfirstlane(tid0 >> 6);
    for (int u = tid0; u < (LDS_BYTES - LDSCTL_OFF) / 4; u += NTHR) ((LAS unsigned*)(lds + LDSCTL_OFF))[u] = 0u;
    __syncthreads();
    KArgs ap = (KArgs)__builtin_amdgcn_kernarg_segment_ptr();
    XcdBarrier bar; bar.bar = (unsigned*)(as_g(args.ws) + WS_CTL) + CW_BAR; bar.x = 0; bar.st = nullptr;
    if (args.use_bar) bar = xcd_barrier_post((unsigned*)(as_g(args.ws) + WS_CTL) + CW_BAR, MISC + 8);
    const int lo = args.ph_lo, hi = args.ph_hi;
#define IN(k) (lo <= (k) && (k) < hi)
#define PHASE_IDS unsigned ones_ = ~0u; asm volatile("" : "+s"(ones_)); int lane = (int)__builtin_amdgcn_mbcnt_hi(ones_, __builtin_amdgcn_mbcnt_lo(ones_, 0u)); asm volatile("" : "+v"(lane)); int wave = wave0; asm volatile("" : "+s"(wave)); const int tid = wave * 64 + lane; (void)tid
#define SEAM(k) do { if (IN(k) && IN((k) + 1)) { XcdBarrier b2_ = bar; unsigned z_ = 0u; asm volatile("" : "+s"(z_)); b2_.bar = bar.bar + z_; xcd_barrier(b2_); } } while (0)

    if (IN(0)) { PHASE_IDS; const Ctx C = make_ctx(ap); p0_prologue(C, lds, wave, lane); }
    SEAM(0);
#pragma unroll 1
    for (int l = 0; l < DEPTH; ++l) {
        const int pb = 1 + l * PH_PER_LAYER;
        if (IN(pb + 0)) {
            PHASE_IDS; const Ctx C = make_ctx(ap);
            DenseSched S; S.A0 = (const char*)C.xb8; S.B0 = (const char*)C.Win + (size_t)l * INW * DM; S.nM0 = NTOK / 256; S.nN0 = INW / 256; S.K0 = DM  ;
            S.A1 = (const char*)C.memb; S.B1 = (const char*)C.Wmem; S.nM1 = (l == 0) ? (NB * MEMLEN) / 256 : 0; S.nN1 = 2048 / 256; S.G = C.G; S.c = (int)blockIdx.x;
            EpiProj E{(unsigned char*)C.proj, C.b_in + l * INW, (unsigned char*)C.memkv};
            pg8::gemm_phase<EpiProj, DenseSched, true>(lds, tid, DM, S, E);
        }
        SEAM(pb + 0);
        if (IN(pb + 1)) { PHASE_IDS; const Ctx C = make_ctx(ap); mixer_phase(C, lds, l, tid, wave, lane); }
        SEAM(pb + 1);
        if (IN(pb + 2)) {
            PHASE_IDS; const Ctx C = make_ctx(ap);
            DenseSched S; S.A0 = (const char*)C.mix; S.B0 = (const char*)C.Wout + (size_t)l * DM * MIXW; S.nM0 = NTOK / 256; S.nN0 = DM / 256; S.K0 = MIXW  ;
            S.A1 = nullptr; S.B1 = nullptr; S.nM1 = 0; S.nN1 = 0; S.G = C.G; S.c = (int)blockIdx.x;
            EpiOut E{(unsigned char*)C.hpre};
            pg8::gemm_phase<EpiOut, DenseSched, true>(lds, tid, MIXW, S, E);
        }
        SEAM(pb + 2);
        if (IN(pb + 3)) { PHASE_IDS; const Ctx C = make_ctx(ap); p4_ln_route(C, lds, l, tid, wave, lane); }
        SEAM(pb + 3);
        if (IN(pb + 4)) {
            PHASE_IDS; const Ctx C = make_ctx(ap);
            LAS int* tb = (LAS int*)(lds + LDSCTL_OFF + 64);
            moe_prefix(C, tb, l, tid);
            const int U = tb[16] * 4;
            MoeSched<true> S; S.A = (const char*)C.xb8; S.Bl = (const char*)C.W1 + (size_t)l * NE * 1024 * DM; S.K = DM  ; S.bstride = (size_t)1024 * DM; S.list = C.list; S.tb = tb;
            S.mode = 0; S.g0 = C.vcu; S.g1 = C.G; S.gU = U < 1024 ? U : 1024;
            EpiG1 E{(unsigned char*)C.hmid};
            pg8::gemm_phase<EpiG1, MoeSched<true>, true>(lds, tid, DM, S, E);
        }
        SEAM(pb + 4);
        if (IN(pb + 5)) {
            PHASE_IDS; const Ctx C = make_ctx(ap);
            LAS int* tb = (LAS int*)(lds + LDSCTL_OFF + 64);
            moe_prefix(C, tb, l, tid);
            const int U = tb[16] * 4, Etail = U > 1024 ? U - 1024 : 0;
            if (C.vcu < Etail) {
                MoeSched<true> S; S.A = (const char*)C.xb8; S.Bl = (const char*)C.W1 + (size_t)l * NE * 1024 * DM; S.K = DM  ; S.bstride = (size_t)1024 * DM; S.list = C.list; S.tb = tb;
                S.mode = 0; S.g0 = 1024 + C.vcu; S.g1 = 1 << 20; S.gU = 1024 + C.vcu + 1;
                EpiG1 E{(unsigned char*)C.hmid};
                pg8::gemm_phase<EpiG1, MoeSched<true>, true>(lds, tid, DM, S, E);
                asm volatile("s_waitcnt vmcnt(0)" ::: "memory");
                __syncthreads();
                if (tid == 0) {
                    unsigned* cnt = C.ctl + CW_TILE + (l * 16 + (C.vcu >> 2)) * 64; unsigned sp = 0;
                    __builtin_amdgcn_fence(__ATOMIC_RELEASE, "agent");
                    asm volatile("s_waitcnt vmcnt(0)" ::: "memory");
                    __hip_atomic_fetch_add(cnt, 1u, __ATOMIC_RELAXED, __HIP_MEMORY_SCOPE_AGENT);
                    while (__hip_atomic_load(cnt, __ATOMIC_RELAXED, __HIP_MEMORY_SCOPE_AGENT) < 4u) { __builtin_amdgcn_s_sleep(2); if (++sp > (1u << 24)) break; }
                    __builtin_amdgcn_fence(__ATOMIC_ACQUIRE, "agent");
                    asm volatile("s_waitcnt vmcnt(0)" ::: "memory");
                }
                __syncthreads();
            }
            MoeSched<false> S; S.A = (const char*)C.hmid; S.Bl = (const char*)C.W2 + (size_t)l * NE * DM * DE; S.K = DE  ; S.bstride = (size_t)DM * DE; S.list = C.list; S.tb = tb;
            S.mode = 1; S.g0 = C.vcu; S.g1 = Etail; S.gU = U < 1024 ? U : 1024;
            EpiG2 E{(unsigned char*)C.ys};
            pg8::gemm_phase<EpiG2, MoeSched<false>, true>(lds, tid, DE, S, E);
        }
        SEAM(pb + 5);
        if (IN(pb + 6)) { PHASE_IDS; const Ctx C = make_ctx(ap); p7_combine(C, lds, l, tid, wave, lane); }
        SEAM(pb + 6);
    }
#undef IN
#undef SEAM
}

#ifndef ONE_LAUNCH
#define ONE_LAUNCH 1
#endif
extern "C" void kernel_launch(void* const* d_in, const int* in_sizes, int n_in, void* d_out, int out_size, void* d_ws, size_t ws_size, hipStream_t stream) {
    static int grid = 0;
    if (grid == 0) {
        if (n_in != 19 || in_sizes[0] != NTOK * DM || out_size != NTOK * DM || ws_size < WS_END) {
            fprintf(stderr, "kernel_launch: unexpected shapes (n_in %d, in0 %d, out %d, ws %zu < %zu); nothing launched\n", n_in, n_in > 0 ? in_sizes[0] : -1, out_size, ws_size, (size_t)WS_END); grid = -1; return; }
        int dev = 0, cus = 0, per_cu = 0;
        if (hipGetDevice(&dev) != hipSuccess || hipDeviceGetAttribute(&cus, hipDeviceAttributeMultiprocessorCount, dev) != hipSuccess) { grid = -1; return; }
        if (hipFuncSetAttribute((const void*)trunk_fwd, hipFuncAttributeMaxDynamicSharedMemorySize, LDS_BYTES) != hipSuccess) { fprintf(stderr, "kernel_launch: hipFuncSetAttribute failed\n"); grid = -1; return; }
        if (hipOccupancyMaxActiveBlocksPerMultiprocessor(&per_cu, (const void*)trunk_fwd, NTHR, LDS_BYTES) != hipSuccess || per_cu < 1) { fprintf(stderr, "kernel_launch: occupancy query says %d\n", per_cu); }
        (void)hipGetLastError();
        grid = cus;
        fprintf(stderr, "kernel_launch: grid %d, occupancy/CU %d, ws %zu\n", grid, per_cu, ws_size);
    }
    if (grid < 0) return;
    (void)hipMemsetAsync((char*)d_ws + WS_CTL, 0, CTL_ZERO_BYTES, stream);
    Args a{};
    for (int i = 0; i < 19; ++i) a.in[i] = (const float*)d_in[i];
    a.out = (float*)d_out; a.ws = (unsigned char*)d_ws;
#if ONE_LAUNCH
    a.ph_lo = 0; a.ph_hi = N_PHASES; a.use_bar = 1;
    void* kargs[] = {&a};
    hipError_t e = hipLaunchCooperativeKernel((const void*)trunk_fwd, dim3(grid), dim3(NTHR), kargs, LDS_BYTES, stream);
    if (e != hipSuccess) fprintf(stderr, "kernel_launch: cooperative launch failed: %s\n", hipGetErrorString(e));
#else
    for (int p = 0; p < N_PHASES; ++p) {
        a.ph_lo = p; a.ph_hi = p + 1; a.use_bar = 0;
        hipLaunchKernelGGL(trunk_fwd, dim3(grid), dim3(NTHR), LDS_BYTES, stream, a);
    }
#endif
}
```

```cpp
#include <hip/hip_runtime.h>
#include <cstdio>
#include <cstdint>

#define LAS __attribute__((address_space(3)))
#define GAS __attribute__((address_space(1)))
typedef unsigned short bf16;
typedef short bf16x8 __attribute__((ext_vector_type(8)));
typedef short s16x4 __attribute__((ext_vector_type(4)));
typedef float f32x4 __attribute__((ext_vector_type(4)));
typedef float f32x2 __attribute__((ext_vector_type(2)));
typedef unsigned u32x4 __attribute__((ext_vector_type(4)));
typedef unsigned u32x2 __attribute__((ext_vector_type(2)));
typedef int i32x4 __attribute__((ext_vector_type(4)));
typedef int i32x8 __attribute__((ext_vector_type(8)));
typedef __bf16 bf16x2_t __attribute__((ext_vector_type(2)));

constexpr int NB = 8, SEQ = 4096, DM = 1024, NTOK = NB * SEQ, DEPTH = 4;
constexpr int INW = 2048, MIXW = 1024, NE = 16, DE = 512, MEMLEN = 256;
constexpr int C_SQ = 0, C_SK = 512, C_SV = 640, C_HQ = 768, C_HF = 1024, C_HI = 1280, C_HG = 1536, C_MQ = 1792;
constexpr float ALPHA = 1.6817928305074290f;
constexpr float LN_EPS = 1e-5f, RMS_EPS = 1e-6f;
constexpr int NSEG = 32, CPS = (SEQ / 16) / NSEG;
constexpr int LCAP = 32768;
constexpr int MAXTILES = NTOK * 2 / 256 + NE;
constexpr int NWAVES = 8, NTHR = 512;

constexpr size_t MiB = 1u << 20;
constexpr size_t WS_CTL = 0, CTL_ZERO_BYTES = 1 * MiB;
constexpr size_t WS_TAB = 1 * MiB;
constexpr size_t WS_WIN = 2 * MiB;
constexpr size_t WS_WOUT = 18 * MiB;
constexpr size_t WS_WMEM = 26 * MiB;
constexpr size_t WS_W1 = 30 * MiB;
constexpr size_t WS_XB8 = 94 * MiB;
constexpr size_t WS_W2 = 158 * MiB;
constexpr size_t WS_XB = 222 * MiB;
constexpr size_t WS_BIG = 286 * MiB;
constexpr size_t WS_MIX = 430 * MiB;
constexpr size_t WS_MEMKV = 502 * MiB;
constexpr size_t WS_MEMB = 510 * MiB;
constexpr size_t WS_LIST = 514 * MiB;
constexpr size_t WS_TOKREC = 516 * MiB;
constexpr size_t WS_HST = 517 * MiB;
constexpr size_t WS_END = 538 * MiB;
constexpr int CW_BAR = 4096;
constexpr int CW_CNT = 16384;
constexpr int CW_QUEUE = 32768;
constexpr int CW_TILE = 57344;
constexpr int CW_HA = 49152;

constexpr int RING_BYTES = 131072;
constexpr int LDSCTL_OFF = RING_BYTES, MISC_OFF = LDSCTL_OFF + 320;
constexpr int LDS_BYTES = 147456;

__device__ __forceinline__ unsigned pk2(float lo, float hi) { f32x2 v = {lo, hi}; bf16x2_t b = __builtin_convertvector(v, bf16x2_t); return __builtin_bit_cast(unsigned, b); }
__device__ __forceinline__ unsigned pk_fp8x4(f32x4 v) { int w = __builtin_amdgcn_cvt_pk_fp8_f32(v.x, v.y, 0, false); w = __builtin_amdgcn_cvt_pk_fp8_f32(v.z, v.w, w, true); return (unsigned)w; }
__device__ __forceinline__ f32x4 dec_fp8x4(unsigned w) { const f32x2 a = __builtin_amdgcn_cvt_pk_f32_fp8((int)w, false), b = __builtin_amdgcn_cvt_pk_f32_fp8((int)w, true); return (f32x4){a.x, a.y, b.x, b.y}; }
__device__ __forceinline__ void split_fp8(f32x4 y, unsigned& hi, unsigned& lo) { const f32x4 y8 = y * 8.f; hi = pk_fp8x4(y8); lo = pk_fp8x4((y8 - dec_fp8x4(hi)) * 16.f); }
__device__ __forceinline__ f32x4 join_fp8(unsigned hi, unsigned lo) { return dec_fp8x4(hi) * 0.125f + dec_fp8x4(lo) * 0.0078125f; }
__device__ __forceinline__ u32x4 fp8x8_to_bf16x8(u32x2 w) { const f32x4 a = dec_fp8x4(w.x), b = dec_fp8x4(w.y); u32x4 o; o.x = pk2(a.x, a.y); o.y = pk2(a.z, a.w); o.z = pk2(b.x, b.y); o.w = pk2(b.z, b.w); return o; }
__device__ __forceinline__ float frcp(float x) { return __builtin_amdgcn_rcpf(x); }
__device__ __forceinline__ float bflo(unsigned w) { return __uint_as_float(w << 16); }
__device__ __forceinline__ float bfhi(unsigned w) { return __uint_as_float(w & 0xffff0000u); }
#define DPPF(v, ctrl) __int_as_float(__builtin_amdgcn_update_dpp(0, __float_as_int(v), (ctrl), 0xf, 0xf, true))
__device__ __forceinline__ float xsum16(float v) { const u32x2 r = __builtin_amdgcn_permlane16_swap(__float_as_uint(v), __float_as_uint(v), false, false); return __uint_as_float(r.x) + __uint_as_float(r.y); }
__device__ __forceinline__ float xsum32(float v) { const u32x2 r = __builtin_amdgcn_permlane32_swap(__float_as_uint(v), __float_as_uint(v), false, false); return __uint_as_float(r.x) + __uint_as_float(r.y); }
__device__ __forceinline__ float xmax16(float v) { const u32x2 r = __builtin_amdgcn_permlane16_swap(__float_as_uint(v), __float_as_uint(v), false, false); return fmaxf(__uint_as_float(r.x), __uint_as_float(r.y)); }
__device__ __forceinline__ float xmax32(float v) { const u32x2 r = __builtin_amdgcn_permlane32_swap(__float_as_uint(v), __float_as_uint(v), false, false); return fmaxf(__uint_as_float(r.x), __uint_as_float(r.y)); }
__device__ __forceinline__ float wave_sum(float v) {
    v += DPPF(v, 0xB1);
    v += DPPF(v, 0x4E);
    v += DPPF(v, 0x141);
    v += DPPF(v, 0x140);
    v = xsum16(v); v = xsum32(v);
    return v;
}
__device__ __forceinline__ s16x4 ld_tr(const LAS unsigned char* p) { return __builtin_amdgcn_ds_read_tr16_b64_v4i16((LAS s16x4*)p); }
__device__ __forceinline__ float row_scan16(float x) {
    x += __int_as_float(__builtin_amdgcn_update_dpp(0, __float_as_int(x), 0x111, 0xf, 0xf, true));
    x += __int_as_float(__builtin_amdgcn_update_dpp(0, __float_as_int(x), 0x112, 0xf, 0xf, true));
    x += __int_as_float(__builtin_amdgcn_update_dpp(0, __float_as_int(x), 0x114, 0xf, 0xf, true));
    x += __int_as_float(__builtin_amdgcn_update_dpp(0, __float_as_int(x), 0x118, 0xf, 0xf, true));
    return x;
}
__device__ __forceinline__ bf16x8 mk8(unsigned a, unsigned b, unsigned c, unsigned d) { u32x4 w = {a, b, c, d}; return __builtin_bit_cast(bf16x8, w); }
__device__ __forceinline__ s16x4 mk4(unsigned a, unsigned b) { u32x2 w = {a, b}; return __builtin_bit_cast(s16x4, w); }

namespace pg8 {
constexpr int BM = 256, BK = 64, HALF = 128, HTB = HALF * BK * 2, STAGE_BYTES = 8 * HTB, NXCD = 8, WGM = 8;
constexpr int NXT_SLOT_OFF = 131072 + 2048;
__host__ __device__ __forceinline__ int lds_byte(int r, int c) { const int st = (r >> 4) * 2 + (c >> 5), rr = r & 15, cc = c & 31, ob = rr * 64 + cc * 2; return st * 1024 + (ob ^ (((ob >> 9) & 1) << 5)); }
__host__ __device__ __forceinline__ void stage_rc(int b, int& R, int& C) { const int st = b / 1024, sb = b % 1024, swz = sb ^ (((sb >> 9) & 1) << 5); R = (st >> 1) * 16 + swz / 64; C = (st & 1) * 32 + (swz % 64) / 2; }
__host__ __device__ __forceinline__ int perm32(int rho) { const int n = rho >> 4, i = rho & 15; return 8 * (i >> 2) + 4 * n + (i & 3); }
__host__ __device__ __forceinline__ int perm256(int R) { const int bj = R >> 7, wc = (R >> 5) & 3, n = (R >> 4) & 1, i = R & 15; return 64 * wc + 16 * (i >> 2) + 8 * bj + 4 * n + (i & 3); }

struct Unit {
    const char* A;
    const char* B;
    unsigned a00, a01, a10, a11;
    int row0, col0, aux;
};
__device__ __forceinline__ void tile_order(int L, int nM, int nN, int& pm, int& pn) {
    const int nwg = nM * nN; int wgid = L;
    { const int q = nwg / NXCD, r = nwg % NXCD, xcd = wgid % NXCD, off = wgid / NXCD; wgid = (xcd < r ? xcd * (q + 1) : r * (q + 1) + (xcd - r) * q) + off; }
    const int nig = WGM * nN, gid = wgid / nig, fm = gid * WGM, gsz = (nM - fm) < WGM ? (nM - fm) : WGM;
    pm = fm + ((wgid % nig) % gsz); pn = (wgid % nig) / gsz;
}

template <class Epi, class Sched, bool ALIGN_EPI>
__device__ __forceinline__ void gemm_phase(LAS unsigned char* lds, const int tid, const int RB  , Sched& S, const Epi& E) {
    const int wid = __builtin_amdgcn_readfirstlane(tid >> 6), lane = tid & 63, wr = wid >> 2, wc = wid & 3, fr = lane & 15, fq = lane >> 4;
    const int nt = RB / 128;
    unsigned voffB[2], voffA[2] = {0u, 0u};
    {
        int Ra[2], Ca[2];
#pragma unroll
        for (int i = 0; i < 2; ++i) { int R, C; stage_rc(tid * 16 + i * 8192, R, C); const int Rb = Epi::PERM16 ? perm256(R) : (Epi::PERM ? ((R & ~31) + perm32(R & 31)) : R);
            Ra[i] = R; Ca[i] = C; voffB[i] = (unsigned)(Rb * RB + 2 * C); }
        S.lane_init(Ra[0], Ca[0], Ra[1], Ca[1]);
        if constexpr (!Sched::GATHER) { voffA[0] = (unsigned)(Ra[0] * RB + 2 * Ca[0]); voffA[1] = (unsigned)(Ra[1] * RB + 2 * Ca[1]); }
    }
    const size_t kstep = (size_t)(BK * 2);
    const size_t hstepB = (size_t)HALF * RB;
    const size_t hstepW = Epi::PERM16 ? (size_t)8 * RB : hstepB;
    const unsigned ldsw = (unsigned)wid * 1024u;
    const int aoff = lds_byte(wr * 64 + fr, fq * 8), boff = lds_byte(wc * 32 + fr, fq * 8);
#define PG8_SA(b, h) (((b) * 2 + (h)) * HTB)
#define PG8_SB(b, h) ((4 + (b) * 2 + (h)) * HTB)
#define PG8_STAGE_B(bufoff, gbase) do { _Pragma("unroll") for (int _i = 0; _i < 2; ++_i) \
        __builtin_amdgcn_global_load_lds((const unsigned*)((const char*)(gbase) + voffB[_i]), (LAS unsigned*)(lds + (bufoff) + ldsw + _i * 8192), 16, 0, 0); } while (0)
#define PG8_STAGE_A(bufoff, gbase, hf, o0, o1) do { if constexpr (Sched::GATHER) { \
        __builtin_amdgcn_global_load_lds((const unsigned*)((const char*)(gbase) + (o0)), (LAS unsigned*)(lds + (bufoff) + ldsw), 16, 0, 0); \
        __builtin_amdgcn_global_load_lds((const unsigned*)((const char*)(gbase) + (o1)), (LAS unsigned*)(lds + (bufoff) + ldsw + 8192), 16, 0, 0); } else { \
        __builtin_amdgcn_global_load_lds((const unsigned*)((const char*)(gbase) + (hf) * hstepB + voffA[0]), (LAS unsigned*)(lds + (bufoff) + ldsw), 16, 0, 0); \
        __builtin_amdgcn_global_load_lds((const unsigned*)((const char*)(gbase) + (hf) * hstepB + voffA[1]), (LAS unsigned*)(lds + (bufoff) + ldsw + 8192), 16, 0, 0); } } while (0)
#define PG8_LDA(dst, b, h) do { _Pragma("unroll") for (int m = 0; m < 4; ++m) { dst[m].lo = *(const LAS i32x4*)(lds + PG8_SA(b, h) + aoff + m * 2048); dst[m].hi = *(const LAS i32x4*)(lds + PG8_SA(b, h) + aoff + m * 2048 + 1024); } } while (0)
#define PG8_LDB(dst, b, h) do { _Pragma("unroll") for (int n = 0; n < 2; ++n) { dst[n].lo = *(const LAS i32x4*)(lds + PG8_SB(b, h) + boff + n * 2048); dst[n].hi = *(const LAS i32x4*)(lds + PG8_SB(b, h) + boff + n * 2048 + 1024); } } while (0)
#define PG8_MMA(ai, bj, At, Bt) do { __builtin_amdgcn_s_setprio(1); _Pragma("unroll") for (int m = 0; m < 4; ++m) _Pragma("unroll") for (int n = 0; n < 2; ++n) { \
        if constexpr (Epi::FP8) asm volatile("v_mfma_scale_f32_16x16x128_f8f6f4 %0, %1, %2, %0, %3, %4 op_sel_hi:[0,0,0]" : "+v"(acc[ai][bj][m][n]) : "v"(Bt[n]), "v"(At[m]), "v"(sclw_), "v"(scla_));   \
        else { const i32x4 bl_ = Bt[n].lo, bh_ = Bt[n].hi, al_ = At[m].lo, ah_ = At[m].hi;     \
               acc[ai][bj][m][n] = __builtin_amdgcn_mfma_f32_16x16x32_bf16(__builtin_bit_cast(bf16x8, bl_), __builtin_bit_cast(bf16x8, al_), acc[ai][bj][m][n], 0, 0, 0); \
               acc[ai][bj][m][n] = __builtin_amdgcn_mfma_f32_16x16x32_bf16(__builtin_bit_cast(bf16x8, bh_), __builtin_bit_cast(bf16x8, ah_), acc[ai][bj][m][n], 0, 0, 0); } } __builtin_amdgcn_s_setprio(0); } while (0)
#define PG8_WAIT_V(n) asm volatile("s_waitcnt vmcnt(" #n ")" ::: "memory")
#define PG8_WAIT_L(n) asm volatile("s_waitcnt lgkmcnt(" #n ")" ::: "memory")
#define PG8_BAR __builtin_amdgcn_s_barrier()
#define PG8_SCHED __builtin_amdgcn_sched_barrier(0)
    Unit cur, nxt; int ui = 0;
    if (!S.next(0, cur)) return;
    f32x4 acc[2][2][4][2];
#pragma unroll
    for (int a = 0; a < 2; ++a)
#pragma unroll
        for (int b = 0; b < 2; ++b)
#pragma unroll
            for (int m = 0; m < 4; ++m)
#pragma unroll
                for (int n = 0; n < 2; ++n) acc[a][b][m][n] = (f32x4){0.f, 0.f, 0.f, 0.f};
    i32x8 At[4], B0[2], B1[2];
    int sclw_ = Epi::SCALE_W, scla_ = Epi::SCALE_A; asm volatile("" : "+v"(sclw_), "+v"(scla_));
    PG8_STAGE_B(PG8_SB(0, 0), cur.B); PG8_STAGE_B(PG8_SB(0, 1), cur.B + hstepW); PG8_STAGE_A(PG8_SA(0, 0), cur.A, 0, cur.a00, cur.a01); PG8_STAGE_A(PG8_SA(0, 1), cur.A, 1, cur.a10, cur.a11);
    if (wr == 1) PG8_BAR;
    PG8_WAIT_V(2); PG8_BAR;
    PG8_STAGE_B(PG8_SB(1, 0), cur.B + kstep); PG8_STAGE_A(PG8_SA(1, 0), cur.A + kstep, 0, cur.a00, cur.a01); PG8_STAGE_B(PG8_SB(1, 1), cur.B + hstepW + kstep);
    PG8_WAIT_V(6); PG8_BAR;
    for (;;) {
        const bool has_next = S.next(ui + 1, nxt);
        const char* nA = has_next ? nxt.A : cur.A; const char* nB = has_next ? nxt.B : cur.B;
        if constexpr (Sched::GATHER) {
            u32x4 nv; nv.x = has_next ? nxt.a00 : cur.a00; nv.y = has_next ? nxt.a01 : cur.a01; nv.z = has_next ? nxt.a10 : cur.a10; nv.w = has_next ? nxt.a11 : cur.a11;
            *(LAS u32x4*)(lds + NXT_SLOT_OFF + tid * 16) = nv; nxt.a00 = 0u; nxt.a01 = 0u; nxt.a10 = 0u; nxt.a11 = 0u;
        }
#pragma unroll 1
        for (int t = 0; t < nt; t += 2) {
            const bool last = (t == nt - 2);
            const char* a1 = cur.A + (size_t)(t + 1) * kstep;
            const char* a2 = last ? nA : cur.A + (size_t)(t + 2) * kstep; const char* b2 = last ? nB : cur.B + (size_t)(t + 2) * kstep;
            const char* a3 = a2 + kstep; const char* b3 = b2 + kstep;
            unsigned x00 = cur.a00, x01 = cur.a01, x10 = cur.a10, x11 = cur.a11;
            if constexpr (Sched::GATHER) { if (last) { const u32x4 nv = *(const LAS u32x4*)(lds + NXT_SLOT_OFF + tid * 16); x00 = nv.x; x01 = nv.y; x10 = nv.z; x11 = nv.w; } }
            PG8_LDB(B0, 0, 0); PG8_LDB(B1, 0, 1); PG8_SCHED; PG8_LDA(At, 0, 0); PG8_STAGE_A(PG8_SA(1, 1), a1, 1, cur.a10, cur.a11);
            PG8_WAIT_V(8); PG8_WAIT_L(0); PG8_BAR; PG8_MMA(0, 0, At, B0); PG8_MMA(0, 1, At, B1); PG8_BAR; PG8_SCHED;
            PG8_LDA(At, 0, 1); PG8_STAGE_B(PG8_SB(0, 0), b2); PG8_STAGE_B(PG8_SB(0, 1), b2 + hstepW); PG8_STAGE_A(PG8_SA(0, 0), a2, 0, x00, x01);
            PG8_WAIT_V(8); PG8_WAIT_L(0); PG8_BAR; PG8_MMA(1, 0, At, B0); PG8_MMA(1, 1, At, B1); PG8_BAR; PG8_SCHED;
            PG8_LDB(B0, 1, 0); PG8_LDB(B1, 1, 1); PG8_SCHED; PG8_LDA(At, 1, 0); PG8_STAGE_A(PG8_SA(0, 1), a2, 1, x10, x11);
            PG8_WAIT_V(8); PG8_WAIT_L(0); PG8_BAR; PG8_MMA(0, 0, At, B0); PG8_MMA(0, 1, At, B1); PG8_BAR; PG8_SCHED;
            PG8_LDA(At, 1, 1); PG8_STAGE_B(PG8_SB(1, 0), b3); PG8_STAGE_B(PG8_SB(1, 1), b3 + hstepW); PG8_STAGE_A(PG8_SA(1, 0), a3, 0, x00, x01);
            PG8_WAIT_V(8); PG8_WAIT_L(0); PG8_BAR; PG8_MMA(1, 0, At, B0); PG8_MMA(1, 1, At, B1); PG8_BAR; PG8_SCHED;
        }
        if constexpr (Epi::FP8) asm volatile("s_nop 15\n\ts_nop 7" ::: "memory");
        if constexpr (ALIGN_EPI) { if (wr == 0) PG8_BAR; }
        E(acc, cur, wr, wc, fr, fq);
        if (!has_next) break;
#pragma unroll
        for (int a = 0; a < 2; ++a)
#pragma unroll
            for (int b = 0; b < 2; ++b)
#pragma unroll
                for (int m = 0; m < 4; ++m)
#pragma unroll
                    for (int n = 0; n < 2; ++n) acc[a][b][m][n] = (f32x4){0.f, 0.f, 0.f, 0.f};
        cur = nxt; ++ui;
        if constexpr (Sched::GATHER) { const u32x4 nv = *(const LAS u32x4*)(lds + NXT_SLOT_OFF + tid * 16); cur.a00 = nv.x; cur.a01 = nv.y; cur.a10 = nv.z; cur.a11 = nv.w; }
        if constexpr (ALIGN_EPI) { if (wr == 1) PG8_BAR; }
    }
    PG8_WAIT_V(0);
    if constexpr (!ALIGN_EPI) { if (wr == 0) PG8_BAR; }
    PG8_BAR;
#undef PG8_SA
#undef PG8_SB
#undef PG8_STAGE_A
#undef PG8_STAGE_B
#undef PG8_LDA
#undef PG8_LDB
#undef PG8_MMA
#undef PG8_WAIT_V
#undef PG8_WAIT_L
#undef PG8_BAR
#undef PG8_SCHED
}
}

#define XB_TMO      128
#define XB_XCNT(j)  (256  + 64 * (j))
#define XB_XSUB(j)  (1280 + 64 * (j))
#define XB_XGEN(j)  (2304 + 64 * (j))
#define XB_TOP      3328
#define XB_TOPGEN   3392
#define XCD_BAR_WORDS 3456
#define XB_SPIN_CAP (1u << 22)
__device__ __forceinline__ unsigned xb_ld(unsigned* p)              { return __hip_atomic_load(p, __ATOMIC_RELAXED, __HIP_MEMORY_SCOPE_AGENT); }
__device__ __forceinline__ unsigned xb_add(unsigned* p, unsigned v) { return __hip_atomic_fetch_add(p, v, __ATOMIC_RELAXED, __HIP_MEMORY_SCOPE_AGENT); }
__device__ __forceinline__ unsigned xb_xcc_id() { return (unsigned)__builtin_amdgcn_s_getreg((3 << 11) | 20) & 0xFu; }
#define XB_SPIN(cond, bar) do { unsigned _sp = 0; while (cond) { __builtin_amdgcn_s_sleep(1); \
    if ((++_sp & 255u) == 0u) { if (xb_ld(&(bar)[XB_TMO])) break; if (_sp > XB_SPIN_CAP) { atomicAdd(&(bar)[XB_TMO], 1u); break; } } } } while (0)
struct XcdBarrier { unsigned* bar; unsigned x; volatile LAS unsigned* st; };
__device__ __forceinline__ XcdBarrier xcd_barrier_post(unsigned* bar, volatile LAS unsigned* st) {
    XcdBarrier b; b.bar = bar; b.x = xb_xcc_id(); b.st = st;
    if (threadIdx.x == 0) (void)xb_add(&bar[XB_XCNT(b.x)], 1u);
    return b;
}
__device__ __forceinline__ void xcd_barrier_complete(unsigned* bar, unsigned x, unsigned& nloc, unsigned& nx) {
    const unsigned G = gridDim.x * gridDim.y * gridDim.z;
    unsigned sum, cnt, mine, sp = 0u;
    for (;;) {
        sum = 0u; cnt = 0u; mine = 0u;
#pragma unroll
        for (unsigned j = 0; j < 16; ++j) { const unsigned c = xb_ld(&bar[XB_XCNT(j)]); sum += c; cnt += (c > 0u) ? 1u : 0u; mine = (j == x) ? c : mine; }
        if (sum == G) break;
        __builtin_amdgcn_s_sleep(1);
        if ((++sp & 255u) == 0u) { if (xb_ld(&bar[XB_TMO])) break; if (sp > XB_SPIN_CAP) { atomicAdd(&bar[XB_TMO], 1u); break; } }
    }
    nloc = mine > 0u ? mine : 1u; nx = cnt > 0u ? cnt : 1u;
}
__device__ __forceinline__ void xcd_barrier(const XcdBarrier& b) {
    asm volatile("s_waitcnt vmcnt(0)" ::: "memory");
    __syncthreads();
    if (threadIdx.x == 0) {
        unsigned* bar = b.bar;
        __builtin_amdgcn_s_waitcnt(0);
        unsigned nloc = b.st[0], nx = b.st[1];
        if (nloc == 0u) { xcd_barrier_complete(bar, b.x, nloc, nx); b.st[0] = nloc; b.st[1] = nx; }
        const unsigned old = xb_add(&bar[XB_XSUB(b.x)], 1u);
        const unsigned gen = old / nloc;
        if (old + 1u == (gen + 1u) * nloc) {
            __builtin_amdgcn_fence(__ATOMIC_RELEASE, "agent");
            asm volatile("s_waitcnt vmcnt(0)" ::: "memory");
            const unsigned og = xb_add(&bar[XB_TOP], 1u);
            const unsigned tg = og / nx;
            if (og + 1u == (tg + 1u) * nx) xb_add(&bar[XB_TOPGEN], 1u);
            else XB_SPIN(xb_ld(&bar[XB_TOPGEN]) == tg, bar);
            __builtin_amdgcn_fence(__ATOMIC_ACQUIRE, "agent");
            xb_add(&bar[XB_XGEN(b.x)], 1u);
            asm volatile("s_waitcnt vmcnt(0)" ::: "memory");
        } else {
            XB_SPIN(xb_ld(&bar[XB_XGEN(b.x)]) == gen, bar);
            __builtin_amdgcn_fence(__ATOMIC_ACQUIRE, "agent");
            asm volatile("s_waitcnt vmcnt(0)" ::: "memory");
        }
    }
    __syncthreads();
}

struct Args {
    const float* in[19];
    float* out; unsigned char* ws;
    int ph_lo, ph_hi, use_bar, rep;
};
struct Ctx {
    const float *x, *mem, *w_in, *b_in, *w_mem_kv, *sinks, *rel_bias, *lb_logits, *hnorm, *w_out, *ln1g, *ln1b, *w_router, *rbias, *w_gate, *w_up, *w_down, *ln2g, *ln2b;
    float* xcur;
    unsigned char* ws;
    unsigned* ctl;
    bf16 *Win, *Wout, *Wmem, *W1, *W2, *xb, *proj, *ys, *mix, *hmid, *memkv, *memb;
    bf16* hpre; float* biastab; float* lbtab; int* list; u32x4* tokrec; float* hst; unsigned char* xb8;
    int vcu, G, rep;
};

__constant__ unsigned char T5_BUCKET[128] = {0, 1, 2, 3, 4, 5, 6, 7, 8, 9, 10, 11, 12, 13, 14, 15, 16, 16, 16, 17, 17, 18, 18, 18, 19, 19, 19, 20, 20, 20, 20, 21, 21, 21, 21, 22, 22, 22, 22, 22, 23, 23, 23, 23, 23, 23, 24, 24, 24, 24, 24, 24, 25, 25, 25, 25, 25, 25, 25, 26, 26, 26, 26, 26, 26, 26, 26, 27, 27, 27, 27, 27, 27, 27, 27, 27, 27, 28, 28, 28, 28, 28, 28, 28, 28, 28, 28, 29, 29, 29, 29, 29, 29, 29, 29, 29, 29, 29, 29, 30, 30, 30, 30, 30, 30, 30, 30, 30, 30, 30, 30, 30, 30, 31, 31, 31, 31, 31, 31, 31, 31, 31, 31, 31, 31, 31, 31, 31};

struct TrItem { const float* src; bf16* dst; int N, K; float fp8s; };
__device__ __forceinline__ bool p0_item(const Ctx& C, int it, TrItem& t) {
    constexpr int I_IN = DEPTH * 16 * 64, I_OUT = DEPTH * 16 * 32, I_MEM = DEPTH * 16 * 16, I_G = 64 * 16 * 16, I_D = 64 * 8 * 32;
    constexpr int NITEMS = I_IN + I_OUT + I_MEM + 2 * I_G + I_D;
    if (it >= NITEMS) return false;
    int r = it;
    if (r < I_IN) { const int l = r / 1024, q = r % 1024, kb = q / 64, nb = q % 64; t.fp8s = 32.f; t.N = INW; t.K = DM; t.src = C.w_in + (size_t)l * DM * INW + (size_t)(64 * kb) * INW + 32 * nb; t.dst = (bf16*)((unsigned char*)C.Win + (size_t)l * INW * DM + (size_t)(32 * nb) * DM + 64 * kb); return true; } r -= I_IN;
    if (r < I_OUT) { const int l = r / 512, q = r % 512, kb = q / 32, nb = q % 32; t.fp8s = 64.f; t.N = DM; t.K = MIXW; t.src = C.w_out + (size_t)l * MIXW * DM + (size_t)(64 * kb) * DM + 32 * nb; t.dst = (bf16*)((unsigned char*)C.Wout + (size_t)l * DM * MIXW + (size_t)(32 * nb) * MIXW + 64 * kb); return true; } r -= I_OUT;
    if (r < I_MEM) { const int l = r / 256, q = r % 256, kb = q / 16, nb = q % 16; t.fp8s = 32.f; t.N = 512; t.K = DM; t.src = C.w_mem_kv + (size_t)l * DM * 512 + (size_t)(64 * kb) * 512 + 32 * nb; t.dst = (bf16*)((unsigned char*)C.Wmem + (size_t)l * 512 * DM + (size_t)(32 * nb) * DM + 64 * kb); return true; } r -= I_MEM;
    if (r < 2 * I_G) { const int up = r >= I_G; if (up) r -= I_G; const int le = r / 256, q = r % 256, kb = q / 16, nb = q % 16; const int n0 = 32 * nb;
        t.N = DE; t.K = DM; t.src = (up ? C.w_up : C.w_gate) + (size_t)le * DM * DE + (size_t)(64 * kb) * DE + n0; t.fp8s = 32.f; t.dst = (bf16*)((unsigned char*)C.W1 + (size_t)le * 1024 * DM + (size_t)((n0 >> 7) * 256 + (up ? 128 : 0) + (n0 & 127)) * DM + 64 * kb); return true; } r -= 2 * I_G;
    { const int le = r / 256, q = r % 256, kb = q / 32, nb = q % 32; t.N = DM; t.K = DE; t.src = C.w_down + (size_t)le * DE * DM + (size_t)(64 * kb) * DM + 32 * nb; t.fp8s = 64.f; t.dst = (bf16*)((unsigned char*)C.W2 + (size_t)le * DM * DE + (size_t)(32 * nb) * DE + 64 * kb); }
    return true;
}
__device__ __forceinline__ void p0_prologue(const Ctx& C, LAS unsigned char* lds, int wave, int lane) {
    LAS float* scr = (LAS float*)(lds + wave * 16384);
    const int gw = C.vcu * NWAVES + wave, NGW = C.G * NWAVES;
    {
        TrItem cur, nxt; float va[32], vb[32];
        bool have = p0_item(C, gw, cur);
        if (have) {
#pragma unroll
            for (int i = 0; i < 32; ++i) va[i] = cur.src[(size_t)(2 * i + (lane >> 5)) * cur.N + (lane & 31)];
        }
        for (int it = gw; have; it += NGW) {
            const bool hn = p0_item(C, it + NGW, nxt);
            if (hn) {
#pragma unroll
                for (int i = 0; i < 32; ++i) vb[i] = nxt.src[(size_t)(2 * i + (lane >> 5)) * nxt.N + (lane & 31)];
            }
#pragma unroll
            for (int i = 0; i < 32; ++i) scr[(2 * i + (lane >> 5)) * 33 + (lane & 31)] = va[i];
            const int c = lane & 7;
#pragma unroll
            for (int j = 0; j < 4; ++j) { const int n = (lane >> 3) + 8 * j; const LAS float* s = scr + (8 * c) * 33 + n;
                if (cur.fp8s != 0.f) { const float sc = cur.fp8s;
                    int w0 = __builtin_amdgcn_cvt_pk_fp8_f32(s[0 * 33] * sc, s[1 * 33] * sc, 0, false); w0 = __builtin_amdgcn_cvt_pk_fp8_f32(s[2 * 33] * sc, s[3 * 33] * sc, w0, true);
                    int w1 = __builtin_amdgcn_cvt_pk_fp8_f32(s[4 * 33] * sc, s[5 * 33] * sc, 0, false); w1 = __builtin_amdgcn_cvt_pk_fp8_f32(s[6 * 33] * sc, s[7 * 33] * sc, w1, true);
                    u32x2 o8; o8.x = (unsigned)w0; o8.y = (unsigned)w1;
                    *(u32x2*)((unsigned char*)cur.dst + (size_t)n * cur.K + 8 * c) = o8; }
                else { u32x4 o; o.x = pk2(s[0 * 33], s[1 * 33]); o.y = pk2(s[2 * 33], s[3 * 33]); o.z = pk2(s[4 * 33], s[5 * 33]); o.w = pk2(s[6 * 33], s[7 * 33]);
                    *(u32x4*)(cur.dst + (size_t)n * cur.K + 8 * c) = o; } }
#pragma unroll
            for (int i = 0; i < 32; ++i) va[i] = vb[i];
            cur = nxt; have = hn;
        }
    }
    for (int m = gw; m < NTOK + NB * MEMLEN; m += NGW) {
        const bool ism = m >= NTOK; const int r = ism ? m - NTOK : m;
        const f32x4* src = (const f32x4*)((ism ? C.mem : C.x) + (size_t)r * DM) + lane;
        f32x4 v[4];
#pragma unroll
        for (int j = 0; j < 4; ++j) v[j] = src[64 * j];
        unsigned* q8 = (unsigned*)((ism ? (unsigned char*)C.memb : C.xb8) + (size_t)r * DM) + lane;
        unsigned* ql = (unsigned*)((unsigned char*)C.xb + (size_t)r * DM) + lane;
#pragma unroll
        for (int j = 0; j < 4; ++j) { unsigned hi, lo; split_fp8(v[j], hi, lo); q8[64 * j] = hi; if (!ism) ql[64 * j] = lo; }
    }
    if (blockIdx.x == 0) {
        const int tid = wave * 64 + lane;
        for (int i = tid; i < 8 * 128; i += NTHR) { const int h = i >> 7, d = i & 127; C.biastab[i] = C.rel_bias[(int)T5_BUCKET[d] * 8 + h]; }
        if (tid < 256) { float v0 = C.lb_logits[tid], v1 = C.lb_logits[256 + tid], v2 = C.lb_logits[512 + tid], v3 = C.lb_logits[768 + tid];
            const float mx = fmaxf(fmaxf(v0, v1), fmaxf(v2, v3)); v0 = __expf(v0 - mx); v1 = __expf(v1 - mx); v2 = __expf(v2 - mx); v3 = __expf(v3 - mx);
            const float inv = 1.f / (v0 + v1 + v2 + v3);
            C.lbtab[tid] = 0.f; C.lbtab[256 + tid] = v1 * inv; C.lbtab[512 + tid] = (v1 + v2) * inv; C.lbtab[768 + tid] = (v1 + v2 + v3) * inv; }
    }
}

struct DenseSched {
    static constexpr bool GATHER = false;
    const char* A0; const char* B0; int nM0, nN0, K0;
    const char* A1; const char* B1; int nM1, nN1;
    int G, c;
    __device__ __forceinline__ void lane_init(int, int, int, int) {}
    __device__ __forceinline__ bool next(int i, pg8::Unit& u) const {
        const int n0 = nM0 * nN0; const int L = i * G + c; if (L >= n0 + nM1 * nN1) return false;
        int pm, pn; const char* A; const char* B; int aux;
        if (L < n0) { pg8::tile_order(L, nM0, nN0, pm, pn); A = A0; B = B0; aux = 0; }
        else { pg8::tile_order(L - n0, nM1, nN1, pm, pn); A = A1; B = B1; aux = 1; }
        u.A = A + (size_t)pm * 256 * K0; u.B = B + (size_t)pn * 256 * K0;
        u.a00 = 0u; u.a01 = 0u; u.a10 = 0u; u.a11 = 0u;
        u.row0 = pm * 256; u.col0 = pn * 256; u.aux = aux; return true;
    }
};
template <bool GATHER_> struct MoeSched {
    static constexpr bool GATHER = GATHER_;
    const char* A; const char* Bl; int K; size_t bstride;
    const int* list; const LAS int* tb;
    int g0, g1, gU, mode; int R0, C0, R1, C1;
    __device__ __forceinline__ void lane_init(int r0, int c0, int r1, int c1) { R0 = r0; C0 = c0; R1 = r1; C1 = c1; }
    __device__ __forceinline__ bool next(int i, pg8::Unit& u) const {
        int g;
        if (mode == 0) { g = g0 + i * g1; if (g >= gU) return false; }
        else {
            const int c = g0, E = g1;
            if (c < E) { if (i == 0) g = 1024 + c; else if (i <= 2) g = c + (i - 1) * E; else return false; }
            else { g = 2 * E + (c - E) + i * (256 - E); if (g >= gU) return false; }
        }
        const int tile = g >> 2, pn = g & 3;
        int e = 0;
#pragma unroll
        for (int j = 1; j < 16; ++j) e += (tile >= tb[j]) ? 1 : 0;
        e = __builtin_amdgcn_readfirstlane(e);
        u.B = Bl + (size_t)e * bstride + (size_t)pn * 256 * K;
        u.A = A;
        if (GATHER) {
            const int p0 = (tile - __builtin_amdgcn_readfirstlane(tb[e])) * 256, cnt = __builtin_amdgcn_readfirstlane(tb[17 + e]); const int* le = list + (size_t)e * LCAP;
            const int cm = cnt - 1;
            const int t00 = le[min(p0 + R0, cm)], t01 = le[min(p0 + R1, cm)], t10 = le[min(p0 + 128 + R0, cm)], t11 = le[min(p0 + 128 + R1, cm)];
            u.a00 = (unsigned)t00 * K + 2 * C0; u.a01 = (unsigned)t01 * K + 2 * C1; u.a10 = (unsigned)t10 * K + 2 * C0; u.a11 = (unsigned)t11 * K + 2 * C1;
        } else {
            u.A = A + (size_t)tile * 256 * K; u.a00 = 0u; u.a01 = 0u; u.a10 = 0u; u.a11 = 0u;
        }
        u.row0 = tile * 256; u.col0 = pn * 256; u.aux = e; return true;
    }
};
struct EpiProj {
    static constexpr bool PERM = true, PERM16 = true, FP8 = true; static constexpr int SCALE_W = 0x7A7A7A7A  , SCALE_A = 0x7C7C7C7C  ;
    unsigned char* O0; const float* bias; unsigned char* O1;
    __device__ __forceinline__ void operator()(const f32x4 (&acc)[2][2][4][2], const pg8::Unit& u, int wr, int wc, int fr, int fq) const {
        unsigned char* base = u.aux ? O1 : O0; const int row0 = u.row0 + wr * 64 + fr, col0 = u.col0 + wc * 64 + 16 * fq;
        f32x4 bv[2][2];
#pragma unroll
        for (int bj = 0; bj < 2; ++bj)
#pragma unroll
            for (int n = 0; n < 2; ++n) bv[bj][n] = u.aux ? (f32x4){0.f, 0.f, 0.f, 0.f} : *(const f32x4*)(bias + col0 + 8 * bj + 4 * n);
#pragma unroll
        for (int ai = 0; ai < 2; ++ai)
#pragma unroll
            for (int m = 0; m < 4; ++m) { unsigned char* rowp = base + (size_t)(row0 + ai * 128 + m * 16) * INW + col0;
                u32x4 w; w.x = pk_fp8x4((acc[ai][0][m][0] + bv[0][0]) * 8.f); w.y = pk_fp8x4((acc[ai][0][m][1] + bv[0][1]) * 8.f); w.z = pk_fp8x4((acc[ai][1][m][0] + bv[1][0]) * 8.f); w.w = pk_fp8x4((acc[ai][1][m][1] + bv[1][1]) * 8.f);
                *(u32x4*)rowp = w; }
    }
};
struct EpiOut {
    static constexpr bool PERM = true, PERM16 = true, FP8 = true; static constexpr int SCALE_W = 0x79797979  , SCALE_A = 0x7C7C7C7C  ;
    unsigned char* H;
    __device__ __forceinline__ void operator()(const f32x4 (&acc)[2][2][4][2], const pg8::Unit& u, int wr, int wc, int fr, int fq) const {
        const int row0 = u.row0 + wr * 64 + fr, col0 = u.col0 + wc * 64 + 16 * fq;
#pragma unroll
        for (int ai = 0; ai < 2; ++ai)
#pragma unroll
            for (int m = 0; m < 4; ++m) { const size_t off = (size_t)(row0 + ai * 128 + m * 16) * DM + col0;
                u32x4 w; w.x = pk_fp8x4(acc[ai][0][m][0] * 64.f); w.y = pk_fp8x4(acc[ai][0][m][1] * 64.f); w.z = pk_fp8x4(acc[ai][1][m][0] * 64.f); w.w = pk_fp8x4(acc[ai][1][m][1] * 64.f);
                *(u32x4*)(H + off) = w; }
    }
};
struct EpiG1 {
    static constexpr bool PERM = true, PERM16 = false, FP8 = true; static constexpr int SCALE_W = 0x7A7A7A7A  , SCALE_A = 0x7C7C7C7C  ;
    unsigned char* O;
    __device__ __forceinline__ void operator()(const f32x4 (&acc)[2][2][4][2], const pg8::Unit& u, int wr, int wc, int fr, int fq) const {
        const int row0 = u.row0 + wr * 64 + fr, col0 = (u.col0 >> 1) + wc * 32 + 8 * fq;
#pragma unroll
        for (int ai = 0; ai < 2; ++ai)
#pragma unroll
            for (int m = 0; m < 4; ++m) { unsigned char* rowp = O + (size_t)(row0 + ai * 128 + m * 16) * DE + col0;
                float hv[8];
#pragma unroll
                for (int n = 0; n < 2; ++n)
#pragma unroll
                    for (int j = 0; j < 4; ++j) { const float gte = acc[ai][0][m][n][j], up = acc[ai][1][m][n][j]; hv[n * 4 + j] = gte * frcp(1.f + __expf(-gte)) * up * 8.f; }
                int w0 = __builtin_amdgcn_cvt_pk_fp8_f32(hv[0], hv[1], 0, false); w0 = __builtin_amdgcn_cvt_pk_fp8_f32(hv[2], hv[3], w0, true);
                int w1 = __builtin_amdgcn_cvt_pk_fp8_f32(hv[4], hv[5], 0, false); w1 = __builtin_amdgcn_cvt_pk_fp8_f32(hv[6], hv[7], w1, true);
                u32x2 w; w.x = (unsigned)w0; w.y = (unsigned)w1;
                *(u32x2*)rowp = w; }
    }
};
struct EpiG2 {
    static constexpr bool PERM = true, PERM16 = true, FP8 = true; static constexpr int SCALE_W = 0x79797979  , SCALE_A = 0x7C7C7C7C  ;
    unsigned char* O;
    __device__ __forceinline__ void operator()(const f32x4 (&acc)[2][2][4][2], const pg8::Unit& u, int wr, int wc, int fr, int fq) const {
        const int row0 = u.row0 + wr * 64 + fr, col0 = u.col0 + wc * 64 + 16 * fq;
#pragma unroll
        for (int ai = 0; ai < 2; ++ai)
#pragma unroll
            for (int m = 0; m < 4; ++m) { unsigned char* rowp = O + (size_t)(row0 + ai * 128 + m * 16) * DM + col0;
                u32x4 w; w.x = pk_fp8x4(acc[ai][0][m][0] * 16.f); w.y = pk_fp8x4(acc[ai][0][m][1] * 16.f); w.z = pk_fp8x4(acc[ai][1][m][0] * 16.f); w.w = pk_fp8x4(acc[ai][1][m][1] * 16.f);
                *(u32x4*)rowp = w; }
    }
};

constexpr int AT_KOFF = 0, AT_VOFF = 36864, AT_BOFF = 73728, AT_OOFF = 77824;
template <bool SWA>
__device__ __forceinline__ void attn_item(const Ctx& C, LAS unsigned char* lds, int l, int item, int tid, int wave, int lane) {
    const int tk = lane & 15, g = lane >> 4;
    int b, nb = 0, kvh = 0, hm = 0, qb = 0;
    const unsigned char *Kg, *Vg; size_t kpitch;
    if (SWA) { b = item >> 6; nb = (item >> 1) & 31; kvh = item & 1;
        Kg = (const unsigned char*)C.proj + ((size_t)b * SEQ + (size_t)(nb - 1) * 128) * INW + C_SK + kvh * 64; Vg = Kg + (C_SV - C_SK); kpitch = INW; }
    else { b = item >> 5; hm = (item >> 3) & 3; qb = item & 7;
        Kg = (const unsigned char*)C.memkv + (size_t)b * MEMLEN * 2048 + l * 512 + hm * 64; Vg = Kg + 256; kpitch = 2048; }
    __syncthreads();
#pragma unroll
    for (int i = 0; i < 4; ++i) { const int c = tid + 512 * i, key = c >> 3, part = c & 7;
        u32x2 k8 = {0u, 0u}, v8 = {0u, 0u};
        if (!SWA || nb > 0 || key >= 128) { k8 = *(const u32x2*)(Kg + (size_t)key * kpitch + part * 8); v8 = *(const u32x2*)(Vg + (size_t)key * kpitch + part * 8); }
        *(LAS u32x4*)(lds + AT_KOFF + key * 144 + part * 16) = fp8x8_to_bf16x8(k8); *(LAS u32x4*)(lds + AT_VOFF + key * 144 + part * 16) = fp8x8_to_bf16x8(v8); }
    if (SWA) ((LAS float*)(lds + AT_BOFF))[tid] = C.biastab[(kvh * 4 + (tid >> 7)) * 128 + (tid & 127)] * 1.44269504f;
    __syncthreads();
    int hq = 0; float sink = 0.f; size_t qrow_base; int qcol, ocol, i0w = 0;
    if (SWA) { hq = kvh * 4 + (wave >> 1); sink = C.sinks[l * 8 + hq]; i0w = (wave & 1) * 64; qrow_base = (size_t)b * SEQ + nb * 128 + i0w; qcol = C_SQ + hq * 64; ocol = hq * 64; }
    else { qrow_base = (size_t)b * SEQ + qb * 512 + wave * 64; qcol = C_MQ + hm * 64; ocol = 768 + hm * 64; }
    const LAS float* biasL = (const LAS float*)(lds + AT_BOFF) + (wave >> 1) * 128;
    const LAS unsigned char* kbase = lds + AT_KOFF + tk * 144 + g * 16;
    const LAS unsigned char* vbase = lds + AT_VOFF + (4 * g + (tk >> 2)) * 144 + (tk & 3) * 8;
#pragma unroll 1
    for (int rt = 0; rt < 4; ++rt) {
        const size_t qrow = qrow_base + rt * 16;
        const unsigned char* qp = (const unsigned char*)C.proj + (qrow + tk) * INW + qcol + 8 * g;
        const bf16x8 q0 = __builtin_bit_cast(bf16x8, fp8x8_to_bf16x8(*(const u32x2*)qp)), q1 = __builtin_bit_cast(bf16x8, fp8x8_to_bf16x8(*(const u32x2*)(qp + 32)));
        constexpr int NT = SWA ? 10 : 16;
        const int t0 = SWA ? ((i0w >> 4) + rt) : 0;
        f32x4 st[NT];
#pragma unroll
        for (int t = 0; t < NT; ++t) {
            const int tc = SWA ? min(t0 + t, 15) : t;
            const bf16x8 k0 = *(const LAS bf16x8*)(kbase + tc * 16 * 144), k1 = *(const LAS bf16x8*)(kbase + tc * 16 * 144 + 64);
            f32x4 a = {0.f, 0.f, 0.f, 0.f};
            a = __builtin_amdgcn_mfma_f32_16x16x32_bf16(k0, q0, a, 0, 0, 0);
            st[t] = __builtin_amdgcn_mfma_f32_16x16x32_bf16(k1, q1, a, 0, 0, 0);
        }
        constexpr float C2 = 0.125f * 1.44269504f * (1.f / 64.f);
        float mx2, sum = 0.f;
        if (SWA) {
            const float sink2 = sink * 1.44269504f;
            const int iq = i0w + rt * 16 + tk;
            const int d0 = iq + 128 - 16 * t0 - 4 * g;
            const unsigned lim = (nb > 0) ? 128u : (unsigned)min(128, iq + 1);
            const LAS float* bl = biasL + (d0 - 16 * (NT - 1) - 3);
            float m4[4] = {sink2, sink2, sink2, sink2};
#pragma unroll
            for (int t = 0; t < NT; ++t)
#pragma unroll
                for (int r = 0; r < 4; ++r) {
                    const unsigned dist = (unsigned)(d0 - 16 * t - r);
                    const float xv = (dist < lim) ? __builtin_fmaf(st[t][r], C2, bl[16 * (NT - 1 - t) + (3 - r)]) : -INFINITY;
                    st[t][r] = xv; m4[r] = fmaxf(m4[r], xv);
                }
            mx2 = fmaxf(fmaxf(m4[0], m4[1]), fmaxf(m4[2], m4[3]));
            mx2 = xmax16(mx2); mx2 = xmax32(mx2);
            float s4[4] = {0.f, 0.f, 0.f, 0.f};
#pragma unroll
            for (int t = 0; t < NT; ++t)
#pragma unroll
                for (int r = 0; r < 4; ++r) { const float p = __builtin_amdgcn_exp2f(st[t][r] - mx2); st[t][r] = p; s4[r] += p; }
            sum = (s4[0] + s4[1]) + (s4[2] + s4[3]);
            sum = xsum16(sum); sum = xsum32(sum);
            sum += __builtin_amdgcn_exp2f(sink2 - mx2);
        } else {
            float m4[4] = {st[0][0], st[0][1], st[0][2], st[0][3]};
#pragma unroll
            for (int t = 1; t < NT; ++t)
#pragma unroll
                for (int r = 0; r < 4; ++r) m4[r] = fmaxf(m4[r], st[t][r]);
            float mr = fmaxf(fmaxf(m4[0], m4[1]), fmaxf(m4[2], m4[3]));
            mr = xmax16(mr); mr = xmax32(mr);
            const float nm = -mr * C2;
            float s4[4] = {0.f, 0.f, 0.f, 0.f};
#pragma unroll
            for (int t = 0; t < NT; ++t)
#pragma unroll
                for (int r = 0; r < 4; ++r) { const float p = __builtin_amdgcn_exp2f(__builtin_fmaf(st[t][r], C2, nm)); st[t][r] = p; s4[r] += p; }
            sum = (s4[0] + s4[1]) + (s4[2] + s4[3]);
            sum = xsum16(sum); sum = xsum32(sum);
        }
        const float inv = frcp(sum);
        f32x4 o[4];
#pragma unroll
        for (int n = 0; n < 4; ++n) o[n] = (f32x4){0.f, 0.f, 0.f, 0.f};
#pragma unroll
        for (int s = 0; s < NT / 2; ++s) {
            const f32x4 pa = st[2 * s] * inv, pb = st[2 * s + 1] * inv;
            const bf16x8 pfrag = mk8(pk2(pa[0], pa[1]), pk2(pa[2], pa[3]), pk2(pb[0], pb[1]), pk2(pb[2], pb[3]));
            const int ta = SWA ? min(t0 + 2 * s, 15) : 2 * s, tb2 = SWA ? min(t0 + 2 * s + 1, 15) : 2 * s + 1;
#pragma unroll
            for (int n = 0; n < 4; ++n) {
                const s16x4 lo = ld_tr(vbase + (16 * ta) * 144 + n * 32), hi = ld_tr(vbase + (16 * tb2) * 144 + n * 32);
                const bf16x8 vf = {lo[0], lo[1], lo[2], lo[3], hi[0], hi[1], hi[2], hi[3]};
                o[n] = __builtin_amdgcn_mfma_f32_16x16x32_bf16(pfrag, vf, o[n], 0, 0, 0);
            }
        }
        LAS unsigned char* ost = lds + AT_OOFF + wave * 2304;
#pragma unroll
        for (int r = 0; r < 4; ++r)
#pragma unroll
            for (int n = 0; n < 4; n += 2) { const unsigned w = (unsigned)__builtin_amdgcn_cvt_pk_fp8_f32(o[n][r], o[n + 1][r], 0, false);
                *(LAS unsigned char*)(ost + (4 * g + r) * 80 + 16 * n + tk) = (unsigned char)(w & 0xffu); *(LAS unsigned char*)(ost + (4 * g + r) * 80 + 16 * (n + 1) + tk) = (unsigned char)((w >> 8) & 0xffu); }
        { const int orow = lane >> 2, part = lane & 3;
            const u32x4 w = *(const LAS u32x4*)(ost + orow * 80 + part * 16);
            *(u32x4*)((unsigned char*)C.mix + (size_t)(qrow + orow) * MIXW + ocol + part * 16) = w; }
    }
}

template <bool PB>
__device__ __forceinline__ void hgrn_item(const Ctx& C, LAS unsigned char* lds, int wv, int l, int witem, int lane) {
    LAS unsigned char* scr = lds + wv * 4608;
    const int tk = lane & 15, g = lane >> 4;
    const int bh = witem / NSEG, seg = witem % NSEG, b = bh >> 2, h = bh & 3;
    float oml[4][4];
#pragma unroll
    for (int c = 0; c < 4; ++c)
#pragma unroll
        for (int i = 0; i < 4; ++i) oml[c][i] = 1.f - C.lbtab[l * 256 + h * 64 + 16 * c + 4 * g + i];
    f32x4 S[4][4];
#pragma unroll
    for (int mt = 0; mt < 4; ++mt)
#pragma unroll
        for (int n = 0; n < 4; ++n) S[mt][n] = (f32x4){0.f, 0.f, 0.f, 0.f};
    float dseg[4][4];
#pragma unroll
    for (int c = 0; c < 4; ++c)
#pragma unroll
        for (int i = 0; i < 4; ++i) dseg[c][i] = 1.f;
    if (PB) {
        if (lane == 0 && wv == 0) {
            unsigned* cnt = C.ctl + CW_HA + (l * 32 + bh) * 64; unsigned sp = 0;
            while (__hip_atomic_load(cnt, __ATOMIC_RELAXED, __HIP_MEMORY_SCOPE_AGENT) < (unsigned)(NSEG / NWAVES)) { __builtin_amdgcn_s_sleep(2); if (++sp > (1u << 24)) break; }
            __builtin_amdgcn_fence(__ATOMIC_ACQUIRE, "agent");
            asm volatile("s_waitcnt vmcnt(0)" ::: "memory");
        }
    }
    if (PB) {
        LAS float* pl = (LAS float*)lds;
        const int seg0 = seg - wv;
        __syncthreads();
#pragma unroll 1
        for (int qq = 0; qq < 8; ++qq) {
            const int q = wv * 8 + qq, dq = 64 + (q >> 4) * 4 + (q & 3);
            const float* base = C.hst + (size_t)bh * NSEG * 80 * 64 + lane;
            float Sx = 0.f;
            for (int j0 = 0; j0 < seg0; j0 += 8) {
                float dv[8], sv[8];
#pragma unroll
                for (int j = 0; j < 8; ++j) { dv[j] = base[((size_t)(j0 + j) * 80 + dq) * 64]; sv[j] = base[((size_t)(j0 + j) * 80 + q) * 64]; }
#pragma unroll
                for (int j = 0; j < 8; ++j) Sx = Sx * dv[j] + sv[j];
            }
            float dv[8], sv[8];
#pragma unroll
            for (int j = 0; j < 8; ++j) { dv[j] = base[((size_t)(seg0 + j) * 80 + dq) * 64]; sv[j] = base[((size_t)(seg0 + j) * 80 + q) * 64]; }
#pragma unroll
            for (int j = 0; j < 8; ++j) { pl[(j * 64 + q) * 64 + lane] = Sx; Sx = Sx * dv[j] + sv[j]; }
        }
        __syncthreads();
#pragma unroll
        for (int mt = 0; mt < 4; ++mt)
#pragma unroll
            for (int n = 0; n < 4; ++n)
#pragma unroll
                for (int r = 0; r < 4; ++r) S[mt][n][r] = pl[(wv * 64 + (mt * 4 + n) * 4 + r) * 64 + lane];
        __syncthreads();
    }
    float nw[4][4];
    if (PB) {
#pragma unroll
        for (int c = 0; c < 4; ++c)
#pragma unroll
            for (int i = 0; i < 4; ++i) nw[c][i] = C.hnorm[l * 64 + 16 * c + 4 * g + i];
    }
    const size_t rowbase = (size_t)b * SEQ + (size_t)seg * CPS * 16;
    LAS unsigned char* sk = scr; LAS unsigned char* sv = scr + 2304;
    const LAS unsigned char* trk = sk + (4 * g + (tk >> 2)) * 144 + (tk & 3) * 8;
    const LAS unsigned char* trv = sv + (4 * g + (tk >> 2)) * 144 + (tk & 3) * 8;
    unsigned nzf[4], nvi[4];
    { const unsigned char* pr = (const unsigned char*)C.proj + (rowbase + tk) * INW + h * 64 + 4 * g;
#pragma unroll
        for (int c = 0; c < 4; ++c) { nzf[c] = *(const unsigned*)(pr + C_HF + 16 * c); nvi[c] = *(const unsigned*)(pr + C_HI + 16 * c); } }
#pragma unroll 1
    for (int ch = 0; ch < CPS; ++ch) {
        const size_t row = rowbase + ch * 16 + tk;
        unsigned zf_[4], vi_[4], zq_[4], gt_[4];
#pragma unroll
        for (int c = 0; c < 4; ++c) { zf_[c] = nzf[c]; vi_[c] = nvi[c]; }
        if (PB) { const unsigned char* pr = (const unsigned char*)C.proj + row * INW + h * 64 + 4 * g;
#pragma unroll
            for (int c = 0; c < 4; ++c) { zq_[c] = *(const unsigned*)(pr + C_HQ + 16 * c); gt_[c] = *(const unsigned*)(pr + C_HG + 16 * c); } }
        { const unsigned char* pr = (const unsigned char*)C.proj + (rowbase + (ch < CPS - 1 ? ch + 1 : ch) * 16 + tk) * INW + h * 64 + 4 * g;
#pragma unroll
            for (int c = 0; c < 4; ++c) { nzf[c] = *(const unsigned*)(pr + C_HF + 16 * c); nvi[c] = *(const unsigned*)(pr + C_HI + 16 * c); } }
        float kk[4][4], bcs[4][4], dreg[4][4];
#pragma unroll
        for (int c = 0; c < 4; ++c) { const f32x4 zf4 = dec_fp8x4(zf_[c]) * (0.125f * 1.44269504f);
#pragma unroll
            for (int i = 0; i < 4; ++i) {
                const float z = zf4[i];
                const float sneg = frcp(1.f + __builtin_amdgcn_exp2f(z));
                const float kv = oml[c][i] * sneg;
                kk[c][i] = kv;
                bcs[c][i] = row_scan16(__builtin_amdgcn_logf(__builtin_fmaf(-oml[c][i], sneg, 1.f)));
            } }
#pragma unroll
        for (int c = 0; c < 4; ++c)
#pragma unroll
            for (int i = 0; i < 4; ++i) { const float bl = DPPF(bcs[c][i], 0x15F); dreg[c][i] = __builtin_amdgcn_exp2f(bl); }
        unsigned kop_[4][2];
#pragma unroll
        for (int c = 0; c < 4; ++c) {
            const float e0 = kk[c][0] * __builtin_amdgcn_exp2f(-bcs[c][0]), e1 = kk[c][1] * __builtin_amdgcn_exp2f(-bcs[c][1]), e2 = kk[c][2] * __builtin_amdgcn_exp2f(-bcs[c][2]), e3 = kk[c][3] * __builtin_amdgcn_exp2f(-bcs[c][3]);
            kop_[c][0] = pk2(e0, e1); kop_[c][1] = pk2(e2, e3);
            u32x2 w; w.x = kop_[c][0]; w.y = kop_[c][1];
            *(LAS u32x2*)(sk + tk * 144 + (16 * c + 4 * g) * 2) = w;
            { const f32x4 vv = dec_fp8x4(vi_[c]) * 0.125f; u32x2 wv; wv.x = pk2(vv.x, vv.y); wv.y = pk2(vv.z, vv.w); *(LAS u32x2*)(sv + tk * 144 + (16 * c + 4 * g) * 2) = wv; }
        }
        s16x4 kT[4], vT[4];
#pragma unroll
        for (int m = 0; m < 4; ++m) { kT[m] = ld_tr(trk + m * 32); vT[m] = ld_tr(trv + m * 32); }
        f32x4 o[4];
        if (PB) {
            unsigned qop_[4][2];
#pragma unroll
            for (int c = 0; c < 4; ++c) {
                float qv[4]; const f32x4 zq8 = dec_fp8x4(zq_[c]);
#pragma unroll
                for (int i = 0; i < 4; ++i)
                    qv[i] = (zq8[i] * 0.015625f) * frcp(1.f + __builtin_amdgcn_exp2f(zq8[i] * (-0.125f * 1.44269504f))) * __builtin_amdgcn_exp2f(bcs[c][i]);
                qop_[c][0] = pk2(qv[0], qv[1]); qop_[c][1] = pk2(qv[2], qv[3]);
            }
            const bf16x8 qa = mk8(qop_[0][0], qop_[0][1], qop_[1][0], qop_[1][1]), qb2 = mk8(qop_[2][0], qop_[2][1], qop_[3][0], qop_[3][1]);
            const bf16x8 ka = mk8(kop_[0][0], kop_[0][1], kop_[1][0], kop_[1][1]), kb2 = mk8(kop_[2][0], kop_[2][1], kop_[3][0], kop_[3][1]);
            f32x4 sT = {0.f, 0.f, 0.f, 0.f};
            sT = __builtin_amdgcn_mfma_f32_16x16x32_bf16(ka, qa, sT, 0, 0, 0);
            sT = __builtin_amdgcn_mfma_f32_16x16x32_bf16(kb2, qb2, sT, 0, 0, 0);
#pragma unroll
            for (int r = 0; r < 4; ++r) if (4 * g + r > tk) sT[r] = 0.f;
            const s16x4 sT4 = mk4(pk2(sT[0], sT[1]), pk2(sT[2], sT[3]));
#pragma unroll
            for (int n = 0; n < 4; ++n) {
                f32x4 a = {0.f, 0.f, 0.f, 0.f};
                a = __builtin_amdgcn_mfma_f32_16x16x16bf16_1k(vT[n], sT4, a, 0, 0, 0);
                const bf16x8 s0 = mk8(pk2(S[0][n][0], S[0][n][1]), pk2(S[0][n][2], S[0][n][3]), pk2(S[1][n][0], S[1][n][1]), pk2(S[1][n][2], S[1][n][3]));
                const bf16x8 s1 = mk8(pk2(S[2][n][0], S[2][n][1]), pk2(S[2][n][2], S[2][n][3]), pk2(S[3][n][0], S[3][n][1]), pk2(S[3][n][2], S[3][n][3]));
                f32x4 a2 = {0.f, 0.f, 0.f, 0.f};
                a2 = __builtin_amdgcn_mfma_f32_16x16x32_bf16(s0, qa, a2, 0, 0, 0);
                a2 = __builtin_amdgcn_mfma_f32_16x16x32_bf16(s1, qb2, a2, 0, 0, 0);
                o[n] = a + a2;
            }
        }
#pragma unroll
        for (int mt = 0; mt < 4; ++mt)
#pragma unroll
            for (int n = 0; n < 4; ++n) {
                f32x4 a = __builtin_amdgcn_mfma_f32_16x16x16bf16_1k(kT[mt], vT[n], S[mt][n], 0, 0, 0);
#pragma unroll
                for (int r = 0; r < 4; ++r) a[r] *= dreg[mt][r];
                S[mt][n] = a;
            }
        if (PB) {
            float ss = 0.f;
#pragma unroll
            for (int n = 0; n < 4; ++n)
#pragma unroll
                for (int r = 0; r < 4; ++r) ss += o[n][r] * o[n][r];
            ss = xsum16(ss); ss = xsum32(ss);
            const float rinv = __builtin_amdgcn_rsqf(ss * (1.f / 64.f) + RMS_EPS);
            unsigned char* op = (unsigned char*)C.mix + row * MIXW + 512 + h * 64 + 4 * g;
#pragma unroll
            for (int n = 0; n < 4; ++n) {
                float ov[4]; const f32x4 gz8 = dec_fp8x4(gt_[n]);
#pragma unroll
                for (int r = 0; r < 4; ++r)
                    ov[r] = __builtin_amdgcn_fmed3f(o[n][r] * rinv * nw[n][r] * (gz8[r] * frcp(1.f + __builtin_amdgcn_exp2f(gz8[r] * (-0.125f * 1.44269504f)))), -448.f, 448.f);
                *(unsigned*)(op + 16 * n) = pk_fp8x4((f32x4){ov[0], ov[1], ov[2], ov[3]});
            }
        } else {
#pragma unroll
            for (int c = 0; c < 4; ++c)
#pragma unroll
                for (int i = 0; i < 4; ++i) dseg[c][i] *= dreg[c][i];
        }
    }
    if (!PB) {
        float* sl = C.hst + ((size_t)witem * 80) * 64 + lane;
#pragma unroll
        for (int mt = 0; mt < 4; ++mt)
#pragma unroll
            for (int n = 0; n < 4; ++n)
#pragma unroll
                for (int r = 0; r < 4; ++r) sl[((mt * 4 + n) * 4 + r) * 64] = S[mt][n][r];
#pragma unroll
        for (int c = 0; c < 4; ++c)
#pragma unroll
            for (int i = 0; i < 4; ++i) sl[(64 + c * 4 + i) * 64] = dseg[c][i];
        asm volatile("s_waitcnt vmcnt(0)" ::: "memory");
        __syncthreads();
        if (lane == 0 && wv == 0) {
            __builtin_amdgcn_fence(__ATOMIC_RELEASE, "agent");
            asm volatile("s_waitcnt vmcnt(0)" ::: "memory");
            __hip_atomic_fetch_add(C.ctl + CW_HA + (l * 32 + bh) * 64, 1u, __ATOMIC_RELAXED, __HIP_MEMORY_SCOPE_AGENT);
        }
    }
}

__device__ __forceinline__ void mixer_phase(const Ctx& C, LAS unsigned char* lds, int l, int tid, int wave, int lane) {
    constexpr int NH = 32 * NSEG / NWAVES;
    constexpr int N_MEM = NB * 4 * 8, N_SWA = NB * 32 * 2;
    unsigned* head = C.ctl + CW_QUEUE + l * 64;
    volatile LAS int* slot = (volatile LAS int*)(lds + LDSCTL_OFF + 256);
    for (;;) {
        __syncthreads();
        if (tid == 0) slot[0] = (int)__hip_atomic_fetch_add(head, 1u, __ATOMIC_RELAXED, __HIP_MEMORY_SCOPE_AGENT);
        __syncthreads();
        int it = __builtin_amdgcn_readfirstlane(slot[0]);
        if (it >= 2 * NH + N_MEM + N_SWA) break;
        int lane_i = lane; asm volatile("" : "+v"(lane_i));
        if (it < NH) { hgrn_item<false>(C, lds, wave, l, it * NWAVES + wave, lane_i); continue; } it -= NH;
        if (it < N_SWA / 2) { attn_item<true>(C, lds, l, it, wave * 64 + lane_i, wave, lane_i); continue; } it -= N_SWA / 2;
        if (it < NH) { hgrn_item<true>(C, lds, wave, l, it * NWAVES + wave, lane_i); continue; } it -= NH;
        if (it < N_SWA / 2) { attn_item<true>(C, lds, l, it + N_SWA / 2, wave * 64 + lane_i, wave, lane_i); continue; } it -= N_SWA / 2;
        attn_item<false>(C, lds, l, it, wave * 64 + lane_i, wave, lane_i);
    }
}

__device__ __forceinline__ float reduce_scatter16(const float (&p)[16], int lane) {
    const bool h5 = (lane & 32) != 0, h4 = (lane & 16) != 0, h3 = (lane & 8) != 0, h2 = (lane & 4) != 0;
    float q8[8], q4[4], q2[2];
#pragma unroll
    for (int i = 0; i < 8; ++i) { const float snd = h5 ? p[i] : p[i + 8], kp = h5 ? p[i + 8] : p[i]; q8[i] = kp + __shfl_xor(snd, 32); }
#pragma unroll
    for (int i = 0; i < 4; ++i) { const float snd = h4 ? q8[i] : q8[i + 4], kp = h4 ? q8[i + 4] : q8[i]; q4[i] = kp + __shfl_xor(snd, 16); }
#pragma unroll
    for (int i = 0; i < 2; ++i) { const float snd = h3 ? q4[i] : q4[i + 2], kp = h3 ? q4[i + 2] : q4[i]; q2[i] = kp + DPPF(snd, 0x128); }
    float q1; { const float snd = h2 ? q2[0] : q2[1], kp = h2 ? q2[1] : q2[0]; q1 = kp + __shfl_xor(snd, 4); }
    q1 += DPPF(q1, 0x4E); q1 += DPPF(q1, 0xB1);
    return q1;
}
__device__ __forceinline__ float reduce_scatter4(const float (&p)[4], int lane) {
    const bool h5 = (lane & 32) != 0, h4 = (lane & 16) != 0;
    float q2[2];
#pragma unroll
    for (int i = 0; i < 2; ++i) { const float snd = h5 ? p[i] : p[i + 2], kp = h5 ? p[i + 2] : p[i]; q2[i] = kp + __shfl_xor(snd, 32); }
    float q1; { const float snd = h4 ? q2[0] : q2[1], kp = h4 ? q2[1] : q2[0]; q1 = kp + __shfl_xor(snd, 16); }
    q1 += DPPF(q1, 0xB1); q1 += DPPF(q1, 0x4E); q1 += DPPF(q1, 0x141); q1 += DPPF(q1, 0x140);
    return q1;
}
__device__ __forceinline__ float reduce_scatter8(const float (&p)[8], int lane) {
    const bool h5 = (lane & 32) != 0, h4 = (lane & 16) != 0, h3 = (lane & 8) != 0;
    float q4[4], q2[2];
#pragma unroll
    for (int i = 0; i < 4; ++i) { const float snd = h5 ? p[i] : p[i + 4], kp = h5 ? p[i + 4] : p[i]; q4[i] = kp + __shfl_xor(snd, 32); }
#pragma unroll
    for (int i = 0; i < 2; ++i) { const float snd = h4 ? q4[i] : q4[i + 2], kp = h4 ? q4[i + 2] : q4[i]; q2[i] = kp + __shfl_xor(snd, 16); }
    float q1; { const float snd = h3 ? q2[0] : q2[1], kp = h3 ? q2[1] : q2[0]; q1 = kp + DPPF(snd, 0x128); }
    q1 += DPPF(q1, 0xB1); q1 += DPPF(q1, 0x4E); q1 += DPPF(q1, 0x141);
    return q1;
}
__device__ __forceinline__ void route_rows16(const LAS float* lg, const float (&rb)[16], LAS unsigned* dec16, int lane) {
    const int r = lane & 15;
    float sel[16], sc[16];
#pragma unroll
    for (int q = 0; q < 4; ++q) { const f32x4 v = *(const LAS f32x4*)(lg + r * 16 + 4 * q);
        sc[4 * q] = frcp(1.f + __expf(-v.x)); sc[4 * q + 1] = frcp(1.f + __expf(-v.y)); sc[4 * q + 2] = frcp(1.f + __expf(-v.z)); sc[4 * q + 3] = frcp(1.f + __expf(-v.w)); }
#pragma unroll
    for (int e = 0; e < 16; ++e) sel[e] = sc[e] + rb[e];
    float bestv = -INFINITY, w1 = 0.f, w2 = 0.f; int e1 = 0, e2 = 1;
#pragma unroll
    for (int gi = 0; gi < 4; ++gi) {
        float m1 = sel[4 * gi], s1 = sc[4 * gi]; int i1 = 0;
#pragma unroll
        for (int i = 1; i < 4; ++i) if (sel[4 * gi + i] > m1) { m1 = sel[4 * gi + i]; s1 = sc[4 * gi + i]; i1 = i; }
        float m2 = -INFINITY, s2v = 0.f; int i2 = 0;
#pragma unroll
        for (int i = 0; i < 4; ++i) if (i != i1 && sel[4 * gi + i] > m2) { m2 = sel[4 * gi + i]; s2v = sc[4 * gi + i]; i2 = i; }
        const float gs = m1 + m2;
        if (gs > bestv) { bestv = gs; e1 = 4 * gi + i1; e2 = 4 * gi + i2; w1 = s1; w2 = s2v; }
    }
    const float wn = 1.f / (w1 + w2);
    if (lane < 16) { u32x4 d; d.x = (unsigned)e1; d.y = (unsigned)e2; d.z = __float_as_uint(w1 * wn); d.w = __float_as_uint(w2 * wn); *(LAS u32x4*)(dec16 + r * 4) = d; }
}
__device__ __forceinline__ void ln_row(const unsigned (&h)[4], const u32x2 (&x)[4], const f32x4 (&gv)[4], const f32x4 (&bv)[4], f32x4 (&v)[4]) {
    float s = 0.f;
#pragma unroll
    for (int j = 0; j < 4; ++j) { v[j] = join_fp8(x[j].x, x[j].y) * ALPHA + dec_fp8x4(h[j]) * 0.015625f;
        s += (v[j].x + v[j].y) + (v[j].z + v[j].w); }
    const float mean = wave_sum(s) * (1.f / DM); float s2 = 0.f;
#pragma unroll
    for (int j = 0; j < 4; ++j) { v[j] = v[j] - mean; s2 += (v[j].x * v[j].x + v[j].y * v[j].y) + (v[j].z * v[j].z + v[j].w * v[j].w); }
    const float rstd = __builtin_amdgcn_rsqf(wave_sum(s2) * (1.f / DM) + LN_EPS);
#pragma unroll
    for (int j = 0; j < 4; ++j) v[j] = v[j] * rstd * gv[j] + bv[j];
}
__device__ __forceinline__ void p4_ln_route(const Ctx& C, LAS unsigned char* lds, int l, int tid, int wave, int lane) {
    LAS float* wr = (LAS float*)lds;
    constexpr int WRP = DM + 4;
    LAS unsigned* dec = (LAS unsigned*)(lds + 66048);
    LAS unsigned* posb = (LAS unsigned*)(lds + 66048 + 2048);
    LAS float* lgw = (LAS float*)(lds + 66048 + 4096) + wave * 256;
    for (int i = tid; i < DM * NE; i += NTHR) { const int d = i >> 4, e = i & 15; wr[e * WRP + d] = C.w_router[i]; }
    f32x4 gv[4], bv[4];
#pragma unroll
    for (int j = 0; j < 4; ++j) { gv[j] = *((const f32x4*)(C.ln1g + l * DM) + lane + 64 * j); bv[j] = *((const f32x4*)(C.ln1b + l * DM) + lane + 64 * j); }
    unsigned* cntl = C.ctl + CW_CNT + (l + C.rep * DEPTH) * 16 * 64;
    __syncthreads();
    for (int blk = C.vcu; blk < NTOK / 128; blk += C.G) {
        const size_t rowb = (size_t)blk * 128 + wave * 16;
        const unsigned char* hp8 = (const unsigned char*)C.hpre; unsigned char* xlo = (unsigned char*)C.xb;
#define P4_LOAD4(H, X, R0) do { _Pragma("unroll") for (int r_ = 0; r_ < 4; ++r_) { const size_t rr_ = (R0) + r_; _Pragma("unroll") for (int j = 0; j < 4; ++j) { \
            H[r_][j] = ((const unsigned*)(hp8 + rr_ * DM) + lane)[64 * j]; X[r_][j].x = ((const unsigned*)(C.xb8 + rr_ * DM) + lane)[64 * j]; X[r_][j].y = ((const unsigned*)(xlo + rr_ * DM) + lane)[64 * j]; } } } while (0)
        unsigned hA[4][4]; u32x2 xA[4][4];
        P4_LOAD4(hA, xA, rowb);
#pragma unroll 1
        for (int st = 0; st < 4; ++st) {
            const size_t row = rowb + 4 * st;
            unsigned hN[4][4]; u32x2 xN[4][4];
            if (st < 3) P4_LOAD4(hN, xN, row + 4);
            f32x4 v[4][4];
#pragma unroll
            for (int r = 0; r < 4; ++r) {
                ln_row(hA[r], xA[r], gv, bv, v[r]);
                unsigned* xl = (unsigned*)(xlo + (row + r) * DM) + lane; unsigned* x8 = (unsigned*)(C.xb8 + (row + r) * DM) + lane;
#pragma unroll
                for (int j = 0; j < 4; ++j) { unsigned hi, lo; split_fp8(v[r][j], hi, lo); x8[64 * j] = hi; xl[64 * j] = lo; }
            }
#pragma unroll
            for (int eh = 0; eh < 4; ++eh) {
                float p[4][4];
#pragma unroll
                for (int e8 = 0; e8 < 4; ++e8) {
                    f32x4 w[4];
#pragma unroll
                    for (int j = 0; j < 4; ++j) w[j] = *((const LAS f32x4*)(wr + (4 * eh + e8) * WRP) + lane + 64 * j);
#pragma unroll
                    for (int r = 0; r < 4; ++r) { f32x2 a = {0.f, 0.f};
#pragma unroll
                        for (int j = 0; j < 4; ++j) { a = __builtin_elementwise_fma((f32x2){v[r][j].x, v[r][j].y}, (f32x2){w[j].x, w[j].y}, a); a = __builtin_elementwise_fma((f32x2){v[r][j].z, v[r][j].w}, (f32x2){w[j].z, w[j].w}, a); }
                        p[r][e8] = a.x + a.y; }
                }
#pragma unroll
                for (int r = 0; r < 4; ++r) { const float q = reduce_scatter4(p[r], lane);
                    if ((lane & 15) == 0) lgw[(4 * st + r) * 16 + 4 * eh + (lane >> 4)] = q; }
                __builtin_amdgcn_sched_barrier(0);
            }
#pragma unroll
            for (int r = 0; r < 4; ++r)
#pragma unroll
                for (int j = 0; j < 4; ++j) { hA[r][j] = hN[r][j]; xA[r][j] = xN[r][j]; }
        }
#undef P4_LOAD4
        float rb[16];
#pragma unroll
        for (int e = 0; e < 16; ++e) rb[e] = C.rbias[e];
        route_rows16(lgw, rb, dec + wave * 16 * 4, lane);
        __syncthreads();
        if (wave == 0) {
            unsigned ea[4], rk[4]; unsigned tot = 0;
#pragma unroll
            for (int i = 0; i < 4; ++i) { const int a = lane + 64 * i; ea[i] = dec[(a >> 1) * 4 + (a & 1)]; rk[i] = 0; }
#pragma unroll
            for (int e = 0; e < 16; ++e) {
                unsigned run = 0;
#pragma unroll
                for (int i = 0; i < 4; ++i) { const unsigned long long m = __ballot(ea[i] == (unsigned)e);
                    const unsigned below = __builtin_amdgcn_mbcnt_hi((unsigned)(m >> 32), __builtin_amdgcn_mbcnt_lo((unsigned)m, 0u));
                    if (ea[i] == (unsigned)e) rk[i] = run + below;
                    run += (unsigned)__popcll(m); }
                if (lane == e) tot = run;
            }
            unsigned base = 0;
            if (lane < 16) base = tot ? atomicAdd(cntl + 64 * lane, tot) : 0u;
#pragma unroll
            for (int i = 0; i < 4; ++i) { const unsigned bs = __shfl(base, (int)ea[i]); const unsigned pos = bs + rk[i]; const int a = lane + 64 * i;
                posb[a] = pos; C.list[(size_t)ea[i] * LCAP + pos] = blk * 128 + (a >> 1); }
        }
        __syncthreads();
        if (tid < 128) { u32x4 rec; rec.x = (dec[tid * 4] << 16) | posb[tid * 2]; rec.y = (dec[tid * 4 + 1] << 16) | posb[tid * 2 + 1]; rec.z = dec[tid * 4 + 2]; rec.w = dec[tid * 4 + 3];
            C.tokrec[(size_t)blk * 128 + tid] = rec; }
        __syncthreads();
    }
}

__device__ __forceinline__ void moe_prefix(const Ctx& C, LAS int* tb, int l, int tid) {
    if (tid == 0) {
        unsigned* cntl = C.ctl + CW_CNT + l * 16 * 64; int acc = 0;
        for (int e = 0; e < 16; ++e) { const int c = (int)__hip_atomic_load(cntl + 64 * e, __ATOMIC_RELAXED, __HIP_MEMORY_SCOPE_AGENT); tb[e] = acc; tb[17 + e] = c; acc += (c + 255) >> 8; }
        tb[16] = acc;
    }
    __syncthreads();
}

__device__ __forceinline__ void p7_combine(const Ctx& C, LAS unsigned char* lds, int l, int tid, int wave, int lane) {
    LAS int* tb = (LAS int*)lds;
    moe_prefix(C, tb, l, tid);
    f32x4 gv[4], bv[4];
#pragma unroll
    for (int j = 0; j < 4; ++j) { gv[j] = *((const f32x4*)(C.ln2g + l * DM) + lane + 64 * j); bv[j] = *((const f32x4*)(C.ln2b + l * DM) + lane + 64 * j); }
    const bool lastl = (l == DEPTH - 1);
    for (int r0 = (C.vcu * NWAVES + wave) * 16; r0 < NTOK; r0 += C.G * NWAVES * 16) {
        u32x4 rec = C.tokrec[r0 + (lane & 15)];
        const unsigned sa_l = (unsigned)tb[rec.x >> 16] * 256u + (rec.x & 0xffffu), sb_l = (unsigned)tb[rec.y >> 16] * 256u + (rec.y & 0xffffu);
#pragma unroll 1
        for (int bq = 0; bq < 2; ++bq) {
            u32x2 xv[8][4]; unsigned av[8][4], bw[8][4]; float wa[8], wb[8];
#pragma unroll
            for (int k = 0; k < 8; ++k) { const int idx = bq * 8 + k;
                const size_t sa = (size_t)__builtin_amdgcn_readlane(sa_l, idx), sb = (size_t)__builtin_amdgcn_readlane(sb_l, idx);
                wa[k] = __uint_as_float(__builtin_amdgcn_readlane(rec.z, idx)) * 0.0625f; wb[k] = __uint_as_float(__builtin_amdgcn_readlane(rec.w, idx)) * 0.0625f;
                const unsigned* xph = (const unsigned*)(C.xb8 + (size_t)(r0 + idx) * DM) + lane; const unsigned* xpl = (const unsigned*)((const unsigned char*)C.xb + (size_t)(r0 + idx) * DM) + lane; const unsigned* ya = (const unsigned*)((const unsigned char*)C.ys + sa * DM) + lane; const unsigned* yb = (const unsigned*)((const unsigned char*)C.ys + sb * DM) + lane;
#pragma unroll
                for (int j = 0; j < 4; ++j) { xv[k][j].x = xph[64 * j]; xv[k][j].y = xpl[64 * j]; av[k][j] = ya[64 * j]; bw[k][j] = yb[64 * j]; } }
#pragma unroll
            for (int k = 0; k < 8; ++k) { const int row = r0 + bq * 8 + k;
                f32x4 v[4]; float s = 0.f;
#pragma unroll
                for (int j = 0; j < 4; ++j) { const u32x2 x2 = xv[k][j];
                    const f32x2 al = __builtin_amdgcn_cvt_pk_f32_fp8((int)av[k][j], false), ah = __builtin_amdgcn_cvt_pk_f32_fp8((int)av[k][j], true);
                    const f32x2 bl = __builtin_amdgcn_cvt_pk_f32_fp8((int)bw[k][j], false), bh = __builtin_amdgcn_cvt_pk_f32_fp8((int)bw[k][j], true);
                    const f32x4 xr = join_fp8(x2.x, x2.y) * ALPHA;
                    v[j].x = xr.x + (al.x * wa[k] + bl.x * wb[k]); v[j].y = xr.y + (al.y * wa[k] + bl.y * wb[k]);
                    v[j].z = xr.z + (ah.x * wa[k] + bh.x * wb[k]); v[j].w = xr.w + (ah.y * wa[k] + bh.y * wb[k]);
                    s += (v[j].x + v[j].y) + (v[j].z + v[j].w); }
                const float mean = wave_sum(s) * (1.f / DM); float s2 = 0.f;
#pragma unroll
                for (int j = 0; j < 4; ++j) { v[j] = v[j] - mean; s2 += (v[j].x * v[j].x + v[j].y * v[j].y) + (v[j].z * v[j].z + v[j].w * v[j].w); }
                const float rstd = __builtin_amdgcn_rsqf(wave_sum(s2) * (1.f / DM) + LN_EPS);
                if (lastl) { f32x4* xo = (f32x4*)(C.xcur + (size_t)row * DM) + lane;
#pragma unroll
                    for (int j = 0; j < 4; ++j) xo[64 * j] = v[j] * rstd * gv[j] + bv[j]; }
                else { unsigned* xlo = (unsigned*)((unsigned char*)C.xb + (size_t)row * DM) + lane; unsigned* x8o = (unsigned*)(C.xb8 + (size_t)row * DM) + lane;
#pragma unroll
                    for (int j = 0; j < 4; ++j) { const f32x4 y = v[j] * rstd * gv[j] + bv[j]; unsigned hi, lo; split_fp8(y, hi, lo); x8o[64 * j] = hi; xlo[64 * j] = lo; } }
            }
        }
    }
}

template <class T> __device__ __forceinline__ T* as_g(T* p) { return (T*)(GAS T*)p; }
typedef const __attribute__((address_space(4))) Args* KArgs;
__device__ __forceinline__ Ctx make_ctx(KArgs ap) {
    asm volatile("" : "+s"(ap));
    Ctx C;
    C.x = as_g(ap->in[0]); C.mem = as_g(ap->in[1]); C.w_in = as_g(ap->in[2]); C.b_in = as_g(ap->in[3]); C.w_mem_kv = as_g(ap->in[4]); C.sinks = as_g(ap->in[5]); C.rel_bias = as_g(ap->in[6]); C.lb_logits = as_g(ap->in[7]);
    C.hnorm = as_g(ap->in[8]); C.w_out = as_g(ap->in[9]); C.ln1g = as_g(ap->in[10]); C.ln1b = as_g(ap->in[11]); C.w_router = as_g(ap->in[12]); C.rbias = as_g(ap->in[13]); C.w_gate = as_g(ap->in[14]); C.w_up = as_g(ap->in[15]);
    C.w_down = as_g(ap->in[16]); C.ln2g = as_g(ap->in[17]); C.ln2b = as_g(ap->in[18]);
    unsigned char* ws = as_g(ap->ws);
    C.xcur = as_g(ap->out); C.ws = ws; C.ctl = (unsigned*)(ws + WS_CTL);
    C.Win = (bf16*)(ws + WS_WIN); C.Wout = (bf16*)(ws + WS_WOUT); C.Wmem = (bf16*)(ws + WS_WMEM); C.W1 = (bf16*)(ws + WS_W1); C.W2 = (bf16*)(ws + WS_W2);
    C.xb = (bf16*)(ws + WS_XB); C.proj = (bf16*)(ws + WS_BIG); C.hpre = (bf16*)(ws + WS_BIG); C.ys = (bf16*)(ws + WS_BIG);
    C.mix = (bf16*)(ws + WS_MIX); C.hmid = (bf16*)(ws + WS_MIX); C.memkv = (bf16*)(ws + WS_MEMKV); C.memb = (bf16*)(ws + WS_MEMB);
    C.biastab = (float*)(ws + WS_TAB); C.lbtab = (float*)(ws + WS_TAB + 4096); C.list = (int*)(ws + WS_LIST); C.tokrec = (u32x4*)(ws + WS_TOKREC); C.hst = (float*)(ws + WS_HST); C.xb8 = ws + WS_XB8;
    C.rep = ap->rep; C.G = gridDim.x; { const int bx = blockIdx.x; C.vcu = (C.G % 8 == 0) ? (bx % 8) * (C.G / 8) + bx / 8 : bx; }
    return C;
}
constexpr int PH_PER_LAYER = 7, N_PHASES = 1 + DEPTH * PH_PER_LAYER;
__global__ void __launch_bounds__(NTHR, 2) trunk_fwd(Args args) {
    extern __shared__ __attribute__((aligned(16))) unsigned char lds_raw[];
    LAS unsigned char* lds = (LAS unsigned char*)lds_raw;
    volatile LAS unsigned* MISC = (volatile LAS unsigned*)(lds + MISC_OFF);
    const int tid0 = threadIdx.x; const int wave0 = __builtin_amdgcn_readfirstlane(tid0 >> 6);
    for (int u = tid0; u < (LDS_BYTES - LDSCTL_OFF) / 4; u += NTHR) ((LAS unsigned*)(lds + LDSCTL_OFF))[u] = 0u;
    __syncthreads();
    KArgs ap = (KArgs)__builtin_amdgcn_kernarg_segment_ptr();
    XcdBarrier bar; bar.bar = (unsigned*)(as_g(args.ws) + WS_CTL) + CW_BAR; bar.x = 0; bar.st = nullptr;
    if (args.use_bar) bar = xcd_barrier_post((unsigned*)(as_g(args.ws) + WS_CTL) + CW_BAR, MISC + 8);
    const int lo = args.ph_lo, hi = args.ph_hi;
#define IN(k) (lo <= (k) && (k) < hi)
#define PHASE_IDS unsigned ones_ = ~0u; asm volatile("" : "+s"(ones_)); int lane = (int)__builtin_amdgcn_mbcnt_hi(ones_, __builtin_amdgcn_mbcnt_lo(ones_, 0u)); asm volatile("" : "+v"(lane)); int wave = wave0; asm volatile("" : "+s"(wave)); const int tid = wave * 64 + lane; (void)tid
#define SEAM(k) do { if (IN(k) && IN((k) + 1)) { XcdBarrier b2_ = bar; unsigned z_ = 0u; asm volatile("" : "+s"(z_)); b2_.bar = bar.bar + z_; xcd_barrier(b2_); } } while (0)

    if (IN(0)) { PHASE_IDS; const Ctx C = make_ctx(ap); p0_prologue(C, lds, wave, lane); }
    SEAM(0);
#pragma unroll 1
    for (int l = 0; l < DEPTH; ++l) {
        const int pb = 1 + l * PH_PER_LAYER;
        if (IN(pb + 0)) {
            PHASE_IDS; const Ctx C = make_ctx(ap);
            DenseSched S; S.A0 = (const char*)C.xb8; S.B0 = (const char*)C.Win + (size_t)l * INW * DM; S.nM0 = NTOK / 256; S.nN0 = INW / 256; S.K0 = DM  ;
            S.A1 = (const char*)C.memb; S.B1 = (const char*)C.Wmem; S.nM1 = (l == 0) ? (NB * MEMLEN) / 256 : 0; S.nN1 = 2048 / 256; S.G = C.G; S.c = (int)blockIdx.x;
            EpiProj E{(unsigned char*)C.proj, C.b_in + l * INW, (unsigned char*)C.memkv};
            pg8::gemm_phase<EpiProj, DenseSched, true>(lds, tid, DM, S, E);
        }
        SEAM(pb + 0);
        if (IN(pb + 1)) { PHASE_IDS; const Ctx C = make_ctx(ap); mixer_phase(C, lds, l, tid, wave, lane); }
        SEAM(pb + 1);
        if (IN(pb + 2)) {
            PHASE_IDS; const Ctx C = make_ctx(ap);
            DenseSched S; S.A0 = (const char*)C.mix; S.B0 = (const char*)C.Wout + (size_t)l * DM * MIXW; S.nM0 = NTOK / 256; S.nN0 = DM / 256; S.K0 = MIXW  ;
            S.A1 = nullptr; S.B1 = nullptr; S.nM1 = 0; S.nN1 = 0; S.G = C.G; S.c = (int)blockIdx.x;
            EpiOut E{(unsigned char*)C.hpre};
            pg8::gemm_phase<EpiOut, DenseSched, true>(lds, tid, MIXW, S, E);
        }
        SEAM(pb + 2);
        if (IN(pb + 3)) { PHASE_IDS; const Ctx C = make_ctx(ap); p4_ln_route(C, lds, l, tid, wave, lane); }
        SEAM(pb + 3);
        if (IN(pb + 4)) {
            PHASE_IDS; const Ctx C = make_ctx(ap);
            LAS int* tb = (LAS int*)(lds + LDSCTL_OFF + 64);
            moe_prefix(C, tb, l, tid);
            const int U = tb[16] * 4;
            MoeSched<true> S; S.A = (const char*)C.xb8; S.Bl = (const char*)C.W1 + (size_t)l * NE * 1024 * DM; S.K = DM  ; S.bstride = (size_t)1024 * DM; S.list = C.list; S.tb = tb;
            S.mode = 0; S.g0 = C.vcu; S.g1 = C.G; S.gU = U < 1024 ? U : 1024;
            EpiG1 E{(unsigned char*)C.hmid};
            pg8::gemm_phase<EpiG1, MoeSched<true>, true>(lds, tid, DM, S, E);
        }
        SEAM(pb + 4);
        if (IN(pb + 5)) {
            PHASE_IDS; const Ctx C = make_ctx(ap);
            LAS int* tb = (LAS int*)(lds + LDSCTL_OFF + 64);
            moe_prefix(C, tb, l, tid);
            const int U = tb[16] * 4, Etail = U > 1024 ? U - 1024 : 0;
            if (C.vcu < Etail) {
                MoeSched<true> S; S.A = (const char*)C.xb8; S.Bl = (const char*)C.W1 + (size_t)l * NE * 1024 * DM; S.K = DM  ; S.bstride = (size_t)1024 * DM; S.list = C.list; S.tb = tb;
                S.mode = 0; S.g0 = 1024 + C.vcu; S.g1 = 1 << 20; S.gU = 1024 + C.vcu + 1;
                EpiG1 E{(unsigned char*)C.hmid};
                pg8::gemm_phase<EpiG1, MoeSched<true>, true>(lds, tid, DM, S, E);
                asm volatile("s_waitcnt vmcnt(0)" ::: "memory");
                __syncthreads();
                if (tid == 0) {
                    unsigned* cnt = C.ctl + CW_TILE + (l * 16 + (C.vcu >> 2)) * 64; unsigned sp = 0;
                    __builtin_amdgcn_fence(__ATOMIC_RELEASE, "agent");
                    asm volatile("s_waitcnt vmcnt(0)" ::: "memory");
                    __hip_atomic_fetch_add(cnt, 1u, __ATOMIC_RELAXED, __HIP_MEMORY_SCOPE_AGENT);
                    while (__hip_atomic_load(cnt, __ATOMIC_RELAXED, __HIP_MEMORY_SCOPE_AGENT) < 4u) { __builtin_amdgcn_s_sleep(2); if (++sp > (1u << 24)) break; }
                    __builtin_amdgcn_fence(__ATOMIC_ACQUIRE, "agent");
                    asm volatile("s_waitcnt vmcnt(0)" ::: "memory");
                }
                __syncthreads();
            }
            MoeSched<false> S; S.A = (const char*)C.hmid; S.Bl = (const char*)C.W2 + (size_t)l * NE * DM * DE; S.K = DE  ; S.bstride = (size_t)DM * DE; S.list = C.list; S.tb = tb;
            S.mode = 1; S.g0 = C.vcu; S.g1 = Etail; S.gU = U < 1024 ? U : 1024;
            EpiG2 E{(unsigned char*)C.ys};
            pg8::gemm_phase<EpiG2, MoeSched<false>, true>(lds, tid, DE, S, E);
        }
        SEAM(pb + 5);
        if (IN(pb + 6)) { PHASE_IDS; const Ctx C = make_ctx(ap); p7_combine(C, lds, l, tid, wave, lane); }
        SEAM(pb + 6);
    }
#undef IN
#undef SEAM
}

#ifndef ONE_LAUNCH
#define ONE_LAUNCH 1
#endif
extern "C" void kernel_launch(void* const* d_in, const int* in_sizes, int n_in, void* d_out, int out_size, void* d_ws, size_t ws_size, hipStream_t stream) {
    static int grid = 0;
    if (grid == 0) {
        if (n_in != 19 || in_sizes[0] != NTOK * DM || out_size != NTOK * DM || ws_size < WS_END) {
            fprintf(stderr, "kernel_launch: unexpected shapes (n_in %d, in0 %d, out %d, ws %zu < %zu); nothing launched\n", n_in, n_in > 0 ? in_sizes[0] : -1, out_size, ws_size, (size_t)WS_END); grid = -1; return; }
        int dev = 0, cus = 0, per_cu = 0;
        if (hipGetDevice(&dev) != hipSuccess || hipDeviceGetAttribute(&cus, hipDeviceAttributeMultiprocessorCount, dev) != hipSuccess) { grid = -1; return; }
        if (hipFuncSetAttribute((const void*)trunk_fwd, hipFuncAttributeMaxDynamicSharedMemorySize, LDS_BYTES) != hipSuccess) { fprintf(stderr, "kernel_launch: hipFuncSetAttribute failed\n"); grid = -1; return; }
        if (hipOccupancyMaxActiveBlocksPerMultiprocessor(&per_cu, (const void*)trunk_fwd, NTHR, LDS_BYTES) != hipSuccess || per_cu < 1) { fprintf(stderr, "kernel_launch: occupancy query says %d\n", per_cu); }
        (void)hipGetLastError();
        grid = cus;
        fprintf(stderr, "kernel_launch: grid %d, occupancy/CU %d, ws %zu\n", grid, per_cu, ws_size);
    }
    if (grid < 0) return;
    (void)hipMemsetAsync((char*)d_ws + WS_CTL, 0, CTL_ZERO_BYTES, stream);
    Args a{};
    for (int i = 0; i < 19; ++i) a.in[i] = (const float*)d_in[i];
    a.out = (float*)d_out; a.ws = (unsigned char*)d_ws;
#if ONE_LAUNCH
    a.ph_lo = 0; a.ph_hi = N_PHASES; a.use_bar = 1;
    void* kargs[] = {&a};
    hipError_t e = hipLaunchCooperativeKernel((const void*)trunk_fwd, dim3(grid), dim3(NTHR), kargs, LDS_BYTES, stream);
    if (e != hipSuccess) fprintf(stderr, "kernel_launch: cooperative launch failed: %s\n", hipGetErrorString(e));
#else
    for (int p = 0; p < N_PHASES; ++p) {
        a.ph_lo = p; a.ph_hi = p + 1; a.use_bar = 0;
        hipLaunchKernelGGL(trunk_fwd, dim3(grid), dim3(NTHR), LDS_BYTES, stream, a);
    }
#endif
}
```

```cpp
#include <hip/hip_runtime.h>
#include <cstdio>
#include <cstdint>

#define LAS __attribute__((address_space(3)))
#define GAS __attribute__((address_space(1)))
typedef unsigned short bf16;
typedef short bf16x8 __attribute__((ext_vector_type(8)));
typedef short s16x4 __attribute__((ext_vector_type(4)));
typedef float f32x4 __attribute__((ext_vector_type(4)));
typedef float f32x2 __attribute__((ext_vector_type(2)));
typedef unsigned u32x4 __attribute__((ext_vector_type(4)));
typedef unsigned u32x2 __attribute__((ext_vector_type(2)));
typedef int i32x4 __attribute__((ext_vector_type(4)));
typedef int i32x8 __attribute__((ext_vector_type(8)));
typedef __bf16 bf16x2_t __attribute__((ext_vector_type(2)));

constexpr int NB = 8, SEQ = 4096, DM = 1024, NTOK = NB * SEQ, DEPTH = 4;
constexpr int INW = 2048, MIXW = 1024, NE = 16, DE = 512, MEMLEN = 256;
constexpr int C_SQ = 0, C_SK = 512, C_SV = 640, C_HQ = 768, C_HF = 1024, C_HI = 1280, C_HG = 1536, C_MQ = 1792;
constexpr float ALPHA = 1.6817928305074290f;
constexpr float LN_EPS = 1e-5f, RMS_EPS = 1e-6f;
constexpr int NSEG = 32, CPS = (SEQ / 16) / NSEG;
constexpr int LCAP = 32768;
constexpr int MAXTILES = NTOK * 2 / 256 + NE;
constexpr int NWAVES = 8, NTHR = 512;

constexpr size_t MiB = 1u << 20;
constexpr size_t WS_CTL = 0, CTL_ZERO_BYTES = 1 * MiB;
constexpr size_t WS_TAB = 1 * MiB;
constexpr size_t WS_WIN = 2 * MiB;
constexpr size_t WS_WOUT = 18 * MiB;
constexpr size_t WS_WMEM = 26 * MiB;
constexpr size_t WS_W1 = 30 * MiB;
constexpr size_t WS_XB8 = 94 * MiB;
constexpr size_t WS_W2 = 158 * MiB;
constexpr size_t WS_XB = 222 * MiB;
constexpr size_t WS_BIG = 286 * MiB;
constexpr size_t WS_MIX = 430 * MiB;
constexpr size_t WS_MEMKV = 502 * MiB;
constexpr size_t WS_MEMB = 510 * MiB;
constexpr size_t WS_LIST = 514 * MiB;
constexpr size_t WS_TOKREC = 516 * MiB;
constexpr size_t WS_HST = 517 * MiB;
constexpr size_t WS_END = 538 * MiB;
constexpr int CW_BAR = 4096;
constexpr int CW_CNT = 16384;
constexpr int CW_QUEUE = 32768;
constexpr int CW_TILE = 57344;
constexpr int CW_HA = 49152;

constexpr int RING_BYTES = 131072;
constexpr int LDSCTL_OFF = RING_BYTES, MISC_OFF = LDSCTL_OFF + 320;
constexpr int LDS_BYTES = 147456;

__device__ __forceinline__ unsigned pk2(float lo, float hi) { f32x2 v = {lo, hi}; bf16x2_t b = __builtin_convertvector(v, bf16x2_t); return __builtin_bit_cast(unsigned, b); }
__device__ __forceinline__ unsigned pk_fp8x4(f32x4 v) { int w = __builtin_amdgcn_cvt_pk_fp8_f32(v.x, v.y, 0, false); w = __builtin_amdgcn_cvt_pk_fp8_f32(v.z, v.w, w, true); return (unsigned)w; }
__device__ __forceinline__ f32x4 dec_fp8x4(unsigned w) { const f32x2 a = __builtin_amdgcn_cvt_pk_f32_fp8((int)w, false), b = __builtin_amdgcn_cvt_pk_f32_fp8((int)w, true); return (f32x4){a.x, a.y, b.x, b.y}; }
__device__ __forceinline__ void split_fp8(f32x4 y, unsigned& hi, unsigned& lo) { const f32x4 y8 = y * 8.f; hi = pk_fp8x4(y8); lo = pk_fp8x4((y8 - dec_fp8x4(hi)) * 16.f); }
__device__ __forceinline__ f32x4 join_fp8(unsigned hi, unsigned lo) { return dec_fp8x4(hi) * 0.125f + dec_fp8x4(lo) * 0.0078125f; }
__device__ __forceinline__ u32x4 fp8x8_to_bf16x8(u32x2 w) { const f32x4 a = dec_fp8x4(w.x), b = dec_fp8x4(w.y); u32x4 o; o.x = pk2(a.x, a.y); o.y = pk2(a.z, a.w); o.z = pk2(b.x, b.y); o.w = pk2(b.z, b.w); return o; }
__device__ __forceinline__ float frcp(float x) { return __builtin_amdgcn_rcpf(x); }
__device__ __forceinline__ float bflo(unsigned w) { return __uint_as_float(w << 16); }
__device__ __forceinline__ float bfhi(unsigned w) { return __uint_as_float(w & 0xffff0000u); }
#define DPPF(v, ctrl) __int_as_float(__builtin_amdgcn_update_dpp(0, __float_as_int(v), (ctrl), 0xf, 0xf, true))
__device__ __forceinline__ float xsum16(float v) { const u32x2 r = __builtin_amdgcn_permlane16_swap(__float_as_uint(v), __float_as_uint(v), false, false); return __uint_as_float(r.x) + __uint_as_float(r.y); }
__device__ __forceinline__ float xsum32(float v) { const u32x2 r = __builtin_amdgcn_permlane32_swap(__float_as_uint(v), __float_as_uint(v), false, false); return __uint_as_float(r.x) + __uint_as_float(r.y); }
__device__ __forceinline__ float xmax16(float v) { const u32x2 r = __builtin_amdgcn_permlane16_swap(__float_as_uint(v), __float_as_uint(v), false, false); return fmaxf(__uint_as_float(r.x), __uint_as_float(r.y)); }
__device__ __forceinline__ float xmax32(float v) { const u32x2 r = __builtin_amdgcn_permlane32_swap(__float_as_uint(v), __float_as_uint(v), false, false); return fmaxf(__uint_as_float(r.x), __uint_as_float(r.y)); }
__device__ __forceinline__ float wave_sum(float v) {
    v += DPPF(v, 0xB1);
    v += DPPF(v, 0x4E);
    v += DPPF(v, 0x141);
    v += DPPF(v, 0x140);
    v = xsum16(v); v = xsum32(v);
    return v;
}
__device__ __forceinline__ s16x4 ld_tr(const LAS unsigned char* p) { return __builtin_amdgcn_ds_read_tr16_b64_v4i16((LAS s16x4*)p); }
__device__ __forceinline__ float row_scan16(float x) {
    x += __int_as_float(__builtin_amdgcn_update_dpp(0, __float_as_int(x), 0x111, 0xf, 0xf, true));
    x += __int_as_float(__builtin_amdgcn_update_dpp(0, __float_as_int(x), 0x112, 0xf, 0xf, true));
    x += __int_as_float(__builtin_amdgcn_update_dpp(0, __float_as_int(x), 0x114, 0xf, 0xf, true));
    x += __int_as_float(__builtin_amdgcn_update_dpp(0, __float_as_int(x), 0x118, 0xf, 0xf, true));
    return x;
}
__device__ __forceinline__ bf16x8 mk8(unsigned a, unsigned b, unsigned c, unsigned d) { u32x4 w = {a, b, c, d}; return __builtin_bit_cast(bf16x8, w); }
__device__ __forceinline__ s16x4 mk4(unsigned a, unsigned b) { u32x2 w = {a, b}; return __builtin_bit_cast(s16x4, w); }

namespace pg8 {
constexpr int BM = 256, BK = 64, HALF = 128, HTB = HALF * BK * 2, STAGE_BYTES = 8 * HTB, NXCD = 8, WGM = 8;
constexpr int NXT_SLOT_OFF = 131072 + 2048;
__host__ __device__ __forceinline__ int lds_byte(int r, int c) { const int st = (r >> 4) * 2 + (c >> 5), rr = r & 15, cc = c & 31, ob = rr * 64 + cc * 2; return st * 1024 + (ob ^ (((ob >> 9) & 1) << 5)); }
__host__ __device__ __forceinline__ void stage_rc(int b, int& R, int& C) { const int st = b / 1024, sb = b % 1024, swz = sb ^ (((sb >> 9) & 1) << 5); R = (st >> 1) * 16 + swz / 64; C = (st & 1) * 32 + (swz % 64) / 2; }
__host__ __device__ __forceinline__ int perm32(int rho) { const int n = rho >> 4, i = rho & 15; return 8 * (i >> 2) + 4 * n + (i & 3); }
__host__ __device__ __forceinline__ int perm256(int R) { const int bj = R >> 7, wc = (R >> 5) & 3, n = (R >> 4) & 1, i = R & 15; return 64 * wc + 16 * (i >> 2) + 8 * bj + 4 * n + (i & 3); }

struct Unit {
    const char* A;
    const char* B;
    unsigned a00, a01, a10, a11;
    int row0, col0, aux;
};
__device__ __forceinline__ void tile_order(int L, int nM, int nN, int& pm, int& pn) {
    const int nwg = nM * nN; int wgid = L;
    { const int q = nwg / NXCD, r = nwg % NXCD, xcd = wgid % NXCD, off = wgid / NXCD; wgid = (xcd < r ? xcd * (q + 1) : r * (q + 1) + (xcd - r) * q) + off; }
    const int nig = WGM * nN, gid = wgid / nig, fm = gid * WGM, gsz = (nM - fm) < WGM ? (nM - fm) : WGM;
    pm = fm + ((wgid % nig) % gsz); pn = (wgid % nig) / gsz;
}

template <class Epi, class Sched, bool ALIGN_EPI>
__device__ __forceinline__ void gemm_phase(LAS unsigned char* lds, const int tid, const int RB  , Sched& S, const Epi& E) {
    const int wid = __builtin_amdgcn_readfirstlane(tid >> 6), lane = tid & 63, wr = wid >> 2, wc = wid & 3, fr = lane & 15, fq = lane >> 4;
    const int nt = RB / 128;
    unsigned voffB[2], voffA[2] = {0u, 0u};
    {
        int Ra[2], Ca[2];
#pragma unroll
        for (int i = 0; i < 2; ++i) { int R, C; stage_rc(tid * 16 + i * 8192, R, C); const int Rb = Epi::PERM16 ? perm256(R) : (Epi::PERM ? ((R & ~31) + perm32(R & 31)) : R);
            Ra[i] = R; Ca[i] = C; voffB[i] = (unsigned)(Rb * RB + 2 * C); }
        S.lane_init(Ra[0], Ca[0], Ra[1], Ca[1]);
        if constexpr (!Sched::GATHER) { voffA[0] = (unsigned)(Ra[0] * RB + 2 * Ca[0]); voffA[1] = (unsigned)(Ra[1] * RB + 2 * Ca[1]); }
    }
    const size_t kstep = (size_t)(BK * 2);
    const size_t hstepB = (size_t)HALF * RB;
    const size_t hstepW = Epi::PERM16 ? (size_t)8 * RB : hstepB;
    const unsigned ldsw = (unsigned)wid * 1024u;
    const int aoff = lds_byte(wr * 64 + fr, fq * 8), boff = lds_byte(wc * 32 + fr, fq * 8);
#define PG8_SA(b, h) (((b) * 2 + (h)) * HTB)
#define PG8_SB(b, h) ((4 + (b) * 2 + (h)) * HTB)
#define PG8_STAGE_B(bufoff, gbase) do { _Pragma("unroll") for (int _i = 0; _i < 2; ++_i) \
        __builtin_amdgcn_global_load_lds((const unsigned*)((const char*)(gbase) + voffB[_i]), (LAS unsigned*)(lds + (bufoff) + ldsw + _i * 8192), 16, 0, 0); } while (0)
#define PG8_STAGE_A(bufoff, gbase, hf, o0, o1) do { if constexpr (Sched::GATHER) { \
        __builtin_amdgcn_global_load_lds((const unsigned*)((const char*)(gbase) + (o0)), (LAS unsigned*)(lds + (bufoff) + ldsw), 16, 0, 0); \
        __builtin_amdgcn_global_load_lds((const unsigned*)((const char*)(gbase) + (o1)), (LAS unsigned*)(lds + (bufoff) + ldsw + 8192), 16, 0, 0); } else { \
        __builtin_amdgcn_global_load_lds((const unsigned*)((const char*)(gbase) + (hf) * hstepB + voffA[0]), (LAS unsigned*)(lds + (bufoff) + ldsw), 16, 0, 0); \
        __builtin_amdgcn_global_load_lds((const unsigned*)((const char*)(gbase) + (hf) * hstepB + voffA[1]), (LAS unsigned*)(lds + (bufoff) + ldsw + 8192), 16, 0, 0); } } while (0)
#define PG8_LDA(dst, b, h) do { _Pragma("unroll") for (int m = 0; m < 4; ++m) { dst[m].lo = *(const LAS i32x4*)(lds + PG8_SA(b, h) + aoff + m * 2048); dst[m].hi = *(const LAS i32x4*)(lds + PG8_SA(b, h) + aoff + m * 2048 + 1024); } } while (0)
#define PG8_LDB(dst, b, h) do { _Pragma("unroll") for (int n = 0; n < 2; ++n) { dst[n].lo = *(const LAS i32x4*)(lds + PG8_SB(b, h) + boff + n * 2048); dst[n].hi = *(const LAS i32x4*)(lds + PG8_SB(b, h) + boff + n * 2048 + 1024); } } while (0)
#define PG8_MMA(ai, bj, At, Bt) do { __builtin_amdgcn_s_setprio(1); _Pragma("unroll") for (int m = 0; m < 4; ++m) _Pragma("unroll") for (int n = 0; n < 2; ++n) { \
        if constexpr (Epi::FP8) asm volatile("v_mfma_scale_f32_16x16x128_f8f6f4 %0, %1, %2, %0, %3, %4 op_sel_hi:[0,0,0]" : "+v"(acc[ai][bj][m][n]) : "v"(Bt[n]), "v"(At[m]), "v"(sclw_), "v"(scla_));   \
        else { const i32x4 bl_ = Bt[n].lo, bh_ = Bt[n].hi, al_ = At[m].lo, ah_ = At[m].hi;     \
               acc[ai][bj][m][n] = __builtin_amdgcn_mfma_f32_16x16x32_bf16(__builtin_bit_cast(bf16x8, bl_), __builtin_bit_cast(bf16x8, al_), acc[ai][bj][m][n], 0, 0, 0); \
               acc[ai][bj][m][n] = __builtin_amdgcn_mfma_f32_16x16x32_bf16(__builtin_bit_cast(bf16x8, bh_), __builtin_bit_cast(bf16x8, ah_), acc[ai][bj][m][n], 0, 0, 0); } } __builtin_amdgcn_s_setprio(0); } while (0)
#define PG8_WAIT_V(n) asm volatile("s_waitcnt vmcnt(" #n ")" ::: "memory")
#define PG8_WAIT_L(n) asm volatile("s_waitcnt lgkmcnt(" #n ")" ::: "memory")
#define PG8_BAR __builtin_amdgcn_s_barrier()
#define PG8_SCHED __builtin_amdgcn_sched_barrier(0)
    Unit cur, nxt; int ui = 0;
    if (!S.next(0, cur)) return;
    f32x4 acc[2][2][4][2];
#pragma unroll
    for (int a = 0; a < 2; ++a)
#pragma unroll
        for (int b = 0; b < 2; ++b)
#pragma unroll
            for (int m = 0; m < 4; ++m)
#pragma unroll
                for (int n = 0; n < 2; ++n) acc[a][b][m][n] = (f32x4){0.f, 0.f, 0.f, 0.f};
    i32x8 At[4], B0[2], B1[2];
    int sclw_ = Epi::SCALE_W, scla_ = Epi::SCALE_A; asm volatile("" : "+v"(sclw_), "+v"(scla_));
    PG8_STAGE_B(PG8_SB(0, 0), cur.B); PG8_STAGE_B(PG8_SB(0, 1), cur.B + hstepW); PG8_STAGE_A(PG8_SA(0, 0), cur.A, 0, cur.a00, cur.a01); PG8_STAGE_A(PG8_SA(0, 1), cur.A, 1, cur.a10, cur.a11);
    if (wr == 1) PG8_BAR;
    PG8_WAIT_V(2); PG8_BAR;
    PG8_STAGE_B(PG8_SB(1, 0), cur.B + kstep); PG8_STAGE_A(PG8_SA(1, 0), cur.A + kstep, 0, cur.a00, cur.a01); PG8_STAGE_B(PG8_SB(1, 1), cur.B + hstepW + kstep);
    PG8_WAIT_V(6); PG8_BAR;
    for (;;) {
        const bool has_next = S.next(ui + 1, nxt);
        const char* nA = has_next ? nxt.A : cur.A; const char* nB = has_next ? nxt.B : cur.B;
        if constexpr (Sched::GATHER) {
            u32x4 nv; nv.x = has_next ? nxt.a00 : cur.a00; nv.y = has_next ? nxt.a01 : cur.a01; nv.z = has_next ? nxt.a10 : cur.a10; nv.w = has_next ? nxt.a11 : cur.a11;
            *(LAS u32x4*)(lds + NXT_SLOT_OFF + tid * 16) = nv; nxt.a00 = 0u; nxt.a01 = 0u; nxt.a10 = 0u; nxt.a11 = 0u;
        }
#pragma unroll 1
        for (int t = 0; t < nt; t += 2) {
            const bool last = (t == nt - 2);
            const char* a1 = cur.A + (size_t)(t + 1) * kstep;
            const char* a2 = last ? nA : cur.A + (size_t)(t + 2) * kstep; const char* b2 = last ? nB : cur.B + (size_t)(t + 2) * kstep;
            const char* a3 = a2 + kstep; const char* b3 = b2 + kstep;
            unsigned x00 = cur.a00, x01 = cur.a01, x10 = cur.a10, x11 = cur.a11;
            if constexpr (Sched::GATHER) { if (last) { const u32x4 nv = *(const LAS u32x4*)(lds + NXT_SLOT_OFF + tid * 16); x00 = nv.x; x01 = nv.y; x10 = nv.z; x11 = nv.w; } }
            PG8_LDB(B0, 0, 0); PG8_LDB(B1, 0, 1); PG8_SCHED; PG8_LDA(At, 0, 0); PG8_STAGE_A(PG8_SA(1, 1), a1, 1, cur.a10, cur.a11);
            PG8_WAIT_V(8); PG8_WAIT_L(0); PG8_BAR; PG8_MMA(0, 0, At, B0); PG8_MMA(0, 1, At, B1); PG8_BAR; PG8_SCHED;
            PG8_LDA(At, 0, 1); PG8_STAGE_B(PG8_SB(0, 0), b2); PG8_STAGE_B(PG8_SB(0, 1), b2 + hstepW); PG8_STAGE_A(PG8_SA(0, 0), a2, 0, x00, x01);
            PG8_WAIT_V(8); PG8_WAIT_L(0); PG8_BAR; PG8_MMA(1, 0, At, B0); PG8_MMA(1, 1, At, B1); PG8_BAR; PG8_SCHED;
            PG8_LDB(B0, 1, 0); PG8_LDB(B1, 1, 1); PG8_SCHED; PG8_LDA(At, 1, 0); PG8_STAGE_A(PG8_SA(0, 1), a2, 1, x10, x11);
            PG8_WAIT_V(8); PG8_WAIT_L(0); PG8_BAR; PG8_MMA(0, 0, At, B0); PG8_MMA(0, 1, At, B1); PG8_BAR; PG8_SCHED;
            PG8_LDA(At, 1, 1); PG8_STAGE_B(PG8_SB(1, 0), b3); PG8_STAGE_B(PG8_SB(1, 1), b3 + hstepW); PG8_STAGE_A(PG8_SA(1, 0), a3, 0, x00, x01);
            PG8_WAIT_V(8); PG8_WAIT_L(0); PG8_BAR; PG8_MMA(1, 0, At, B0); PG8_MMA(1, 1, At, B1); PG8_BAR; PG8_SCHED;
        }
        if constexpr (Epi::FP8) asm volatile("s_nop 15\n\ts_nop 7" ::: "memory");
        if constexpr (ALIGN_EPI) { if (wr == 0) PG8_BAR; }
        E(acc, cur, wr, wc, fr, fq);
        if (!has_next) break;
#pragma unroll
        for (int a = 0; a < 2; ++a)
#pragma unroll
            for (int b = 0; b < 2; ++b)
#pragma unroll
                for (int m = 0; m < 4; ++m)
#pragma unroll
                    for (int n = 0; n < 2; ++n) acc[a][b][m][n] = (f32x4){0.f, 0.f, 0.f, 0.f};
        cur = nxt; ++ui;
        if constexpr (Sched::GATHER) { const u32x4 nv = *(const LAS u32x4*)(lds + NXT_SLOT_OFF + tid * 16); cur.a00 = nv.x; cur.a01 = nv.y; cur.a10 = nv.z; cur.a11 = nv.w; }
        if constexpr (ALIGN_EPI) { if (wr == 1) PG8_BAR; }
    }
    PG8_WAIT_V(0);
    if constexpr (!ALIGN_EPI) { if (wr == 0) PG8_BAR; }
    PG8_BAR;
#undef PG8_SA
#undef PG8_SB
#undef PG8_STAGE_A
#undef PG8_STAGE_B
#undef PG8_LDA
#undef PG8_LDB
#undef PG8_MMA
#undef PG8_WAIT_V
#undef PG8_WAIT_L
#undef PG8_BAR
#undef PG8_SCHED
}
}

#define XB_TMO      128
#define XB_XCNT(j)  (256  + 64 * (j))
#define XB_XSUB(j)  (1280 + 64 * (j))
#define XB_XGEN(j)  (2304 + 64 * (j))
#define XB_TOP      3328
#define XB_TOPGEN   3392
#define XCD_BAR_WORDS 3456
#define XB_SPIN_CAP (1u << 22)
__device__ __forceinline__ unsigned xb_ld(unsigned* p)              { return __hip_atomic_load(p, __ATOMIC_RELAXED, __HIP_MEMORY_SCOPE_AGENT); }
__device__ __forceinline__ unsigned xb_add(unsigned* p, unsigned v) { return __hip_atomic_fetch_add(p, v, __ATOMIC_RELAXED, __HIP_MEMORY_SCOPE_AGENT); }
__device__ __forceinline__ unsigned xb_xcc_id() { return (unsigned)__builtin_amdgcn_s_getreg((3 << 11) | 20) & 0xFu; }
#define XB_SPIN(cond, bar) do { unsigned _sp = 0; while (cond) { __builtin_amdgcn_s_sleep(1); \
    if ((++_sp & 255u) == 0u) { if (xb_ld(&(bar)[XB_TMO])) break; if (_sp > XB_SPIN_CAP) { atomicAdd(&(bar)[XB_TMO], 1u); break; } } } } while (0)
struct XcdBarrier { unsigned* bar; unsigned x; volatile LAS unsigned* st; };
__device__ __forceinline__ XcdBarrier xcd_barrier_post(unsigned* bar, volatile LAS unsigned* st) {
    XcdBarrier b; b.bar = bar; b.x = xb_xcc_id(); b.st = st;
    if (threadIdx.x == 0) (void)xb_add(&bar[XB_XCNT(b.x)], 1u);
    return b;
}
__device__ __forceinline__ void xcd_barrier_complete(unsigned* bar, unsigned x, unsigned& nloc, unsigned& nx) {
    const unsigned G = gridDim.x * gridDim.y * gridDim.z;
    unsigned sum, cnt, mine, sp = 0u;
    for (;;) {
        sum = 0u; cnt = 0u; mine = 0u;
#pragma unroll
        for (unsigned j = 0; j < 16; ++j) { const unsigned c = xb_ld(&bar[XB_XCNT(j)]); sum += c; cnt += (c > 0u) ? 1u : 0u; mine = (j == x) ? c : mine; }
        if (sum == G) break;
        __builtin_amdgcn_s_sleep(1);
        if ((++sp & 255u) == 0u) { if (xb_ld(&bar[XB_TMO])) break; if (sp > XB_SPIN_CAP) { atomicAdd(&bar[XB_TMO], 1u); break; } }
    }
    nloc = mine > 0u ? mine : 1u; nx = cnt > 0u ? cnt : 1u;
}
__device__ __forceinline__ void xcd_barrier(const XcdBarrier& b) {
    asm volatile("s_waitcnt vmcnt(0)" ::: "memory");
    __syncthreads();
    if (threadIdx.x == 0) {
        unsigned* bar = b.bar;
        __builtin_amdgcn_s_waitcnt(0);
        unsigned nloc = b.st[0], nx = b.st[1];
        if (nloc == 0u) { xcd_barrier_complete(bar, b.x, nloc, nx); b.st[0] = nloc; b.st[1] = nx; }
        const unsigned old = xb_add(&bar[XB_XSUB(b.x)], 1u);
        const unsigned gen = old / nloc;
        if (old + 1u == (gen + 1u) * nloc) {
            __builtin_amdgcn_fence(__ATOMIC_RELEASE, "agent");
            asm volatile("s_waitcnt vmcnt(0)" ::: "memory");
            const unsigned og = xb_add(&bar[XB_TOP], 1u);
            const unsigned tg = og / nx;
            if (og + 1u == (tg + 1u) * nx) xb_add(&bar[XB_TOPGEN], 1u);
            else XB_SPIN(xb_ld(&bar[XB_TOPGEN]) == tg, bar);
            __builtin_amdgcn_fence(__ATOMIC_ACQUIRE, "agent");
            xb_add(&bar[XB_XGEN(b.x)], 1u);
            asm volatile("s_waitcnt vmcnt(0)" ::: "memory");
        } else {
            XB_SPIN(xb_ld(&bar[XB_XGEN(b.x)]) == gen, bar);
            __builtin_amdgcn_fence(__ATOMIC_ACQUIRE, "agent");
            asm volatile("s_waitcnt vmcnt(0)" ::: "memory");
        }
    }
    __syncthreads();
}

struct Args {
    const float* in[19];
    float* out; unsigned char* ws;
    int ph_lo, ph_hi, use_bar, rep;
};
struct Ctx {
    const float *x, *mem, *w_in, *b_in, *w_mem_kv, *sinks, *rel_bias, *lb_logits, *hnorm, *w_out, *ln1g, *ln1b, *w_router, *rbias, *w_gate, *w_up, *w_down, *ln2g, *ln2b;
    float* xcur;
    unsigned char* ws;
    unsigned* ctl;
    bf16 *Win, *Wout, *Wmem, *W1, *W2, *xb, *proj, *ys, *mix, *hmid, *memkv, *memb;
    bf16* hpre; float* biastab; float* lbtab; int* list; u32x4* tokrec; float* hst; unsigned char* xb8;
    int vcu, G, rep;
};

__constant__ unsigned char T5_BUCKET[128] = {0, 1, 2, 3, 4, 5, 6, 7, 8, 9, 10, 11, 12, 13, 14, 15, 16, 16, 16, 17, 17, 18, 18, 18, 19, 19, 19, 20, 20, 20, 20, 21, 21, 21, 21, 22, 22, 22, 22, 22, 23, 23, 23, 23, 23, 23, 24, 24, 24, 24, 24, 24, 25, 25, 25, 25, 25, 25, 25, 26, 26, 26, 26, 26, 26, 26, 26, 27, 27, 27, 27, 27, 27, 27, 27, 27, 27, 28, 28, 28, 28, 28, 28, 28, 28, 28, 28, 29, 29, 29, 29, 29, 29, 29, 29, 29, 29, 29, 29, 30, 30, 30, 30, 30, 30, 30, 30, 30, 30, 30, 30, 30, 30, 31, 31, 31, 31, 31, 31, 31, 31, 31, 31, 31, 31, 31, 31, 31};

struct TrItem { const float* src; bf16* dst; int N, K; float fp8s; };
__device__ __forceinline__ bool p0_item(const Ctx& C, int it, TrItem& t) {
    constexpr int I_IN = DEPTH * 16 * 64, I_OUT = DEPTH * 16 * 32, I_MEM = DEPTH * 16 * 16, I_G = 64 * 16 * 16, I_D = 64 * 8 * 32;
    constexpr int NITEMS = I_IN + I_OUT + I_MEM + 2 * I_G + I_D;
    if (it >= NITEMS) return false;
    int r = it;
    if (r < I_IN) { const int l = r / 1024, q = r % 1024, kb = q / 64, nb = q % 64; t.fp8s = 32.f; t.N = INW; t.K = DM; t.src = C.w_in + (size_t)l * DM * INW + (size_t)(64 * kb) * INW + 32 * nb; t.dst = (bf16*)((unsigned char*)C.Win + (size_t)l * INW * DM + (size_t)(32 * nb) * DM + 64 * kb); return true; } r -= I_IN;
    if (r < I_OUT) { const int l = r / 512, q = r % 512, kb = q / 32, nb = q % 32; t.fp8s = 64.f; t.N = DM; t.K = MIXW; t.src = C.w_out + (size_t)l * MIXW * DM + (size_t)(64 * kb) * DM + 32 * nb; t.dst = (bf16*)((unsigned char*)C.Wout + (size_t)l * DM * MIXW + (size_t)(32 * nb) * MIXW + 64 * kb); return true; } r -= I_OUT;
    if (r < I_MEM) { const int l = r / 256, q = r % 256, kb = q / 16, nb = q % 16; t.fp8s = 32.f; t.N = 512; t.K = DM; t.src = C.w_mem_kv + (size_t)l * DM * 512 + (size_t)(64 * kb) * 512 + 32 * nb; t.dst = (bf16*)((unsigned char*)C.Wmem + (size_t)l * 512 * DM + (size_t)(32 * nb) * DM + 64 * kb); return true; } r -= I_MEM;
    if (r < 2 * I_G) { const int up = r >= I_G; if (up) r -= I_G; const int le = r / 256, q = r % 256, kb = q / 16, nb = q % 16; const int n0 = 32 * nb;
        t.N = DE; t.K = DM; t.src = (up ? C.w_up : C.w_gate) + (size_t)le * DM * DE + (size_t)(64 * kb) * DE + n0; t.fp8s = 32.f; t.dst = (bf16*)((unsigned char*)C.W1 + (size_t)le * 1024 * DM + (size_t)((n0 >> 7) * 256 + (up ? 128 : 0) + (n0 & 127)) * DM + 64 * kb); return true; } r -= 2 * I_G;
    { const int le = r / 256, q = r % 256, kb = q / 32, nb = q % 32; t.N = DM; t.K = DE; t.src = C.w_down + (size_t)le * DE * DM + (size_t)(64 * kb) * DM + 32 * nb; t.fp8s = 64.f; t.dst = (bf16*)((unsigned char*)C.W2 + (size_t)le * DM * DE + (size_t)(32 * nb) * DE + 64 * kb); }
    return true;
}
__device__ __forceinline__ void p0_prologue(const Ctx& C, LAS unsigned char* lds, int wave, int lane) {
    LAS float* scr = (LAS float*)(lds + wave * 16384);
    const int gw = C.vcu * NWAVES + wave, NGW = C.G * NWAVES;
    {
        TrItem cur, nxt; float va[32], vb[32];
        bool have = p0_item(C, gw, cur);
        if (have) {
#pragma unroll
            for (int i = 0; i < 32; ++i) va[i] = cur.src[(size_t)(2 * i + (lane >> 5)) * cur.N + (lane & 31)];
        }
        for (int it = gw; have; it += NGW) {
            const bool hn = p0_item(C, it + NGW, nxt);
            if (hn) {
#pragma unroll
                for (int i = 0; i < 32; ++i) vb[i] = nxt.src[(size_t)(2 * i + (lane >> 5)) * nxt.N + (lane & 31)];
            }
#pragma unroll
            for (int i = 0; i < 32; ++i) scr[(2 * i + (lane >> 5)) * 33 + (lane & 31)] = va[i];
            const int c = lane & 7;
#pragma unroll
            for (int j = 0; j < 4; ++j) { const int n = (lane >> 3) + 8 * j; const LAS float* s = scr + (8 * c) * 33 + n;
                if (cur.fp8s != 0.f) { const float sc = cur.fp8s;
                    int w0 = __builtin_amdgcn_cvt_pk_fp8_f32(s[0 * 33] * sc, s[1 * 33] * sc, 0, false); w0 = __builtin_amdgcn_cvt_pk_fp8_f32(s[2 * 33] * sc, s[3 * 33] * sc, w0, true);
                    int w1 = __builtin_amdgcn_cvt_pk_fp8_f32(s[4 * 33] * sc, s[5 * 33] * sc, 0, false); w1 = __builtin_amdgcn_cvt_pk_fp8_f32(s[6 * 33] * sc, s[7 * 33] * sc, w1, true);
                    u32x2 o8; o8.x = (unsigned)w0; o8.y = (unsigned)w1;
                    *(u32x2*)((unsigned char*)cur.dst + (size_t)n * cur.K + 8 * c) = o8; }
                else { u32x4 o; o.x = pk2(s[0 * 33], s[1 * 33]); o.y = pk2(s[2 * 33], s[3 * 33]); o.z = pk2(s[4 * 33], s[5 * 33]); o.w = pk2(s[6 * 33], s[7 * 33]);
                    *(u32x4*)(cur.dst + (size_t)n * cur.K + 8 * c) = o; } }
#pragma unroll
            for (int i = 0; i < 32; ++i) va[i] = vb[i];
            cur = nxt; have = hn;
        }
    }
    for (int m = gw; m < NTOK + NB * MEMLEN; m += NGW) {
        const bool ism = m >= NTOK; const int r = ism ? m - NTOK : m;
        const f32x4* src = (const f32x4*)((ism ? C.mem : C.x) + (size_t)r * DM) + lane;
        f32x4 v[4];
#pragma unroll
        for (int j = 0; j < 4; ++j) v[j] = src[64 * j];
        unsigned* q8 = (unsigned*)((ism ? (unsigned char*)C.memb : C.xb8) + (size_t)r * DM) + lane;
        unsigned* ql = (unsigned*)((unsigned char*)C.xb + (size_t)r * DM) + lane;
#pragma unroll
        for (int j = 0; j < 4; ++j) { unsigned hi, lo; split_fp8(v[j], hi, lo); q8[64 * j] = hi; if (!ism) ql[64 * j] = lo; }
    }
    if (blockIdx.x == 0) {
        const int tid = wave * 64 + lane;
        for (int i = tid; i < 8 * 128; i += NTHR) { const int h = i >> 7, d = i & 127; C.biastab[i] = C.rel_bias[(int)T5_BUCKET[d] * 8 + h]; }
        if (tid < 256) { float v0 = C.lb_logits[tid], v1 = C.lb_logits[256 + tid], v2 = C.lb_logits[512 + tid], v3 = C.lb_logits[768 + tid];
            const float mx = fmaxf(fmaxf(v0, v1), fmaxf(v2, v3)); v0 = __expf(v0 - mx); v1 = __expf(v1 - mx); v2 = __expf(v2 - mx); v3 = __expf(v3 - mx);
            const float inv = 1.f / (v0 + v1 + v2 + v3);
            C.lbtab[tid] = 0.f; C.lbtab[256 + tid] = v1 * inv; C.lbtab[512 + tid] = (v1 + v2) * inv; C.lbtab[768 + tid] = (v1 + v2 + v3) * inv; }
    }
}

struct DenseSched {
    static constexpr bool GATHER = false;
    const char* A0; const char* B0; int nM0, nN0, K0;
    const char* A1; const char* B1; int nM1, nN1;
    int G, c;
    __device__ __forceinline__ void lane_init(int, int, int, int) {}
    __device__ __forceinline__ bool next(int i, pg8::Unit& u) const {
        const int n0 = nM0 * nN0; const int L = i * G + c; if (L >= n0 + nM1 * nN1) return false;
        int pm, pn; const char* A; const char* B; int aux;
        if (L < n0) { pg8::tile_order(L, nM0, nN0, pm, pn); A = A0; B = B0; aux = 0; }
        else { pg8::tile_order(L - n0, nM1, nN1, pm, pn); A = A1; B = B1; aux = 1; }
        u.A = A + (size_t)pm * 256 * K0; u.B = B + (size_t)pn * 256 * K0;
        u.a00 = 0u; u.a01 = 0u; u.a10 = 0u; u.a11 = 0u;
        u.row0 = pm * 256; u.col0 = pn * 256; u.aux = aux; return true;
    }
};
template <bool GATHER_> struct MoeSched {
    static constexpr bool GATHER = GATHER_;
    const char* A; const char* Bl; int K; size_t bstride;
    const int* list; const LAS int* tb;
    int g0, g1, gU, mode; int R0, C0, R1, C1;
    __device__ __forceinline__ void lane_init(int r0, int c0, int r1, int c1) { R0 = r0; C0 = c0; R1 = r1; C1 = c1; }
    __device__ __forceinline__ bool next(int i, pg8::Unit& u) const {
        int g;
        if (mode == 0) { g = g0 + i * g1; if (g >= gU) return false; }
        else {
            const int c = g0, E = g1;
            if (c < E) { if (i == 0) g = 1024 + c; else if (i <= 2) g = c + (i - 1) * E; else return false; }
            else { g = 2 * E + (c - E) + i * (256 - E); if (g >= gU) return false; }
        }
        const int tile = g >> 2, pn = g & 3;
        int e = 0;
#pragma unroll
        for (int j = 1; j < 16; ++j) e += (tile >= tb[j]) ? 1 : 0;
        e = __builtin_amdgcn_readfirstlane(e);
        u.B = Bl + (size_t)e * bstride + (size_t)pn * 256 * K;
        u.A = A;
        if (GATHER) {
            const int p0 = (tile - __builtin_amdgcn_readfirstlane(tb[e])) * 256, cnt = __builtin_amdgcn_readfirstlane(tb[17 + e]); const int* le = list + (size_t)e * LCAP;
            const int cm = cnt - 1;
            const int t00 = le[min(p0 + R0, cm)], t01 = le[min(p0 + R1, cm)], t10 = le[min(p0 + 128 + R0, cm)], t11 = le[min(p0 + 128 + R1, cm)];
            u.a00 = (unsigned)t00 * K + 2 * C0; u.a01 = (unsigned)t01 * K + 2 * C1; u.a10 = (unsigned)t10 * K + 2 * C0; u.a11 = (unsigned)t11 * K + 2 * C1;
        } else {
            u.A = A + (size_t)tile * 256 * K; u.a00 = 0u; u.a01 = 0u; u.a10 = 0u; u.a11 = 0u;
        }
        u.row0 = tile * 256; u.col0 = pn * 256; u.aux = e; return true;
    }
};
struct EpiProj {
    static constexpr bool PERM = true, PERM16 = true, FP8 = true; static constexpr int SCALE_W = 0x7A7A7A7A  , SCALE_A = 0x7C7C7C7C  ;
    unsigned char* O0; const float* bias; unsigned char* O1;
    __device__ __forceinline__ void operator()(const f32x4 (&acc)[2][2][4][2], const pg8::Unit& u, int wr, int wc, int fr, int fq) const {
        unsigned char* base = u.aux ? O1 : O0; const int row0 = u.row0 + wr * 64 + fr, col0 = u.col0 + wc * 64 + 16 * fq;
        f32x4 bv[2][2];
#pragma unroll
        for (int bj = 0; bj < 2; ++bj)
#pragma unroll
            for (int n = 0; n < 2; ++n) bv[bj][n] = u.aux ? (f32x4){0.f, 0.f, 0.f, 0.f} : *(const f32x4*)(bias + col0 + 8 * bj + 4 * n);
#pragma unroll
        for (int ai = 0; ai < 2; ++ai)
#pragma unroll
            for (int m = 0; m < 4; ++m) { unsigned char* rowp = base + (size_t)(row0 + ai * 128 + m * 16) * INW + col0;
                u32x4 w; w.x = pk_fp8x4((acc[ai][0][m][0] + bv[0][0]) * 8.f); w.y = pk_fp8x4((acc[ai][0][m][1] + bv[0][1]) * 8.f); w.z = pk_fp8x4((acc[ai][1][m][0] + bv[1][0]) * 8.f); w.w = pk_fp8x4((acc[ai][1][m][1] + bv[1][1]) * 8.f);
                *(u32x4*)rowp = w; }
    }
};
struct EpiOut {
    static constexpr bool PERM = true, PERM16 = true, FP8 = true; static constexpr int SCALE_W = 0x79797979  , SCALE_A = 0x7C7C7C7C  ;
    unsigned char* H;
    __device__ __forceinline__ void operator()(const f32x4 (&acc)[2][2][4][2], const pg8::Unit& u, int wr, int wc, int fr, int fq) const {
        const int row0 = u.row0 + wr * 64 + fr, col0 = u.col0 + wc * 64 + 16 * fq;
#pragma unroll
        for (int ai = 0; ai < 2; ++ai)
#pragma unroll
            for (int m = 0; m < 4; ++m) { const size_t off = (size_t)(row0 + ai * 128 + m * 16) * DM + col0;
                u32x4 w; w.x = pk_fp8x4(acc[ai][0][m][0] * 64.f); w.y = pk_fp8x4(acc[ai][0][m][1] * 64.f); w.z = pk_fp8x4(acc[ai][1][m][0] * 64.f); w.w = pk_fp8x4(acc[ai][1][m][1] * 64.f);
                *(u32x4*)(H + off) = w; }
    }
};
struct EpiG1 {
    static constexpr bool PERM = true, PERM16 = false, FP8 = true; static constexpr int SCALE_W = 0x7A7A7A7A  , SCALE_A = 0x7C7C7C7C  ;
    unsigned char* O;
    __device__ __forceinline__ void operator()(const f32x4 (&acc)[2][2][4][2], const pg8::Unit& u, int wr, int wc, int fr, int fq) const {
        const int row0 = u.row0 + wr * 64 + fr, col0 = (u.col0 >> 1) + wc * 32 + 8 * fq;
#pragma unroll
        for (int ai = 0; ai < 2; ++ai)
#pragma unroll
            for (int m = 0; m < 4; ++m) { unsigned char* rowp = O + (size_t)(row0 + ai * 128 + m * 16) * DE + col0;
                float hv[8];
#pragma unroll
                for (int n = 0; n < 2; ++n)
#pragma unroll
                    for (int j = 0; j < 4; ++j) { const float gte = acc[ai][0][m][n][j], up = acc[ai][1][m][n][j]; hv[n * 4 + j] = gte * frcp(1.f + __expf(-gte)) * up * 8.f; }
                int w0 = __builtin_amdgcn_cvt_pk_fp8_f32(hv[0], hv[1], 0, false); w0 = __builtin_amdgcn_cvt_pk_fp8_f32(hv[2], hv[3], w0, true);
                int w1 = __builtin_amdgcn_cvt_pk_fp8_f32(hv[4], hv[5], 0, false); w1 = __builtin_amdgcn_cvt_pk_fp8_f32(hv[6], hv[7], w1, true);
                u32x2 w; w.x = (unsigned)w0; w.y = (unsigned)w1;
                *(u32x2*)rowp = w; }
    }
};
struct EpiG2 {
    static constexpr bool PERM = true, PERM16 = true, FP8 = true; static constexpr int SCALE_W = 0x79797979  , SCALE_A = 0x7C7C7C7C  ;
    unsigned char* O;
    __device__ __forceinline__ void operator()(const f32x4 (&acc)[2][2][4][2], const pg8::Unit& u, int wr, int wc, int fr, int fq) const {
        const int row0 = u.row0 + wr * 64 + fr, col0 = u.col0 + wc * 64 + 16 * fq;
#pragma unroll
        for (int ai = 0; ai < 2; ++ai)
#pragma unroll
            for (int m = 0; m < 4; ++m) { unsigned char* rowp = O + (size_t)(row0 + ai * 128 + m * 16) * DM + col0;
                u32x4 w; w.x = pk_fp8x4(acc[ai][0][m][0] * 16.f); w.y = pk_fp8x4(acc[ai][0][m][1] * 16.f); w.z = pk_fp8x4(acc[ai][1][m][0] * 16.f); w.w = pk_fp8x4(acc[ai][1][m][1] * 16.f);
                *(u32x4*)rowp = w; }
    }
};

constexpr int AT_KOFF = 0, AT_VOFF = 36864, AT_BOFF = 73728, AT_OOFF = 77824;
template <bool SWA>
__device__ __forceinline__ void attn_item(const Ctx& C, LAS unsigned char* lds, int l, int item, int tid, int wave, int lane) {
    const int tk = lane & 15, g = lane >> 4;
    int b, nb = 0, kvh = 0, hm = 0, qb = 0;
    const unsigned char *Kg, *Vg; size_t kpitch;
    if (SWA) { b = item >> 6; nb = (item >> 1) & 31; kvh = item & 1;
        Kg = (const unsigned char*)C.proj + ((size_t)b * SEQ + (size_t)(nb - 1) * 128) * INW + C_SK + kvh * 64; Vg = Kg + (C_SV - C_SK); kpitch = INW; }
    else { b = item >> 5; hm = (item >> 3) & 3; qb = item & 7;
        Kg = (const unsigned char*)C.memkv + (size_t)b * MEMLEN * 2048 + l * 512 + hm * 64; Vg = Kg + 256; kpitch = 2048; }
    __syncthreads();
#pragma unroll
    for (int i = 0; i < 4; ++i) { const int c = tid + 512 * i, key = c >> 3, part = c & 7;
        u32x2 k8 = {0u, 0u}, v8 = {0u, 0u};
        if (!SWA || nb > 0 || key >= 128) { k8 = *(const u32x2*)(Kg + (size_t)key * kpitch + part * 8); v8 = *(const u32x2*)(Vg + (size_t)key * kpitch + part * 8); }
        *(LAS u32x4*)(lds + AT_KOFF + key * 144 + part * 16) = fp8x8_to_bf16x8(k8); *(LAS u32x4*)(lds + AT_VOFF + key * 144 + part * 16) = fp8x8_to_bf16x8(v8); }
    if (SWA) ((LAS float*)(lds + AT_BOFF))[tid] = C.biastab[(kvh * 4 + (tid >> 7)) * 128 + (tid & 127)] * 1.44269504f;
    __syncthreads();
    int hq = 0; float sink = 0.f; size_t qrow_base; int qcol, ocol, i0w = 0;
    if (SWA) { hq = kvh * 4 + (wave >> 1); sink = C.sinks[l * 8 + hq]; i0w = (wave & 1) * 64; qrow_base = (size_t)b * SEQ + nb * 128 + i0w; qcol = C_SQ + hq * 64; ocol = hq * 64; }
    else { qrow_base = (size_t)b * SEQ + qb * 512 + wave * 64; qcol = C_MQ + hm * 64; ocol = 768 + hm * 64; }
    const LAS float* biasL = (const LAS float*)(lds + AT_BOFF) + (wave >> 1) * 128;
    const LAS unsigned char* kbase = lds + AT_KOFF + tk * 144 + g * 16;
    const LAS unsigned char* vbase = lds + AT_VOFF + (4 * g + (tk >> 2)) * 144 + (tk & 3) * 8;
#pragma unroll 1
    for (int rt = 0; rt < 4; ++rt) {
        const size_t qrow = qrow_base + rt * 16;
        const unsigned char* qp = (const unsigned char*)C.proj + (qrow + tk) * INW + qcol + 8 * g;
        const bf16x8 q0 = __builtin_bit_cast(bf16x8, fp8x8_to_bf16x8(*(const u32x2*)qp)), q1 = __builtin_bit_cast(bf16x8, fp8x8_to_bf16x8(*(const u32x2*)(qp + 32)));
        constexpr int NT = SWA ? 10 : 16;
        const int t0 = SWA ? ((i0w >> 4) + rt) : 0;
        f32x4 st[NT];
#pragma unroll
        for (int t = 0; t < NT; ++t) {
            const int tc = SWA ? min(t0 + t, 15) : t;
            const bf16x8 k0 = *(const LAS bf16x8*)(kbase + tc * 16 * 144), k1 = *(const LAS bf16x8*)(kbase + tc * 16 * 144 + 64);
            f32x4 a = {0.f, 0.f, 0.f, 0.f};
            a = __builtin_amdgcn_mfma_f32_16x16x32_bf16(k0, q0, a, 0, 0, 0);
            st[t] = __builtin_amdgcn_mfma_f32_16x16x32_bf16(k1, q1, a, 0, 0, 0);
        }
        constexpr float C2 = 0.125f * 1.44269504f * (1.f / 64.f);
        float mx2, sum = 0.f;
        if (SWA) {
            const float sink2 = sink * 1.44269504f;
            const int iq = i0w + rt * 16 + tk;
            const int d0 = iq + 128 - 16 * t0 - 4 * g;
            const unsigned lim = (nb > 0) ? 128u : (unsigned)min(128, iq + 1);
            const LAS float* bl = biasL + (d0 - 16 * (NT - 1) - 3);
            float m4[4] = {sink2, sink2, sink2, sink2};
#pragma unroll
            for (int t = 0; t < NT; ++t)
#pragma unroll
                for (int r = 0; r < 4; ++r) {
                    const unsigned dist = (unsigned)(d0 - 16 * t - r);
                    const float xv = (dist < lim) ? __builtin_fmaf(st[t][r], C2, bl[16 * (NT - 1 - t) + (3 - r)]) : -INFINITY;
                    st[t][r] = xv; m4[r] = fmaxf(m4[r], xv);
                }
            mx2 = fmaxf(fmaxf(m4[0], m4[1]), fmaxf(m4[2], m4[3]));
            mx2 = xmax16(mx2); mx2 = xmax32(mx2);
            float s4[4] = {0.f, 0.f, 0.f, 0.f};
#pragma unroll
            for (int t = 0; t < NT; ++t)
#pragma unroll
                for (int r = 0; r < 4; ++r) { const float p = __builtin_amdgcn_exp2f(st[t][r] - mx2); st[t][r] = p; s4[r] += p; }
            sum = (s4[0] + s4[1]) + (s4[2] + s4[3]);
            sum = xsum16(sum); sum = xsum32(sum);
            sum += __builtin_amdgcn_exp2f(sink2 - mx2);
        } else {
            float m4[4] = {st[0][0], st[0][1], st[0][2], st[0][3]};
#pragma unroll
            for (int t = 1; t < NT; ++t)
#pragma unroll
                for (int r = 0; r < 4; ++r) m4[r] = fmaxf(m4[r], st[t][r]);
            float mr = fmaxf(fmaxf(m4[0], m4[1]), fmaxf(m4[2], m4[3]));
            mr = xmax16(mr); mr = xmax32(mr);
            const float nm = -mr * C2;
            float s4[4] = {0.f, 0.f, 0.f, 0.f};
#pragma unroll
            for (int t = 0; t < NT; ++t)
#pragma unroll
                for (int r = 0; r < 4; ++r) { const float p = __builtin_amdgcn_exp2f(__builtin_fmaf(st[t][r], C2, nm)); st[t][r] = p; s4[r] += p; }
            sum = (s4[0] + s4[1]) + (s4[2] + s4[3]);
            sum = xsum16(sum); sum = xsum32(sum);
        }
        const float inv = frcp(sum);
        f32x4 o[4];
#pragma unroll
        for (int n = 0; n < 4; ++n) o[n] = (f32x4){0.f, 0.f, 0.f, 0.f};
#pragma unroll
        for (int s = 0; s < NT / 2; ++s) {
            const f32x4 pa = st[2 * s] * inv, pb = st[2 * s + 1] * inv;
            const bf16x8 pfrag = mk8(pk2(pa[0], pa[1]), pk2(pa[2], pa[3]), pk2(pb[0], pb[1]), pk2(pb[2], pb[3]));
            const int ta = SWA ? min(t0 + 2 * s, 15) : 2 * s, tb2 = SWA ? min(t0 + 2 * s + 1, 15) : 2 * s + 1;
#pragma unroll
            for (int n = 0; n < 4; ++n) {
                const s16x4 lo = ld_tr(vbase + (16 * ta) * 144 + n * 32), hi = ld_tr(vbase + (16 * tb2) * 144 + n * 32);
                const bf16x8 vf = {lo[0], lo[1], lo[2], lo[3], hi[0], hi[1], hi[2], hi[3]};
                o[n] = __builtin_amdgcn_mfma_f32_16x16x32_bf16(pfrag, vf, o[n], 0, 0, 0);
            }
        }
        LAS unsigned char* ost = lds + AT_OOFF + wave * 2304;
#pragma unroll
        for (int r = 0; r < 4; ++r)
#pragma unroll
            for (int n = 0; n < 4; n += 2) { const unsigned w = (unsigned)__builtin_amdgcn_cvt_pk_fp8_f32(o[n][r], o[n + 1][r], 0, false);
                *(LAS unsigned char*)(ost + (4 * g + r) * 80 + 16 * n + tk) = (unsigned char)(w & 0xffu); *(LAS unsigned char*)(ost + (4 * g + r) * 80 + 16 * (n + 1) + tk) = (unsigned char)((w >> 8) & 0xffu); }
        { const int orow = lane >> 2, part = lane & 3;
            const u32x4 w = *(const LAS u32x4*)(ost + orow * 80 + part * 16);
            *(u32x4*)((unsigned char*)C.mix + (size_t)(qrow + orow) * MIXW + ocol + part * 16) = w; }
    }
}

template <bool PB>
__device__ __forceinline__ void hgrn_item(const Ctx& C, LAS unsigned char* lds, int wv, int l, int witem, int lane) {
    LAS unsigned char* scr = lds + wv * 4608;
    const int tk = lane & 15, g = lane >> 4;
    const int bh = witem / NSEG, seg = witem % NSEG, b = bh >> 2, h = bh & 3;
    float oml[4][4];
#pragma unroll
    for (int c = 0; c < 4; ++c)
#pragma unroll
        for (int i = 0; i < 4; ++i) oml[c][i] = 1.f - C.lbtab[l * 256 + h * 64 + 16 * c + 4 * g + i];
    f32x4 S[4][4];
#pragma unroll
    for (int mt = 0; mt < 4; ++mt)
#pragma unroll
        for (int n = 0; n < 4; ++n) S[mt][n] = (f32x4){0.f, 0.f, 0.f, 0.f};
    float dseg[4][4];
#pragma unroll
    for (int c = 0; c < 4; ++c)
#pragma unroll
        for (int i = 0; i < 4; ++i) dseg[c][i] = 1.f;
    if (PB) {
        if (lane == 0 && wv == 0) {
            unsigned* cnt = C.ctl + CW_HA + (l * 32 + bh) * 64; unsigned sp = 0;
            while (__hip_atomic_load(cnt, __ATOMIC_RELAXED, __HIP_MEMORY_SCOPE_AGENT) < (unsigned)(NSEG / NWAVES)) { __builtin_amdgcn_s_sleep(2); if (++sp > (1u << 24)) break; }
            __builtin_amdgcn_fence(__ATOMIC_ACQUIRE, "agent");
            asm volatile("s_waitcnt vmcnt(0)" ::: "memory");
        }
    }
    if (PB) {
        LAS float* pl = (LAS float*)lds;
        const int seg0 = seg - wv;
        __syncthreads();
#pragma unroll 1
        for (int qq = 0; qq < 8; ++qq) {
            const int q = wv * 8 + qq, dq = 64 + (q >> 4) * 4 + (q & 3);
            const float* base = C.hst + (size_t)bh * NSEG * 80 * 64 + lane;
            float Sx = 0.f;
            for (int j0 = 0; j0 < seg0; j0 += 8) {
                float dv[8], sv[8];
#pragma unroll
                for (int j = 0; j < 8; ++j) { dv[j] = base[((size_t)(j0 + j) * 80 + dq) * 64]; sv[j] = base[((size_t)(j0 + j) * 80 + q) * 64]; }
#pragma unroll
                for (int j = 0; j < 8; ++j) Sx = Sx * dv[j] + sv[j];
            }
            float dv[8], sv[8];
#pragma unroll
            for (int j = 0; j < 8; ++j) { dv[j] = base[((size_t)(seg0 + j) * 80 + dq) * 64]; sv[j] = base[((size_t)(seg0 + j) * 80 + q) * 64]; }
#pragma unroll
            for (int j = 0; j < 8; ++j) { pl[(j * 64 + q) * 64 + lane] = Sx; Sx = Sx * dv[j] + sv[j]; }
        }
        __syncthreads();
#pragma unroll
        for (int mt = 0; mt < 4; ++mt)
#pragma unroll
            for (int n = 0; n < 4; ++n)
#pragma unroll
                for (int r = 0; r < 4; ++r) S[mt][n][r] = pl[(wv * 64 + (mt * 4 + n) * 4 + r) * 64 + lane];
        __syncthreads();
    }
    float nw[4][4];
    if (PB) {
#pragma unroll
        for (int c = 0; c < 4; ++c)
#pragma unroll
            for (int i = 0; i < 4; ++i) nw[c][i] = C.hnorm[l * 64 + 16 * c + 4 * g + i];
    }
    const size_t rowbase = (size_t)b * SEQ + (size_t)seg * CPS * 16;
    LAS unsigned char* sk = scr; LAS unsigned char* sv = scr + 2304;
    const LAS unsigned char* trk = sk + (4 * g + (tk >> 2)) * 144 + (tk & 3) * 8;
    const LAS unsigned char* trv = sv + (4 * g + (tk >> 2)) * 144 + (tk & 3) * 8;
    unsigned nzf[4], nvi[4];
    { const unsigned char* pr = (const unsigned char*)C.proj + (rowbase + tk) * INW + h * 64 + 4 * g;
#pragma unroll
        for (int c = 0; c < 4; ++c) { nzf[c] = *(const unsigned*)(pr + C_HF + 16 * c); nvi[c] = *(const unsigned*)(pr + C_HI + 16 * c); } }
#pragma unroll 1
    for (int ch = 0; ch < CPS; ++ch) {
        const size_t row = rowbase + ch * 16 + tk;
        unsigned zf_[4], vi_[4], zq_[4], gt_[4];
#pragma unroll
        for (int c = 0; c < 4; ++c) { zf_[c] = nzf[c]; vi_[c] = nvi[c]; }
        if (PB) { const unsigned char* pr = (const unsigned char*)C.proj + row * INW + h * 64 + 4 * g;
#pragma unroll
            for (int c = 0; c < 4; ++c) { zq_[c] = *(const unsigned*)(pr + C_HQ + 16 * c); gt_[c] = *(const unsigned*)(pr + C_HG + 16 * c); } }
        { const unsigned char* pr = (const unsigned char*)C.proj + (rowbase + (ch < CPS - 1 ? ch + 1 : ch) * 16 + tk) * INW + h * 64 + 4 * g;
#pragma unroll
            for (int c = 0; c < 4; ++c) { nzf[c] = *(const unsigned*)(pr + C_HF + 16 * c); nvi[c] = *(const unsigned*)(pr + C_HI + 16 * c); } }
        float kk[4][4], bcs[4][4], dreg[4][4];
#pragma unroll
        for (int c = 0; c < 4; ++c) { const f32x4 zf4 = dec_fp8x4(zf_[c]) * (0.125f * 1.44269504f);
#pragma unroll
            for (int i = 0; i < 4; ++i) {
                const float z = zf4[i];
                const float sneg = frcp(1.f + __builtin_amdgcn_exp2f(z));
                const float kv = oml[c][i] * sneg;
                kk[c][i] = kv;
                bcs[c][i] = row_scan16(__builtin_amdgcn_logf(__builtin_fmaf(-oml[c][i], sneg, 1.f)));
            } }
#pragma unroll
        for (int c = 0; c < 4; ++c)
#pragma unroll
            for (int i = 0; i < 4; ++i) { const float bl = DPPF(bcs[c][i], 0x15F); dreg[c][i] = __builtin_amdgcn_exp2f(bl); }
        unsigned kop_[4][2];
#pragma unroll
        for (int c = 0; c < 4; ++c) {
            const float e0 = kk[c][0] * __builtin_amdgcn_exp2f(-bcs[c][0]), e1 = kk[c][1] * __builtin_amdgcn_exp2f(-bcs[c][1]), e2 = kk[c][2] * __builtin_amdgcn_exp2f(-bcs[c][2]), e3 = kk[c][3] * __builtin_amdgcn_exp2f(-bcs[c][3]);
            kop_[c][0] = pk2(e0, e1); kop_[c][1] = pk2(e2, e3);
            u32x2 w; w.x = kop_[c][0]; w.y = kop_[c][1];
            *(LAS u32x2*)(sk + tk * 144 + (16 * c + 4 * g) * 2) = w;
            { const f32x4 vv = dec_fp8x4(vi_[c]) * 0.125f; u32x2 wv; wv.x = pk2(vv.x, vv.y); wv.y = pk2(vv.z, vv.w); *(LAS u32x2*)(sv + tk * 144 + (16 * c + 4 * g) * 2) = wv; }
        }
        s16x4 kT[4], vT[4];
#pragma unroll
        for (int m = 0; m < 4; ++m) { kT[m] = ld_tr(trk + m * 32); vT[m] = ld_tr(trv + m * 32); }
        f32x4 o[4];
        if (PB) {
            unsigned qop_[4][2];
#pragma unroll
            for (int c = 0; c < 4; ++c) {
                float qv[4]; const f32x4 zq8 = dec_fp8x4(zq_[c]);
#pragma unroll
                for (int i = 0; i < 4; ++i)
                    qv[i] = (zq8[i] * 0.015625f) * frcp(1.f + __builtin_amdgcn_exp2f(zq8[i] * (-0.125f * 1.44269504f))) * __builtin_amdgcn_exp2f(bcs[c][i]);
                qop_[c][0] = pk2(qv[0], qv[1]); qop_[c][1] = pk2(qv[2], qv[3]);
            }
            const bf16x8 qa = mk8(qop_[0][0], qop_[0][1], qop_[1][0], qop_[1][1]), qb2 = mk8(qop_[2][0], qop_[2][1], qop_[3][0], qop_[3][1]);
            const bf16x8 ka = mk8(kop_[0][0], kop_[0][1], kop_[1][0], kop_[1][1]), kb2 = mk8(kop_[2][0], kop_[2][1], kop_[3][0], kop_[3][1]);
            f32x4 sT = {0.f, 0.f, 0.f, 0.f};
            sT = __builtin_amdgcn_mfma_f32_16x16x32_bf16(ka, qa, sT, 0, 0, 0);
            sT = __builtin_amdgcn_mfma_f32_16x16x32_bf16(kb2, qb2, sT, 0, 0, 0);
#pragma unroll
            for (int r = 0; r < 4; ++r) if (4 * g + r > tk) sT[r] = 0.f;
            const s16x4 sT4 = mk4(pk2(sT[0], sT[1]), pk2(sT[2], sT[3]));
#pragma unroll
            for (int n = 0; n < 4; ++n) {
                f32x4 a = {0.f, 0.f, 0.f, 0.f};
                a = __builtin_amdgcn_mfma_f32_16x16x16bf16_1k(vT[n], sT4, a, 0, 0, 0);
                const bf16x8 s0 = mk8(pk2(S[0][n][0], S[0][n][1]), pk2(S[0][n][2], S[0][n][3]), pk2(S[1][n][0], S[1][n][1]), pk2(S[1][n][2], S[1][n][3]));
                const bf16x8 s1 = mk8(pk2(S[2][n][0], S[2][n][1]), pk2(S[2][n][2], S[2][n][3]), pk2(S[3][n][0], S[3][n][1]), pk2(S[3][n][2], S[3][n][3]));
                f32x4 a2 = {0.f, 0.f, 0.f, 0.f};
                a2 = __builtin_amdgcn_mfma_f32_16x16x32_bf16(s0, qa, a2, 0, 0, 0);
                a2 = __builtin_amdgcn_mfma_f32_16x16x32_bf16(s1, qb2, a2, 0, 0, 0);
                o[n] = a + a2;
            }
        }
#pragma unroll
        for (int mt = 0; mt < 4; ++mt)
#pragma unroll
            for (int n = 0; n < 4; ++n) {
                f32x4 a = __builtin_amdgcn_mfma_f32_16x16x16bf16_1k(kT[mt], vT[n], S[mt][n], 0, 0, 0);
#pragma unroll
                for (int r = 0; r < 4; ++r) a[r] *= dreg[mt][r];
                S[mt][n] = a;
            }
        if (PB) {
            float ss = 0.f;
#pragma unroll
            for (int n = 0; n < 4; ++n)
#pragma unroll
                for (int r = 0; r < 4; ++r) ss += o[n][r] * o[n][r];
            ss = xsum16(ss); ss = xsum32(ss);
            const float rinv = __builtin_amdgcn_rsqf(ss * (1.f / 64.f) + RMS_EPS);
            unsigned char* op = (unsigned char*)C.mix + row * MIXW + 512 + h * 64 + 4 * g;
#pragma unroll
            for (int n = 0; n < 4; ++n) {
                float ov[4]; const f32x4 gz8 = dec_fp8x4(gt_[n]);
#pragma unroll
                for (int r = 0; r < 4; ++r)
                    ov[r] = __builtin_amdgcn_fmed3f(o[n][r] * rinv * nw[n][r] * (gz8[r] * frcp(1.f + __builtin_amdgcn_exp2f(gz8[r] * (-0.125f * 1.44269504f)))), -448.f, 448.f);
                *(unsigned*)(op + 16 * n) = pk_fp8x4((f32x4){ov[0], ov[1], ov[2], ov[3]});
            }
        } else {
#pragma unroll
            for (int c = 0; c < 4; ++c)
#pragma unroll
                for (int i = 0; i < 4; ++i) dseg[c][i] *= dreg[c][i];
        }
    }
    if (!PB) {
        float* sl = C.hst + ((size_t)witem * 80) * 64 + lane;
#pragma unroll
        for (int mt = 0; mt < 4; ++mt)
#pragma unroll
            for (int n = 0; n < 4; ++n)
#pragma unroll
                for (int r = 0; r < 4; ++r) sl[((mt * 4 + n) * 4 + r) * 64] = S[mt][n][r];
#pragma unroll
        for (int c = 0; c < 4; ++c)
#pragma unroll
            for (int i = 0; i < 4; ++i) sl[(64 + c * 4 + i) * 64] = dseg[c][i];
        asm volatile("s_waitcnt vmcnt(0)" ::: "memory");
        __syncthreads();
        if (lane == 0 && wv == 0) {
            __builtin_amdgcn_fence(__ATOMIC_RELEASE, "agent");
            asm volatile("s_waitcnt vmcnt(0)" ::: "memory");
            __hip_atomic_fetch_add(C.ctl + CW_HA + (l * 32 + bh) * 64, 1u, __ATOMIC_RELAXED, __HIP_MEMORY_SCOPE_AGENT);
        }
    }
}

__device__ __forceinline__ void mixer_phase(const Ctx& C, LAS unsigned char* lds, int l, int tid, int wave, int lane) {
    constexpr int NH = 32 * NSEG / NWAVES;
    constexpr int N_MEM = NB * 4 * 8, N_SWA = NB * 32 * 2;
    unsigned* head = C.ctl + CW_QUEUE + l * 64;
    volatile LAS int* slot = (volatile LAS int*)(lds + LDSCTL_OFF + 256);
    for (;;) {
        __syncthreads();
        if (tid == 0) slot[0] = (int)__hip_atomic_fetch_add(head, 1u, __ATOMIC_RELAXED, __HIP_MEMORY_SCOPE_AGENT);
        __syncthreads();
        int it = __builtin_amdgcn_readfirstlane(slot[0]);
        if (it >= 2 * NH + N_MEM + N_SWA) break;
        int lane_i = lane; asm volatile("" : "+v"(lane_i));
        if (it < NH) { hgrn_item<false>(C, lds, wave, l, it * NWAVES + wave, lane_i); continue; } it -= NH;
        if (it < N_SWA / 2) { attn_item<true>(C, lds, l, it, wave * 64 + lane_i, wave, lane_i); continue; } it -= N_SWA / 2;
        if (it < NH) { hgrn_item<true>(C, lds, wave, l, it * NWAVES + wave, lane_i); continue; } it -= NH;
        if (it < N_SWA / 2) { attn_item<true>(C, lds, l, it + N_SWA / 2, wave * 64 + lane_i, wave, lane_i); continue; } it -= N_SWA / 2;
        attn_item<false>(C, lds, l, it, wave * 64 + lane_i, wave, lane_i);
    }
}

__device__ __forceinline__ float reduce_scatter16(const float (&p)[16], int lane) {
    const bool h5 = (lane & 32) != 0, h4 = (lane & 16) != 0, h3 = (lane & 8) != 0, h2 = (lane & 4) != 0;
    float q8[8], q4[4], q2[2];
#pragma unroll
    for (int i = 0; i < 8; ++i) { const float snd = h5 ? p[i] : p[i + 8], kp = h5 ? p[i + 8] : p[i]; q8[i] = kp + __shfl_xor(snd, 32); }
#pragma unroll
    for (int i = 0; i < 4; ++i) { const float snd = h4 ? q8[i] : q8[i + 4], kp = h4 ? q8[i + 4] : q8[i]; q4[i] = kp + __shfl_xor(snd, 16); }
#pragma unroll
    for (int i = 0; i < 2; ++i) { const float snd = h3 ? q4[i] : q4[i + 2], kp = h3 ? q4[i + 2] : q4[i]; q2[i] = kp + DPPF(snd, 0x128); }
    float q1; { const float snd = h2 ? q2[0] : q2[1], kp = h2 ? q2[1] : q2[0]; q1 = kp + __shfl_xor(snd, 4); }
    q1 += DPPF(q1, 0x4E); q1 += DPPF(q1, 0xB1);
    return q1;
}
__device__ __forceinline__ float reduce_scatter4(const float (&p)[4]) {
    const u32x2 r0 = __builtin_amdgcn_permlane32_swap(__float_as_uint(p[0]), __float_as_uint(p[2]), false, false), r1 = __builtin_amdgcn_permlane32_swap(__float_as_uint(p[1]), __float_as_uint(p[3]), false, false);
    const float a = __uint_as_float(r0.x) + __uint_as_float(r0.y), b = __uint_as_float(r1.x) + __uint_as_float(r1.y);
    const u32x2 r2 = __builtin_amdgcn_permlane16_swap(__float_as_uint(a), __float_as_uint(b), false, false);
    float q1 = __uint_as_float(r2.x) + __uint_as_float(r2.y);
    q1 += DPPF(q1, 0xB1); q1 += DPPF(q1, 0x4E); q1 += DPPF(q1, 0x141); q1 += DPPF(q1, 0x140);
    return q1;
}
__device__ __forceinline__ int rs4_index() {
    const u32x2 r0 = __builtin_amdgcn_permlane32_swap(0u, 2u, false, false), r1 = __builtin_amdgcn_permlane32_swap(1u, 3u, false, false);
    const u32x2 r2 = __builtin_amdgcn_permlane16_swap(r0.x, r1.x, false, false);
    return (int)r2.x;
}
__device__ __forceinline__ float reduce_scatter8(const float (&p)[8], int lane) {
    const bool h5 = (lane & 32) != 0, h4 = (lane & 16) != 0, h3 = (lane & 8) != 0;
    float q4[4], q2[2];
#pragma unroll
    for (int i = 0; i < 4; ++i) { const float snd = h5 ? p[i] : p[i + 4], kp = h5 ? p[i + 4] : p[i]; q4[i] = kp + __shfl_xor(snd, 32); }
#pragma unroll
    for (int i = 0; i < 2; ++i) { const float snd = h4 ? q4[i] : q4[i + 2], kp = h4 ? q4[i + 2] : q4[i]; q2[i] = kp + __shfl_xor(snd, 16); }
    float q1; { const float snd = h3 ? q2[0] : q2[1], kp = h3 ? q2[1] : q2[0]; q1 = kp + DPPF(snd, 0x128); }
    q1 += DPPF(q1, 0xB1); q1 += DPPF(q1, 0x4E); q1 += DPPF(q1, 0x141);
    return q1;
}
__device__ __forceinline__ void route_rows16(const LAS float* lg, const float (&rb)[16], LAS unsigned* dec16, int lane) {
    const int r = lane & 15;
    float sel[16], sc[16];
#pragma unroll
    for (int q = 0; q < 4; ++q) { const f32x4 v = *(const LAS f32x4*)(lg + r * 16 + 4 * q);
        sc[4 * q] = frcp(1.f + __expf(-v.x)); sc[4 * q + 1] = frcp(1.f + __expf(-v.y)); sc[4 * q + 2] = frcp(1.f + __expf(-v.z)); sc[4 * q + 3] = frcp(1.f + __expf(-v.w)); }
#pragma unroll
    for (int e = 0; e < 16; ++e) sel[e] = sc[e] + rb[e];
    float bestv = -INFINITY, w1 = 0.f, w2 = 0.f; int e1 = 0, e2 = 1;
#pragma unroll
    for (int gi = 0; gi < 4; ++gi) {
        float m1 = sel[4 * gi], s1 = sc[4 * gi]; int i1 = 0;
#pragma unroll
        for (int i = 1; i < 4; ++i) if (sel[4 * gi + i] > m1) { m1 = sel[4 * gi + i]; s1 = sc[4 * gi + i]; i1 = i; }
        float m2 = -INFINITY, s2v = 0.f; int i2 = 0;
#pragma unroll
        for (int i = 0; i < 4; ++i) if (i != i1 && sel[4 * gi + i] > m2) { m2 = sel[4 * gi + i]; s2v = sc[4 * gi + i]; i2 = i; }
        const float gs = m1 + m2;
        if (gs > bestv) { bestv = gs; e1 = 4 * gi + i1; e2 = 4 * gi + i2; w1 = s1; w2 = s2v; }
    }
    const float wn = 1.f / (w1 + w2);
    if (lane < 16) { u32x4 d; d.x = (unsigned)e1; d.y = (unsigned)e2; d.z = __float_as_uint(w1 * wn); d.w = __float_as_uint(w2 * wn); *(LAS u32x4*)(dec16 + r * 4) = d; }
}
__device__ __forceinline__ void ln_row(const unsigned (&h)[4], const u32x2 (&x)[4], const f32x4 (&gv)[4], const f32x4 (&bv)[4], f32x4 (&v)[4]) {
    float s = 0.f;
#pragma unroll
    for (int j = 0; j < 4; ++j) { v[j] = join_fp8(x[j].x, x[j].y) * ALPHA + dec_fp8x4(h[j]) * 0.015625f;
        s += (v[j].x + v[j].y) + (v[j].z + v[j].w); }
    const float mean = wave_sum(s) * (1.f / DM); float s2 = 0.f;
#pragma unroll
    for (int j = 0; j < 4; ++j) { v[j] = v[j] - mean; s2 += (v[j].x * v[j].x + v[j].y * v[j].y) + (v[j].z * v[j].z + v[j].w * v[j].w); }
    const float rstd = __builtin_amdgcn_rsqf(wave_sum(s2) * (1.f / DM) + LN_EPS);
#pragma unroll
    for (int j = 0; j < 4; ++j) v[j] = v[j] * rstd * gv[j] + bv[j];
}
__device__ __forceinline__ void p4_ln_route(const Ctx& C, LAS unsigned char* lds, int l, int tid, int wave, int lane) {
    LAS float* wr = (LAS float*)lds;
    constexpr int WRP = DM + 4;
    LAS unsigned* dec = (LAS unsigned*)(lds + 66048);
    LAS unsigned* posb = (LAS unsigned*)(lds + 66048 + 2048);
    LAS float* lgw = (LAS float*)(lds + 66048 + 4096) + wave * 256;
    for (int i = tid; i < DM * NE; i += NTHR) { const int d = i >> 4, e = i & 15; wr[e * WRP + d] = C.w_router[i]; }
    f32x4 gv[4], bv[4];
#pragma unroll
    for (int j = 0; j < 4; ++j) { gv[j] = *((const f32x4*)(C.ln1g + l * DM) + lane + 64 * j); bv[j] = *((const f32x4*)(C.ln1b + l * DM) + lane + 64 * j); }
    unsigned* cntl = C.ctl + CW_CNT + (l + C.rep * DEPTH) * 16 * 64;
    __syncthreads();
    for (int blk = C.vcu; blk < NTOK / 128; blk += C.G) {
        const size_t rowb = (size_t)blk * 128 + wave * 16;
        const unsigned char* hp8 = (const unsigned char*)C.hpre; unsigned char* xlo = (unsigned char*)C.xb;
#define P4_LOAD4(H, X, R0) do { _Pragma("unroll") for (int r_ = 0; r_ < 4; ++r_) { const size_t rr_ = (R0) + r_; _Pragma("unroll") for (int j = 0; j < 4; ++j) { \
            H[r_][j] = ((const unsigned*)(hp8 + rr_ * DM) + lane)[64 * j]; X[r_][j].x = ((const unsigned*)(C.xb8 + rr_ * DM) + lane)[64 * j]; X[r_][j].y = ((const unsigned*)(xlo + rr_ * DM) + lane)[64 * j]; } } } while (0)
        const int rs4 = rs4_index();
        unsigned hA[4][4]; u32x2 xA[4][4];
        P4_LOAD4(hA, xA, rowb);
#pragma unroll 1
        for (int st = 0; st < 4; ++st) {
            const size_t row = rowb + 4 * st;
            unsigned hN[4][4]; u32x2 xN[4][4];
            if (st < 3) P4_LOAD4(hN, xN, row + 4);
            f32x4 v[4][4];
#pragma unroll
            for (int r = 0; r < 4; ++r) {
                ln_row(hA[r], xA[r], gv, bv, v[r]);
                unsigned* xl = (unsigned*)(xlo + (row + r) * DM) + lane; unsigned* x8 = (unsigned*)(C.xb8 + (row + r) * DM) + lane;
#pragma unroll
                for (int j = 0; j < 4; ++j) { unsigned hi, lo; split_fp8(v[r][j], hi, lo); x8[64 * j] = hi; xl[64 * j] = lo; }
            }
#pragma unroll
            for (int eh = 0; eh < 4; ++eh) {
                float p[4][4];
#pragma unroll
                for (int e8 = 0; e8 < 4; ++e8) {
                    f32x4 w[4];
#pragma unroll
                    for (int j = 0; j < 4; ++j) w[j] = *((const LAS f32x4*)(wr + (4 * eh + e8) * WRP) + lane + 64 * j);
#pragma unroll
                    for (int r = 0; r < 4; ++r) { f32x2 a = {0.f, 0.f};
#pragma unroll
                        for (int j = 0; j < 4; ++j) { a = __builtin_elementwise_fma((f32x2){v[r][j].x, v[r][j].y}, (f32x2){w[j].x, w[j].y}, a); a = __builtin_elementwise_fma((f32x2){v[r][j].z, v[r][j].w}, (f32x2){w[j].z, w[j].w}, a); }
                        p[r][e8] = a.x + a.y; }
                }
#pragma unroll
                for (int r = 0; r < 4; ++r) { const float q = reduce_scatter4(p[r]);
                    if ((lane & 15) == 0) lgw[(4 * st + r) * 16 + 4 * eh + rs4] = q; }
                __builtin_amdgcn_sched_barrier(0);
            }
#pragma unroll
            for (int r = 0; r < 4; ++r)
#pragma unroll
                for (int j = 0; j < 4; ++j) { hA[r][j] = hN[r][j]; xA[r][j] = xN[r][j]; }
        }
#undef P4_LOAD4
        float rb[16];
#pragma unroll
        for (int e = 0; e < 16; ++e) rb[e] = C.rbias[e];
        route_rows16(lgw, rb, dec + wave * 16 * 4, lane);
        __syncthreads();
        if (wave == 0) {
            unsigned ea[4], rk[4]; unsigned tot = 0;
#pragma unroll
            for (int i = 0; i < 4; ++i) { const int a = lane + 64 * i; ea[i] = dec[(a >> 1) * 4 + (a & 1)]; rk[i] = 0; }
#pragma unroll
            for (int e = 0; e < 16; ++e) {
                unsigned run = 0;
#pragma unroll
                for (int i = 0; i < 4; ++i) { const unsigned long long m = __ballot(ea[i] == (unsigned)e);
                    const unsigned below = __builtin_amdgcn_mbcnt_hi((unsigned)(m >> 32), __builtin_amdgcn_mbcnt_lo((unsigned)m, 0u));
                    if (ea[i] == (unsigned)e) rk[i] = run + below;
                    run += (unsigned)__popcll(m); }
                if (lane == e) tot = run;
            }
            unsigned base = 0;
            if (lane < 16) base = tot ? atomicAdd(cntl + 64 * lane, tot) : 0u;
#pragma unroll
            for (int i = 0; i < 4; ++i) { const unsigned bs = __shfl(base, (int)ea[i]); const unsigned pos = bs + rk[i]; const int a = lane + 64 * i;
                posb[a] = pos; C.list[(size_t)ea[i] * LCAP + pos] = blk * 128 + (a >> 1); }
        }
        __syncthreads();
        if (tid < 128) { u32x4 rec; rec.x = (dec[tid * 4] << 16) | posb[tid * 2]; rec.y = (dec[tid * 4 + 1] << 16) | posb[tid * 2 + 1]; rec.z = dec[tid * 4 + 2]; rec.w = dec[tid * 4 + 3];
            C.tokrec[(size_t)blk * 128 + tid] = rec; }
        __syncthreads();
    }
}

__device__ __forceinline__ void moe_prefix(const Ctx& C, LAS int* tb, int l, int tid) {
    if (tid == 0) {
        unsigned* cntl = C.ctl + CW_CNT + l * 16 * 64; int acc = 0;
        for (int e = 0; e < 16; ++e) { const int c = (int)__hip_atomic_load(cntl + 64 * e, __ATOMIC_RELAXED, __HIP_MEMORY_SCOPE_AGENT); tb[e] = acc; tb[17 + e] = c; acc += (c + 255) >> 8; }
        tb[16] = acc;
    }
    __syncthreads();
}

__device__ __forceinline__ void p7_combine(const Ctx& C, LAS unsigned char* lds, int l, int tid, int wave, int lane) {
    LAS int* tb = (LAS int*)lds;
    moe_prefix(C, tb, l, tid);
    f32x4 gv[4], bv[4];
#pragma unroll
    for (int j = 0; j < 4; ++j) { gv[j] = *((const f32x4*)(C.ln2g + l * DM) + lane + 64 * j); bv[j] = *((const f32x4*)(C.ln2b + l * DM) + lane + 64 * j); }
    const bool lastl = (l == DEPTH - 1);
    for (int r0 = (C.vcu * NWAVES + wave) * 16; r0 < NTOK; r0 += C.G * NWAVES * 16) {
        u32x4 rec = C.tokrec[r0 + (lane & 15)];
        const unsigned sa_l = (unsigned)tb[rec.x >> 16] * 256u + (rec.x & 0xffffu), sb_l = (unsigned)tb[rec.y >> 16] * 256u + (rec.y & 0xffffu);
#pragma unroll 1
        for (int bq = 0; bq < 2; ++bq) {
            u32x2 xv[8][4]; unsigned av[8][4], bw[8][4]; float wa[8], wb[8];
#pragma unroll
            for (int k = 0; k < 8; ++k) { const int idx = bq * 8 + k;
                const size_t sa = (size_t)__builtin_amdgcn_readlane(sa_l, idx), sb = (size_t)__builtin_amdgcn_readlane(sb_l, idx);
                wa[k] = __uint_as_float(__builtin_amdgcn_readlane(rec.z, idx)) * 0.0625f; wb[k] = __uint_as_float(__builtin_amdgcn_readlane(rec.w, idx)) * 0.0625f;
                const unsigned* xph = (const unsigned*)(C.xb8 + (size_t)(r0 + idx) * DM) + lane; const unsigned* xpl = (const unsigned*)((const unsigned char*)C.xb + (size_t)(r0 + idx) * DM) + lane; const unsigned* ya = (const unsigned*)((const unsigned char*)C.ys + sa * DM) + lane; const unsigned* yb = (const unsigned*)((const unsigned char*)C.ys + sb * DM) + lane;
#pragma unroll
                for (int j = 0; j < 4; ++j) { xv[k][j].x = xph[64 * j]; xv[k][j].y = xpl[64 * j]; av[k][j] = ya[64 * j]; bw[k][j] = yb[64 * j]; } }
#pragma unroll
            for (int k = 0; k < 8; ++k) { const int row = r0 + bq * 8 + k;
                f32x4 v[4]; float s = 0.f;
#pragma unroll
                for (int j = 0; j < 4; ++j) { const u32x2 x2 = xv[k][j];
                    const f32x2 al = __builtin_amdgcn_cvt_pk_f32_fp8((int)av[k][j], false), ah = __builtin_amdgcn_cvt_pk_f32_fp8((int)av[k][j], true);
                    const f32x2 bl = __builtin_amdgcn_cvt_pk_f32_fp8((int)bw[k][j], false), bh = __builtin_amdgcn_cvt_pk_f32_fp8((int)bw[k][j], true);
                    const f32x4 xr = join_fp8(x2.x, x2.y) * ALPHA;
                    v[j].x = xr.x + (al.x * wa[k] + bl.x * wb[k]); v[j].y = xr.y + (al.y * wa[k] + bl.y * wb[k]);
                    v[j].z = xr.z + (ah.x * wa[k] + bh.x * wb[k]); v[j].w = xr.w + (ah.y * wa[k] + bh.y * wb[k]);
                    s += (v[j].x + v[j].y) + (v[j].z + v[j].w); }
                const float mean = wave_sum(s) * (1.f / DM); float s2 = 0.f;
#pragma unroll
                for (int j = 0; j < 4; ++j) { v[j] = v[j] - mean; s2 += (v[j].x * v[j].x + v[j].y * v[j].y) + (v[j].z * v[j].z + v[j].w * v[j].w); }
                const float rstd = __builtin_amdgcn_rsqf(wave_sum(s2) * (1.f / DM) + LN_EPS);
                if (lastl) { f32x4* xo = (f32x4*)(C.xcur + (size_t)row * DM) + lane;
#pragma unroll
                    for (int j = 0; j < 4; ++j) xo[64 * j] = v[j] * rstd * gv[j] + bv[j]; }
                else { unsigned* xlo = (unsigned*)((unsigned char*)C.xb + (size_t)row * DM) + lane; unsigned* x8o = (unsigned*)(C.xb8 + (size_t)row * DM) + lane;
#pragma unroll
                    for (int j = 0; j < 4; ++j) { const f32x4 y = v[j] * rstd * gv[j] + bv[j]; unsigned hi, lo; split_fp8(y, hi, lo); x8o[64 * j] = hi; xlo[64 * j] = lo; } }
            }
        }
    }
}

template <class T> __device__ __forceinline__ T* as_g(T* p) { return (T*)(GAS T*)p; }
typedef const __attribute__((address_space(4))) Args* KArgs;
__device__ __forceinline__ Ctx make_ctx(KArgs ap) {
    asm volatile("" : "+s"(ap));
    Ctx C;
    C.x = as_g(ap->in[0]); C.mem = as_g(ap->in[1]); C.w_in = as_g(ap->in[2]); C.b_in = as_g(ap->in[3]); C.w_mem_kv = as_g(ap->in[4]); C.sinks = as_g(ap->in[5]); C.rel_bias = as_g(ap->in[6]); C.lb_logits = as_g(ap->in[7]);
    C.hnorm = as_g(ap->in[8]); C.w_out = as_g(ap->in[9]); C.ln1g = as_g(ap->in[10]); C.ln1b = as_g(ap->in[11]); C.w_router = as_g(ap->in[12]); C.rbias = as_g(ap->in[13]); C.w_gate = as_g(ap->in[14]); C.w_up = as_g(ap->in[15]);
    C.w_down = as_g(ap->in[16]); C.ln2g = as_g(ap->in[17]); C.ln2b = as_g(ap->in[18]);
    unsigned char* ws = as_g(ap->ws);
    C.xcur = as_g(ap->out); C.ws = ws; C.ctl = (unsigned*)(ws + WS_CTL);
    C.Win = (bf16*)(ws + WS_WIN); C.Wout = (bf16*)(ws + WS_WOUT); C.Wmem = (bf16*)(ws + WS_WMEM); C.W1 = (bf16*)(ws + WS_W1); C.W2 = (bf16*)(ws + WS_W2);
    C.xb = (bf16*)(ws + WS_XB); C.proj = (bf16*)(ws + WS_BIG); C.hpre = (bf16*)(ws + WS_BIG); C.ys = (bf16*)(ws + WS_BIG);
    C.mix = (bf16*)(ws + WS_MIX); C.hmid = (bf16*)(ws + WS_MIX); C.memkv = (bf16*)(ws + WS_MEMKV); C.memb = (bf16*)(ws + WS_MEMB);
    C.biastab = (float*)(ws + WS_TAB); C.lbtab = (float*)(ws + WS_TAB + 4096); C.list = (int*)(ws + WS_LIST); C.tokrec = (u32x4*)(ws + WS_TOKREC); C.hst = (float*)(ws + WS_HST); C.xb8 = ws + WS_XB8;
    C.rep = ap->rep; C.G = gridDim.x; { const int bx = blockIdx.x; C.vcu = (C.G % 8 == 0) ? (bx % 8) * (C.G / 8) + bx / 8 : bx; }
    return C;
}
constexpr int PH_PER_LAYER = 7, N_PHASES = 1 + DEPTH * PH_PER_LAYER;
__global__ void __launch_bounds__(NTHR, 2) trunk_fwd(Args args) {
    extern __shared__ __attribute__((aligned(16))) unsigned char lds_raw[];
    LAS unsigned char* lds = (LAS unsigned char*)lds_raw;
    volatile LAS unsigned* MISC = (volatile LAS unsigned*)(lds + MISC_OFF);
    const int tid0 = threadIdx.x; const int wave0 = __builtin_amdgcn_readfirstlane(tid0 >> 6);
    for (int u = tid0; u < (LDS_BYTES - LDSCTL_OFF) / 4; u += NTHR) ((LAS unsigned*)(lds + LDSCTL_OFF))[u] = 0u;
    __syncthreads();
    KArgs ap = (KArgs)__builtin_amdgcn_kernarg_segment_ptr();
    XcdBarrier bar; bar.bar = (unsigned*)(as_g(args.ws) + WS_CTL) + CW_BAR; bar.x = 0; bar.st = nullptr;
    if (args.use_bar) bar = xcd_barrier_post((unsigned*)(as_g(args.ws) + WS_CTL) + CW_BAR, MISC + 8);
    const int lo = args.ph_lo, hi = args.ph_hi;
#define IN(k) (lo <= (k) && (k) < hi)
#define PHASE_IDS unsigned ones_ = ~0u; asm volatile("" : "+s"(ones_)); int lane = (int)__builtin_amdgcn_mbcnt_hi(ones_, __builtin_amdgcn_mbcnt_lo(ones_, 0u)); asm volatile("" : "+v"(lane)); int wave = wave0; asm volatile("" : "+s"(wave)); const int tid = wave * 64 + lane; (void)tid
#define SEAM(k) do { if (IN(k) && IN((k) + 1)) { XcdBarrier b2_ = bar; unsigned z_ = 0u; asm volatile("" : "+s"(z_)); b2_.bar = bar.bar + z_; xcd_barrier(b2_); } } while (0)

    if (IN(0)) { PHASE_IDS; const Ctx C = make_ctx(ap); p0_prologue(C, lds, wave, lane); }
    SEAM(0);
#pragma unroll 1
    for (int l = 0; l < DEPTH; ++l) {
        const int pb = 1 + l * PH_PER_LAYER;
        if (IN(pb + 0)) {
            PHASE_IDS; const Ctx C = make_ctx(ap);
            DenseSched S; S.A0 = (const char*)C.xb8; S.B0 = (const char*)C.Win + (size_t)l * INW * DM; S.nM0 = NTOK / 256; S.nN0 = INW / 256; S.K0 = DM  ;
            S.A1 = (const char*)C.memb; S.B1 = (const char*)C.Wmem; S.nM1 = (l == 0) ? (NB * MEMLEN) / 256 : 0; S.nN1 = 2048 / 256; S.G = C.G; S.c = (int)blockIdx.x;
            EpiProj E{(unsigned char*)C.proj, C.b_in + l * INW, (unsigned char*)C.memkv};
            pg8::gemm_phase<EpiProj, DenseSched, true>(lds, tid, DM, S, E);
        }
        SEAM(pb + 0);
        if (IN(pb + 1)) { PHASE_IDS; const Ctx C = make_ctx(ap); mixer_phase(C, lds, l, tid, wave, lane); }
        SEAM(pb + 1);
        if (IN(pb + 2)) {
            PHASE_IDS; const Ctx C = make_ctx(ap);
            DenseSched S; S.A0 = (const char*)C.mix; S.B0 = (const char*)C.Wout + (size_t)l * DM * MIXW; S.nM0 = NTOK / 256; S.nN0 = DM / 256; S.K0 = MIXW  ;
            S.A1 = nullptr; S.B1 = nullptr; S.nM1 = 0; S.nN1 = 0; S.G = C.G; S.c = (int)blockIdx.x;
            EpiOut E{(unsigned char*)C.hpre};
            pg8::gemm_phase<EpiOut, DenseSched, true>(lds, tid, MIXW, S, E);
        }
        SEAM(pb + 2);
        if (IN(pb + 3)) { PHASE_IDS; const Ctx C = make_ctx(ap); p4_ln_route(C, lds, l, tid, wave, lane); }
        SEAM(pb + 3);
        if (IN(pb + 4)) {
            PHASE_IDS; const Ctx C = make_ctx(ap);
            LAS int* tb = (LAS int*)(lds + LDSCTL_OFF + 64);
            moe_prefix(C, tb, l, tid);
            const int U = tb[16] * 4;
            MoeSched<true> S; S.A = (const char*)C.xb8; S.Bl = (const char*)C.W1 + (size_t)l * NE * 1024 * DM; S.K = DM  ; S.bstride = (size_t)1024 * DM; S.list = C.list; S.tb = tb;
            S.mode = 0; S.g0 = C.vcu; S.g1 = C.G; S.gU = U < 1024 ? U : 1024;
            EpiG1 E{(unsigned char*)C.hmid};
            pg8::gemm_phase<EpiG1, MoeSched<true>, true>(lds, tid, DM, S, E);
        }
        SEAM(pb + 4);
        if (IN(pb + 5)) {
            PHASE_IDS; const Ctx C = make_ctx(ap);
            LAS int* tb = (LAS int*)(lds + LDSCTL_OFF + 64);
            moe_prefix(C, tb, l, tid);
            const int U = tb[16] * 4, Etail = U > 1024 ? U - 1024 : 0;
            if (C.vcu < Etail) {
                MoeSched<true> S; S.A = (const char*)C.xb8; S.Bl = (const char*)C.W1 + (size_t)l * NE * 1024 * DM; S.K = DM  ; S.bstride = (size_t)1024 * DM; S.list = C.list; S.tb = tb;
                S.mode = 0; S.g0 = 1024 + C.vcu; S.g1 = 1 << 20; S.gU = 1024 + C.vcu + 1;
                EpiG1 E{(unsigned char*)C.hmid};
                pg8::gemm_phase<EpiG1, MoeSched<true>, true>(lds, tid, DM, S, E);
                asm volatile("s_waitcnt vmcnt(0)" ::: "memory");
                __syncthreads();
                if (tid == 0) {
                    unsigned* cnt = C.ctl + CW_TILE + (l * 16 + (C.vcu >> 2)) * 64; unsigned sp = 0;
                    __builtin_amdgcn_fence(__ATOMIC_RELEASE, "agent");
                    asm volatile("s_waitcnt vmcnt(0)" ::: "memory");
                    __hip_atomic_fetch_add(cnt, 1u, __ATOMIC_RELAXED, __HIP_MEMORY_SCOPE_AGENT);
                    while (__hip_atomic_load(cnt, __ATOMIC_RELAXED, __HIP_MEMORY_SCOPE_AGENT) < 4u) { __builtin_amdgcn_s_sleep(2); if (++sp > (1u << 24)) break; }
                    __builtin_amdgcn_fence(__ATOMIC_ACQUIRE, "agent");
                    asm volatile("s_waitcnt vmcnt(0)" ::: "memory");
                }
                __syncthreads();
            }
            MoeSched<false> S; S.A = (const char*)C.hmid; S.Bl = (const char*)C.W2 + (size_t)l * NE * DM * DE; S.K = DE  ; S.bstride = (size_t)DM * DE; S.list = C.list; S.tb = tb;
            S.mode = 1; S.g0 = C.vcu; S.g1 = Etail; S.gU = U < 1024 ? U : 1024;
            EpiG2 E{(unsigned char*)C.ys};
            pg8::gemm_phase<EpiG2, MoeSched<false>, true>(lds, tid, DE, S, E);
        }
        SEAM(pb + 5);
        if (IN(pb + 6)) { PHASE_IDS; const Ctx C = make_ctx(ap); p7_combine(C, lds, l, tid, wave, lane); }
        SEAM(pb + 6);
    }
#undef IN
#undef SEAM
}

#ifndef ONE_LAUNCH
#define ONE_LAUNCH 1
#endif
extern "C" void kernel_launch(void* const* d_in, const int* in_sizes, int n_in, void* d_out, int out_size, void* d_ws, size_t ws_size, hipStream_t stream) {
    static int grid = 0;
    if (grid == 0) {
        if (n_in != 19 || in_sizes[0] != NTOK * DM || out_size != NTOK * DM || ws_size < WS_END) {
            fprintf(stderr, "kernel_launch: unexpected shapes (n_in %d, in0 %d, out %d, ws %zu < %zu); nothing launched\n", n_in, n_in > 0 ? in_sizes[0] : -1, out_size, ws_size, (size_t)WS_END); grid = -1; return; }
        int dev = 0, cus = 0, per_cu = 0;
        if (hipGetDevice(&dev) != hipSuccess || hipDeviceGetAttribute(&cus, hipDeviceAttributeMultiprocessorCount, dev) != hipSuccess) { grid = -1; return; }
        if (hipFuncSetAttribute((const void*)trunk_fwd, hipFuncAttributeMaxDynamicSharedMemorySize, LDS_BYTES) != hipSuccess) { fprintf(stderr, "kernel_launch: hipFuncSetAttribute failed\n"); grid = -1; return; }
        if (hipOccupancyMaxActiveBlocksPerMultiprocessor(&per_cu, (const void*)trunk_fwd, NTHR, LDS_BYTES) != hipSuccess || per_cu < 1) { fprintf(stderr, "kernel_launch: occupancy query says %d\n", per_cu); }
        (void)hipGetLastError();
        grid = cus;
        fprintf(stderr, "kernel_launch: grid %d, occupancy/CU %d, ws %zu\n", grid, per_cu, ws_size);
    }
    if (grid < 0) return;
    (void)hipMemsetAsync((char*)d_ws + WS_CTL, 0, CTL_ZERO_BYTES, stream);
    Args a{};
    for (int i = 0; i < 19; ++i) a.in[i] = (const float*)d_in[i];
    a.out = (float*)d_out; a.ws = (unsigned char*)d_ws;
#if ONE_LAUNCH
    a.ph_lo = 0; a.ph_hi = N_PHASES; a.use_bar = 1;
    void* kargs[] = {&a};
    hipError_t e = hipLaunchCooperativeKernel((const void*)trunk_fwd, dim3(grid), dim3(NTHR), kargs, LDS_BYTES, stream);
    if (e != hipSuccess) fprintf(stderr, "kernel_launch: cooperative launch failed: %s\n", hipGetErrorString(e));
#else
    for (int p = 0; p < N_PHASES; ++p) {
        a.ph_lo = p; a.ph_hi = p + 1; a.use_bar = 0;
        hipLaunchKernelGGL(trunk_fwd, dim3(grid), dim3(NTHR), LDS_BYTES, stream, a);
    }
#endif
}
```

```cpp
#include <hip/hip_runtime.h>
#include <cstdio>
#include <cstdint>

#define LAS __attribute__((address_space(3)))
#define GAS __attribute__((address_space(1)))
typedef unsigned short bf16;
typedef short bf16x8 __attribute__((ext_vector_type(8)));
typedef short s16x4 __attribute__((ext_vector_type(4)));
typedef float f32x4 __attribute__((ext_vector_type(4)));
typedef float f32x2 __attribute__((ext_vector_type(2)));
typedef unsigned u32x4 __attribute__((ext_vector_type(4)));
typedef unsigned u32x2 __attribute__((ext_vector_type(2)));
typedef int i32x4 __attribute__((ext_vector_type(4)));
typedef int i32x8 __attribute__((ext_vector_type(8)));
typedef __bf16 bf16x2_t __attribute__((ext_vector_type(2)));

constexpr int NB = 8, SEQ = 4096, DM = 1024, NTOK = NB * SEQ, DEPTH = 4;
constexpr int INW = 2048, MIXW = 1024, NE = 16, DE = 512, MEMLEN = 256;
constexpr int C_SQ = 0, C_SK = 512, C_SV = 640, C_HQ = 768, C_HF = 1024, C_HI = 1280, C_HG = 1536, C_MQ = 1792;
constexpr float ALPHA = 1.6817928305074290f;
constexpr float LN_EPS = 1e-5f, RMS_EPS = 1e-6f;
constexpr int NSEG = 32, CPS = (SEQ / 16) / NSEG;
constexpr int LCAP = 32768;
constexpr int MAXTILES = NTOK * 2 / 256 + NE;
constexpr int NWAVES = 8, NTHR = 512;

constexpr size_t MiB = 1u << 20;
constexpr size_t WS_CTL = 0, CTL_ZERO_BYTES = 256 * 1024;
constexpr size_t WS_TAB = 1 * MiB;
constexpr size_t WS_WIN = 2 * MiB;
constexpr size_t WS_WOUT = 18 * MiB;
constexpr size_t WS_WMEM = 26 * MiB;
constexpr size_t WS_W1 = 30 * MiB;
constexpr size_t WS_XB8 = 94 * MiB;
constexpr size_t WS_W2 = 158 * MiB;
constexpr size_t WS_XB = 222 * MiB;
constexpr size_t WS_BIG = 286 * MiB;
constexpr size_t WS_MIX = 430 * MiB;
constexpr size_t WS_MEMKV = 502 * MiB;
constexpr size_t WS_MEMB = 510 * MiB;
constexpr size_t WS_LIST = 514 * MiB;
constexpr size_t WS_TOKREC = 516 * MiB;
constexpr size_t WS_HST = 517 * MiB;
constexpr size_t WS_END = 538 * MiB;
constexpr int CW_BAR = 4096;
constexpr int CW_CNT = 16384;
constexpr int CW_QUEUE = 32768;
constexpr int CW_TILE = 57344;
constexpr int CW_MKV = 61440;
constexpr int CW_HA = 49152;

constexpr int RING_BYTES = 131072;
constexpr int LDSCTL_OFF = RING_BYTES, MISC_OFF = LDSCTL_OFF + 320;
constexpr int LDS_BYTES = 147456;

__device__ __forceinline__ unsigned pk2(float lo, float hi) { f32x2 v = {lo, hi}; bf16x2_t b = __builtin_convertvector(v, bf16x2_t); return __builtin_bit_cast(unsigned, b); }
__device__ __forceinline__ unsigned pk_fp8x4(f32x4 v) { int w = __builtin_amdgcn_cvt_pk_fp8_f32(v.x, v.y, 0, false); w = __builtin_amdgcn_cvt_pk_fp8_f32(v.z, v.w, w, true); return (unsigned)w; }
__device__ __forceinline__ f32x4 dec_fp8x4(unsigned w) { const f32x2 a = __builtin_amdgcn_cvt_pk_f32_fp8((int)w, false), b = __builtin_amdgcn_cvt_pk_f32_fp8((int)w, true); return (f32x4){a.x, a.y, b.x, b.y}; }
__device__ __forceinline__ void split_fp8(f32x4 y, unsigned& hi, unsigned& lo) { const f32x4 y8 = y * 8.f; hi = pk_fp8x4(y8); lo = pk_fp8x4((y8 - dec_fp8x4(hi)) * 16.f); }
__device__ __forceinline__ void split_fp8_pre8(f32x4 y8, unsigned& hi, unsigned& lo) { hi = pk_fp8x4(y8); lo = pk_fp8x4((y8 - dec_fp8x4(hi)) * 16.f); }
__device__ __forceinline__ f32x4 join_fp8(unsigned hi, unsigned lo) { return dec_fp8x4(hi) * 0.125f + dec_fp8x4(lo) * 0.0078125f; }
__device__ __forceinline__ u32x4 fp8x8_to_bf16x8(u32x2 w) { const f32x4 a = dec_fp8x4(w.x), b = dec_fp8x4(w.y); u32x4 o; o.x = pk2(a.x, a.y); o.y = pk2(a.z, a.w); o.z = pk2(b.x, b.y); o.w = pk2(b.z, b.w); return o; }
__device__ __forceinline__ float frcp(float x) { return __builtin_amdgcn_rcpf(x); }
__device__ __forceinline__ float bflo(unsigned w) { return __uint_as_float(w << 16); }
__device__ __forceinline__ float bfhi(unsigned w) { return __uint_as_float(w & 0xffff0000u); }
#define DPPF(v, ctrl) __int_as_float(__builtin_amdgcn_update_dpp(0, __float_as_int(v), (ctrl), 0xf, 0xf, true))
__device__ __forceinline__ float xsum16(float v) { const u32x2 r = __builtin_amdgcn_permlane16_swap(__float_as_uint(v), __float_as_uint(v), false, false); return __uint_as_float(r.x) + __uint_as_float(r.y); }
__device__ __forceinline__ float xsum32(float v) { const u32x2 r = __builtin_amdgcn_permlane32_swap(__float_as_uint(v), __float_as_uint(v), false, false); return __uint_as_float(r.x) + __uint_as_float(r.y); }
__device__ __forceinline__ float xmax16(float v) { const u32x2 r = __builtin_amdgcn_permlane16_swap(__float_as_uint(v), __float_as_uint(v), false, false); return fmaxf(__uint_as_float(r.x), __uint_as_float(r.y)); }
__device__ __forceinline__ float xmax32(float v) { const u32x2 r = __builtin_amdgcn_permlane32_swap(__float_as_uint(v), __float_as_uint(v), false, false); return fmaxf(__uint_as_float(r.x), __uint_as_float(r.y)); }
__device__ __forceinline__ float wave_sum(float v) {
    v += DPPF(v, 0xB1);
    v += DPPF(v, 0x4E);
    v += DPPF(v, 0x141);
    v += DPPF(v, 0x140);
    v = xsum16(v); v = xsum32(v);
    return v;
}
__device__ __forceinline__ s16x4 ld_tr(const LAS unsigned char* p) { return __builtin_amdgcn_ds_read_tr16_b64_v4i16((LAS s16x4*)p); }
__device__ __forceinline__ void row_scanmul16x4(float& a, float& b, float& c, float& d) {
    asm("s_nop 1\n\t"
        "v_mul_f32_dpp %0, %0, %0 row_shr:1 row_mask:0xf bank_mask:0xf\n\tv_mul_f32_dpp %1, %1, %1 row_shr:1 row_mask:0xf bank_mask:0xf\n\tv_mul_f32_dpp %2, %2, %2 row_shr:1 row_mask:0xf bank_mask:0xf\n\tv_mul_f32_dpp %3, %3, %3 row_shr:1 row_mask:0xf bank_mask:0xf\n\t"
        "v_mul_f32_dpp %0, %0, %0 row_shr:2 row_mask:0xf bank_mask:0xf\n\tv_mul_f32_dpp %1, %1, %1 row_shr:2 row_mask:0xf bank_mask:0xf\n\tv_mul_f32_dpp %2, %2, %2 row_shr:2 row_mask:0xf bank_mask:0xf\n\tv_mul_f32_dpp %3, %3, %3 row_shr:2 row_mask:0xf bank_mask:0xf\n\t"
        "v_mul_f32_dpp %0, %0, %0 row_shr:4 row_mask:0xf bank_mask:0xf\n\tv_mul_f32_dpp %1, %1, %1 row_shr:4 row_mask:0xf bank_mask:0xf\n\tv_mul_f32_dpp %2, %2, %2 row_shr:4 row_mask:0xf bank_mask:0xf\n\tv_mul_f32_dpp %3, %3, %3 row_shr:4 row_mask:0xf bank_mask:0xf\n\t"
        "v_mul_f32_dpp %0, %0, %0 row_shr:8 row_mask:0xf bank_mask:0xf\n\tv_mul_f32_dpp %1, %1, %1 row_shr:8 row_mask:0xf bank_mask:0xf\n\tv_mul_f32_dpp %2, %2, %2 row_shr:8 row_mask:0xf bank_mask:0xf\n\tv_mul_f32_dpp %3, %3, %3 row_shr:8 row_mask:0xf bank_mask:0xf\n\t"
        "s_nop 1"
        : "+v"(a), "+v"(b), "+v"(c), "+v"(d));
}
__device__ __forceinline__ float row_scan16(float x) {
    x += __int_as_float(__builtin_amdgcn_update_dpp(0, __float_as_int(x), 0x111, 0xf, 0xf, true));
    x += __int_as_float(__builtin_amdgcn_update_dpp(0, __float_as_int(x), 0x112, 0xf, 0xf, true));
    x += __int_as_float(__builtin_amdgcn_update_dpp(0, __float_as_int(x), 0x114, 0xf, 0xf, true));
    x += __int_as_float(__builtin_amdgcn_update_dpp(0, __float_as_int(x), 0x118, 0xf, 0xf, true));
    return x;
}
__device__ __forceinline__ bf16x8 mk8(unsigned a, unsigned b, unsigned c, unsigned d) { u32x4 w = {a, b, c, d}; return __builtin_bit_cast(bf16x8, w); }
__device__ __forceinline__ s16x4 mk4(unsigned a, unsigned b) { u32x2 w = {a, b}; return __builtin_bit_cast(s16x4, w); }

namespace pg8 {
constexpr int BM = 256, BK = 64, HALF = 128, HTB = HALF * BK * 2, STAGE_BYTES = 8 * HTB, NXCD = 8, WGM = 8;
constexpr int NXT_SLOT_OFF = 131072 + 2048;
__host__ __device__ __forceinline__ int lds_byte(int r, int c) { const int st = (r >> 4) * 2 + (c >> 5), rr = r & 15, cc = c & 31, ob = rr * 64 + cc * 2; return st * 1024 + (ob ^ (((ob >> 9) & 1) << 5)); }
__host__ __device__ __forceinline__ void stage_rc(int b, int& R, int& C) { const int st = b / 1024, sb = b % 1024, swz = sb ^ (((sb >> 9) & 1) << 5); R = (st >> 1) * 16 + swz / 64; C = (st & 1) * 32 + (swz % 64) / 2; }
__host__ __device__ __forceinline__ int perm32(int rho) { const int n = rho >> 4, i = rho & 15; return 8 * (i >> 2) + 4 * n + (i & 3); }
__host__ __device__ __forceinline__ int perm256(int R) { const int bj = R >> 7, wc = (R >> 5) & 3, n = (R >> 4) & 1, i = R & 15; return 64 * wc + 16 * (i >> 2) + 8 * bj + 4 * n + (i & 3); }

struct Unit {
    const char* A;
    const char* B;
    unsigned a00, a01, a10, a11;
    int row0, col0, aux;
};
__device__ __forceinline__ void tile_order(int L, int nM, int nN, int& pm, int& pn) {
    const int nwg = nM * nN; int wgid = L;
    { const int q = nwg / NXCD, r = nwg % NXCD, xcd = wgid % NXCD, off = wgid / NXCD; wgid = (xcd < r ? xcd * (q + 1) : r * (q + 1) + (xcd - r) * q) + off; }
    const int nig = WGM * nN, gid = wgid / nig, fm = gid * WGM, gsz = (nM - fm) < WGM ? (nM - fm) : WGM;
    pm = fm + ((wgid % nig) % gsz); pn = (wgid % nig) / gsz;
}

template <class Epi, class Sched, bool ALIGN_EPI>
__device__ __forceinline__ void gemm_phase(LAS unsigned char* lds, const int tid, const int RB  , Sched& S, const Epi& E) {
    const int wid = __builtin_amdgcn_readfirstlane(tid >> 6), lane = tid & 63, wr = wid >> 2, wc = wid & 3, fr = lane & 15, fq = lane >> 4;
    const int nt = RB / 128;
    unsigned voffB[2], voffA[2] = {0u, 0u};
    {
        int Ra[2], Ca[2];
#pragma unroll
        for (int i = 0; i < 2; ++i) { int R, C; stage_rc(tid * 16 + i * 8192, R, C); const int Rb = Epi::PERM16 ? perm256(R) : (Epi::PERM ? ((R & ~31) + perm32(R & 31)) : R);
            Ra[i] = R; Ca[i] = C; voffB[i] = (unsigned)(Rb * RB + 2 * C); }
        S.lane_init(Ra[0], Ca[0], Ra[1], Ca[1]);
        if constexpr (!Sched::GATHER) { voffA[0] = (unsigned)(Ra[0] * RB + 2 * Ca[0]); voffA[1] = (unsigned)(Ra[1] * RB + 2 * Ca[1]); }
    }
    const size_t kstep = (size_t)(BK * 2);
    const size_t hstepB = (size_t)HALF * RB;
    const size_t hstepW = Epi::PERM16 ? (size_t)8 * RB : hstepB;
    const unsigned ldsw = (unsigned)wid * 1024u;
    const int aoff = lds_byte(wr * 64 + fr, fq * 8), boff = lds_byte(wc * 32 + fr, fq * 8);
#define PG8_SA(b, h) (((b) * 2 + (h)) * HTB)
#define PG8_SB(b, h) ((4 + (b) * 2 + (h)) * HTB)
#define PG8_STAGE_B(bufoff, gbase) do { _Pragma("unroll") for (int _i = 0; _i < 2; ++_i) \
        __builtin_amdgcn_global_load_lds((const unsigned*)((const char*)(gbase) + voffB[_i]), (LAS unsigned*)(lds + (bufoff) + ldsw + _i * 8192), 16, 0, 0); } while (0)
#define PG8_STAGE_A(bufoff, gbase, hf, o0, o1) do { if constexpr (Sched::GATHER) { \
        __builtin_amdgcn_global_load_lds((const unsigned*)((const char*)(gbase) + (o0)), (LAS unsigned*)(lds + (bufoff) + ldsw), 16, 0, 0); \
        __builtin_amdgcn_global_load_lds((const unsigned*)((const char*)(gbase) + (o1)), (LAS unsigned*)(lds + (bufoff) + ldsw + 8192), 16, 0, 0); } else { \
        __builtin_amdgcn_global_load_lds((const unsigned*)((const char*)(gbase) + (hf) * hstepB + voffA[0]), (LAS unsigned*)(lds + (bufoff) + ldsw), 16, 0, 0); \
        __builtin_amdgcn_global_load_lds((const unsigned*)((const char*)(gbase) + (hf) * hstepB + voffA[1]), (LAS unsigned*)(lds + (bufoff) + ldsw + 8192), 16, 0, 0); } } while (0)
#define PG8_LDA(dst, b, h) do { _Pragma("unroll") for (int m = 0; m < 4; ++m) { dst[m].lo = *(const LAS i32x4*)(lds + PG8_SA(b, h) + aoff + m * 2048); dst[m].hi = *(const LAS i32x4*)(lds + PG8_SA(b, h) + aoff + m * 2048 + 1024); } } while (0)
#define PG8_LDB(dst, b, h) do { _Pragma("unroll") for (int n = 0; n < 2; ++n) { dst[n].lo = *(const LAS i32x4*)(lds + PG8_SB(b, h) + boff + n * 2048); dst[n].hi = *(const LAS i32x4*)(lds + PG8_SB(b, h) + boff + n * 2048 + 1024); } } while (0)
#define PG8_MMA(ai, bj, At, Bt) do { __builtin_amdgcn_s_setprio(1); _Pragma("unroll") for (int m = 0; m < 4; ++m) _Pragma("unroll") for (int n = 0; n < 2; ++n) { \
        if constexpr (Epi::FP8) asm volatile("v_mfma_scale_f32_16x16x128_f8f6f4 %0, %1, %2, %0, %3, %4 op_sel_hi:[0,0,0]" : "+v"(acc[ai][bj][m][n]) : "v"(Bt[n]), "v"(At[m]), "v"(sclw_), "v"(scla_));   \
        else { const i32x4 bl_ = Bt[n].lo, bh_ = Bt[n].hi, al_ = At[m].lo, ah_ = At[m].hi;     \
               acc[ai][bj][m][n] = __builtin_amdgcn_mfma_f32_16x16x32_bf16(__builtin_bit_cast(bf16x8, bl_), __builtin_bit_cast(bf16x8, al_), acc[ai][bj][m][n], 0, 0, 0); \
               acc[ai][bj][m][n] = __builtin_amdgcn_mfma_f32_16x16x32_bf16(__builtin_bit_cast(bf16x8, bh_), __builtin_bit_cast(bf16x8, ah_), acc[ai][bj][m][n], 0, 0, 0); } } __builtin_amdgcn_s_setprio(0); } while (0)
#define PG8_WAIT_V(n) asm volatile("s_waitcnt vmcnt(" #n ")" ::: "memory")
#define PG8_WAIT_L(n) asm volatile("s_waitcnt lgkmcnt(" #n ")" ::: "memory")
#define PG8_BAR __builtin_amdgcn_s_barrier()
#define PG8_SCHED __builtin_amdgcn_sched_barrier(0)
    Unit cur, nxt; int ui = 0;
    if (!S.next(0, cur)) return;
    f32x4 acc[2][2][4][2];
#pragma unroll
    for (int a = 0; a < 2; ++a)
#pragma unroll
        for (int b = 0; b < 2; ++b)
#pragma unroll
            for (int m = 0; m < 4; ++m)
#pragma unroll
                for (int n = 0; n < 2; ++n) acc[a][b][m][n] = (f32x4){0.f, 0.f, 0.f, 0.f};
    i32x8 At[4], B0[2], B1[2];
    int sclw_ = Epi::SCALE_W, scla_ = Epi::SCALE_A; asm volatile("" : "+v"(sclw_), "+v"(scla_));
    PG8_STAGE_B(PG8_SB(0, 0), cur.B); PG8_STAGE_B(PG8_SB(0, 1), cur.B + hstepW); PG8_STAGE_A(PG8_SA(0, 0), cur.A, 0, cur.a00, cur.a01); PG8_STAGE_A(PG8_SA(0, 1), cur.A, 1, cur.a10, cur.a11);
    if (wr == 1) PG8_BAR;
    PG8_WAIT_V(2); PG8_BAR;
    PG8_STAGE_B(PG8_SB(1, 0), cur.B + kstep); PG8_STAGE_A(PG8_SA(1, 0), cur.A + kstep, 0, cur.a00, cur.a01); PG8_STAGE_B(PG8_SB(1, 1), cur.B + hstepW + kstep);
    PG8_WAIT_V(6); PG8_BAR;
    for (;;) {
        const bool has_next = S.next(ui + 1, nxt);
        const char* nA = has_next ? nxt.A : cur.A; const char* nB = has_next ? nxt.B : cur.B;
        if constexpr (Sched::GATHER) {
            u32x4 nv; nv.x = has_next ? nxt.a00 : cur.a00; nv.y = has_next ? nxt.a01 : cur.a01; nv.z = has_next ? nxt.a10 : cur.a10; nv.w = has_next ? nxt.a11 : cur.a11;
            *(LAS u32x4*)(lds + NXT_SLOT_OFF + tid * 16) = nv; nxt.a00 = 0u; nxt.a01 = 0u; nxt.a10 = 0u; nxt.a11 = 0u;
        }
#pragma unroll 1
        for (int t = 0; t < nt; t += 2) {
            const bool last = (t == nt - 2);
            const char* a1 = cur.A + (size_t)(t + 1) * kstep;
            const char* a2 = last ? nA : cur.A + (size_t)(t + 2) * kstep; const char* b2 = last ? nB : cur.B + (size_t)(t + 2) * kstep;
            const char* a3 = a2 + kstep; const char* b3 = b2 + kstep;
            unsigned x00 = cur.a00, x01 = cur.a01, x10 = cur.a10, x11 = cur.a11;
            if constexpr (Sched::GATHER) { if (last) { const u32x4 nv = *(const LAS u32x4*)(lds + NXT_SLOT_OFF + tid * 16); x00 = nv.x; x01 = nv.y; x10 = nv.z; x11 = nv.w; } }
            PG8_LDB(B0, 0, 0); PG8_LDB(B1, 0, 1); PG8_SCHED; PG8_LDA(At, 0, 0); PG8_STAGE_A(PG8_SA(1, 1), a1, 1, cur.a10, cur.a11);
            PG8_WAIT_V(8); PG8_WAIT_L(0); PG8_BAR; PG8_MMA(0, 0, At, B0); PG8_MMA(0, 1, At, B1); PG8_BAR; PG8_SCHED;
            PG8_LDA(At, 0, 1); PG8_STAGE_B(PG8_SB(0, 0), b2); PG8_STAGE_B(PG8_SB(0, 1), b2 + hstepW); PG8_STAGE_A(PG8_SA(0, 0), a2, 0, x00, x01);
            PG8_WAIT_V(8); PG8_WAIT_L(0); PG8_BAR; PG8_MMA(1, 0, At, B0); PG8_MMA(1, 1, At, B1); PG8_BAR; PG8_SCHED;
            PG8_LDB(B0, 1, 0); PG8_LDB(B1, 1, 1); PG8_SCHED; PG8_LDA(At, 1, 0); PG8_STAGE_A(PG8_SA(0, 1), a2, 1, x10, x11);
            PG8_WAIT_V(8); PG8_WAIT_L(0); PG8_BAR; PG8_MMA(0, 0, At, B0); PG8_MMA(0, 1, At, B1); PG8_BAR; PG8_SCHED;
            PG8_LDA(At, 1, 1); PG8_STAGE_B(PG8_SB(1, 0), b3); PG8_STAGE_B(PG8_SB(1, 1), b3 + hstepW); PG8_STAGE_A(PG8_SA(1, 0), a3, 0, x00, x01);
            PG8_WAIT_V(8); PG8_WAIT_L(0); PG8_BAR; PG8_MMA(1, 0, At, B0); PG8_MMA(1, 1, At, B1); PG8_BAR; PG8_SCHED;
        }
        if constexpr (Epi::FP8) asm volatile("s_nop 15\n\ts_nop 7" ::: "memory");
        if constexpr (ALIGN_EPI) { if (wr == 0) PG8_BAR; }
        E(acc, cur, wr, wc, fr, fq);
        if (!has_next) break;
#pragma unroll
        for (int a = 0; a < 2; ++a)
#pragma unroll
            for (int b = 0; b < 2; ++b)
#pragma unroll
                for (int m = 0; m < 4; ++m)
#pragma unroll
                    for (int n = 0; n < 2; ++n) acc[a][b][m][n] = (f32x4){0.f, 0.f, 0.f, 0.f};
        cur = nxt; ++ui;
        if constexpr (Sched::GATHER) { const u32x4 nv = *(const LAS u32x4*)(lds + NXT_SLOT_OFF + tid * 16); cur.a00 = nv.x; cur.a01 = nv.y; cur.a10 = nv.z; cur.a11 = nv.w; }
        if constexpr (ALIGN_EPI) { if (wr == 1) PG8_BAR; }
    }
    PG8_WAIT_V(0);
    if constexpr (!ALIGN_EPI) { if (wr == 0) PG8_BAR; }
    PG8_BAR;
#undef PG8_SA
#undef PG8_SB
#undef PG8_STAGE_A
#undef PG8_STAGE_B
#undef PG8_LDA
#undef PG8_LDB
#undef PG8_MMA
#undef PG8_WAIT_V
#undef PG8_WAIT_L
#undef PG8_BAR
#undef PG8_SCHED
}
}

#define XB_TMO      128
#define XB_XCNT(j)  (256  + 64 * (j))
#define XB_XSUB(j)  (1280 + 64 * (j))
#define XB_XGEN(j)  (2304 + 64 * (j))
#define XB_TOP      3328
#define XB_TOPGEN   3392
#define XCD_BAR_WORDS 3456
#define XB_SPIN_CAP (1u << 22)
__device__ __forceinline__ unsigned xb_ld(unsigned* p)              { return __hip_atomic_load(p, __ATOMIC_RELAXED, __HIP_MEMORY_SCOPE_AGENT); }
__device__ __forceinline__ unsigned xb_add(unsigned* p, unsigned v) { return __hip_atomic_fetch_add(p, v, __ATOMIC_RELAXED, __HIP_MEMORY_SCOPE_AGENT); }
__device__ __forceinline__ unsigned xb_xcc_id() { return (unsigned)__builtin_amdgcn_s_getreg((3 << 11) | 20) & 0xFu; }
#define XB_SPIN(cond, bar) do { unsigned _sp = 0; while (cond) { __builtin_amdgcn_s_sleep(1); \
    if ((++_sp & 255u) == 0u) { if (xb_ld(&(bar)[XB_TMO])) break; if (_sp > XB_SPIN_CAP) { atomicAdd(&(bar)[XB_TMO], 1u); break; } } } } while (0)
struct XcdBarrier { unsigned* bar; unsigned x; volatile LAS unsigned* st; };
__device__ __forceinline__ XcdBarrier xcd_barrier_post(unsigned* bar, volatile LAS unsigned* st) {
    XcdBarrier b; b.bar = bar; b.x = xb_xcc_id(); b.st = st;
    if (threadIdx.x == 0) (void)xb_add(&bar[XB_XCNT(b.x)], 1u);
    return b;
}
__device__ __forceinline__ void xcd_barrier_complete(unsigned* bar, unsigned x, unsigned& nloc, unsigned& nx) {
    const unsigned G = gridDim.x * gridDim.y * gridDim.z;
    unsigned sum, cnt, mine, sp = 0u;
    for (;;) {
        sum = 0u; cnt = 0u; mine = 0u;
#pragma unroll
        for (unsigned j = 0; j < 16; ++j) { const unsigned c = xb_ld(&bar[XB_XCNT(j)]); sum += c; cnt += (c > 0u) ? 1u : 0u; mine = (j == x) ? c : mine; }
        if (sum == G) break;
        __builtin_amdgcn_s_sleep(1);
        if ((++sp & 255u) == 0u) { if (xb_ld(&bar[XB_TMO])) break; if (sp > XB_SPIN_CAP) { atomicAdd(&bar[XB_TMO], 1u); break; } }
    }
    nloc = mine > 0u ? mine : 1u; nx = cnt > 0u ? cnt : 1u;
}
__device__ __forceinline__ void xcd_barrier(const XcdBarrier& b) {
    asm volatile("s_waitcnt vmcnt(0)" ::: "memory");
    __syncthreads();
    if (threadIdx.x == 0) {
        unsigned* bar = b.bar;
        __builtin_amdgcn_s_waitcnt(0);
        unsigned nloc = b.st[0], nx = b.st[1];
        if (nloc == 0u) { xcd_barrier_complete(bar, b.x, nloc, nx); b.st[0] = nloc; b.st[1] = nx; }
        const unsigned old = xb_add(&bar[XB_XSUB(b.x)], 1u);
        const unsigned gen = old / nloc;
        if (old + 1u == (gen + 1u) * nloc) {
            __builtin_amdgcn_fence(__ATOMIC_RELEASE, "agent");
            asm volatile("s_waitcnt vmcnt(0)" ::: "memory");
            const unsigned og = xb_add(&bar[XB_TOP], 1u);
            const unsigned tg = og / nx;
            if (og + 1u == (tg + 1u) * nx) xb_add(&bar[XB_TOPGEN], 1u);
            else XB_SPIN(xb_ld(&bar[XB_TOPGEN]) == tg, bar);
            __builtin_amdgcn_fence(__ATOMIC_ACQUIRE, "agent");
            xb_add(&bar[XB_XGEN(b.x)], 1u);
            asm volatile("s_waitcnt vmcnt(0)" ::: "memory");
        } else {
            XB_SPIN(xb_ld(&bar[XB_XGEN(b.x)]) == gen, bar);
            __builtin_amdgcn_fence(__ATOMIC_ACQUIRE, "agent");
            asm volatile("s_waitcnt vmcnt(0)" ::: "memory");
        }
    }
    __syncthreads();
}

struct Args {
    const float* in[19];
    float* out; unsigned char* ws;
    int ph_lo, ph_hi, use_bar, rep;
};
struct Ctx {
    const float *x, *mem, *w_in, *b_in, *w_mem_kv, *sinks, *rel_bias, *lb_logits, *hnorm, *w_out, *ln1g, *ln1b, *w_router, *rbias, *w_gate, *w_up, *w_down, *ln2g, *ln2b;
    float* xcur;
    unsigned char* ws;
    unsigned* ctl;
    bf16 *Win, *Wout, *Wmem, *W1, *W2, *xb, *proj, *ys, *mix, *hmid, *memkv, *memb;
    bf16* hpre; float* biastab; float* lbtab; int* list; u32x4* tokrec; float* hst; unsigned char* xb8;
    int vcu, G, rep;
};

__constant__ unsigned char T5_BUCKET[128] = {0, 1, 2, 3, 4, 5, 6, 7, 8, 9, 10, 11, 12, 13, 14, 15, 16, 16, 16, 17, 17, 18, 18, 18, 19, 19, 19, 20, 20, 20, 20, 21, 21, 21, 21, 22, 22, 22, 22, 22, 23, 23, 23, 23, 23, 23, 24, 24, 24, 24, 24, 24, 25, 25, 25, 25, 25, 25, 25, 26, 26, 26, 26, 26, 26, 26, 26, 27, 27, 27, 27, 27, 27, 27, 27, 27, 27, 28, 28, 28, 28, 28, 28, 28, 28, 28, 28, 29, 29, 29, 29, 29, 29, 29, 29, 29, 29, 29, 29, 30, 30, 30, 30, 30, 30, 30, 30, 30, 30, 30, 30, 30, 30, 31, 31, 31, 31, 31, 31, 31, 31, 31, 31, 31, 31, 31, 31, 31};

struct TrItem { const float* src; bf16* dst; int N, K; float fp8s; };
__device__ __forceinline__ bool p0_item(const Ctx& C, int it, TrItem& t) {
    constexpr int I_IN = DEPTH * 16 * 64, I_OUT = DEPTH * 16 * 32, I_MEM = DEPTH * 16 * 16, I_G = 64 * 16 * 16, I_D = 64 * 8 * 32;
    constexpr int NITEMS = I_IN + I_OUT + I_MEM + 2 * I_G + I_D;
    if (it >= NITEMS) return false;
    int r = it;
    if (r < I_IN) { const int l = r / 1024, q = r % 1024, kb = q / 64, nb = q % 64; t.fp8s = 32.f; t.N = INW; t.K = DM; t.src = C.w_in + (size_t)l * DM * INW + (size_t)(64 * kb) * INW + 32 * nb; t.dst = (bf16*)((unsigned char*)C.Win + (size_t)l * INW * DM + (size_t)(32 * nb) * DM + 64 * kb); return true; } r -= I_IN;
    if (r < I_OUT) { const int l = r / 512, q = r % 512, kb = q / 32, nb = q % 32; t.fp8s = 64.f; t.N = DM; t.K = MIXW; t.src = C.w_out + (size_t)l * MIXW * DM + (size_t)(64 * kb) * DM + 32 * nb; t.dst = (bf16*)((unsigned char*)C.Wout + (size_t)l * DM * MIXW + (size_t)(32 * nb) * MIXW + 64 * kb); return true; } r -= I_OUT;
    if (r < I_MEM) { const int l = r / 256, q = r % 256, kb = q / 16, nb = q % 16; t.fp8s = 32.f; t.N = 512; t.K = DM; t.src = C.w_mem_kv + (size_t)l * DM * 512 + (size_t)(64 * kb) * 512 + 32 * nb; t.dst = (bf16*)((unsigned char*)C.Wmem + (size_t)l * 512 * DM + (size_t)(32 * nb) * DM + 64 * kb); return true; } r -= I_MEM;
    if (r < 2 * I_G) { const int up = r >= I_G; if (up) r -= I_G; const int le = r / 256, q = r % 256, kb = q / 16, nb = q % 16; const int n0 = 32 * nb;
        t.N = DE; t.K = DM; t.src = (up ? C.w_up : C.w_gate) + (size_t)le * DM * DE + (size_t)(64 * kb) * DE + n0; t.fp8s = up ? (32.f * 8.f / 1.44269504f) : (32.f * 1.44269504f); t.dst = (bf16*)((unsigned char*)C.W1 + (size_t)le * 1024 * DM + (size_t)((n0 >> 7) * 256 + (up ? 128 : 0) + (n0 & 127)) * DM + 64 * kb); return true; } r -= 2 * I_G;
    { const int le = r / 256, q = r % 256, kb = q / 32, nb = q % 32; t.N = DM; t.K = DE; t.src = C.w_down + (size_t)le * DE * DM + (size_t)(64 * kb) * DM + 32 * nb; t.fp8s = 64.f; t.dst = (bf16*)((unsigned char*)C.W2 + (size_t)le * DM * DE + (size_t)(32 * nb) * DE + 64 * kb); }
    return true;
}
constexpr int P0_NLD = 1024 + 512 + 3 * 4096, P0_TPI = 16, P0_NCV = P0_NLD / P0_TPI;
__device__ __forceinline__ int p0_map(int l, int j) {
    constexpr int I_IN = DEPTH * 16 * 64, I_OUT = DEPTH * 16 * 32, I_MEM = DEPTH * 16 * 16, I_G = 64 * 16 * 16;
    if (l < 0) return (j < 1024) ? j : I_IN + I_OUT + (j - 1024);
    if (j < 512) return I_IN + l * 512 + j;
    if (j < 12800) { const int q = j - 512; return I_IN + I_OUT + I_MEM + (q >> 12) * I_G + l * 4096 + (q & 4095); }
    return (l + 1) * 1024 + (j - 12800);
}
__device__ __forceinline__ void p0_convert(const Ctx& C, LAS unsigned char* lds, int wave, int lane, int l, int j0, int j1, int stride) {
    LAS float* scr = (LAS float*)(lds + wave * 16384);
    TrItem cur[2], nxt[2]; float va[2][32], vb[2][32]; bool hv[2], hn[2];
#pragma unroll
    for (int u = 0; u < 2; ++u) { const int j = j0 + u * stride; hv[u] = j < j1;
        if (hv[u]) { p0_item(C, p0_map(l, j), cur[u]);
#pragma unroll
            for (int i = 0; i < 32; ++i) va[u][i] = __builtin_nontemporal_load(cur[u].src + (size_t)(2 * i + (lane >> 5)) * cur[u].N + (lane & 31)); } }
    for (int it = j0; hv[0]; it += 2 * stride) {
#pragma unroll
        for (int u = 0; u < 2; ++u) { const int j = it + (2 + u) * stride; hn[u] = j < j1;
            if (hn[u]) { p0_item(C, p0_map(l, j), nxt[u]);
#pragma unroll
                for (int i = 0; i < 32; ++i) vb[u][i] = __builtin_nontemporal_load(nxt[u].src + (size_t)(2 * i + (lane >> 5)) * nxt[u].N + (lane & 31)); } }
#pragma unroll
        for (int u = 0; u < 2; ++u) if (hv[u]) {
#pragma unroll
            for (int i = 0; i < 32; ++i) scr[(2 * i + (lane >> 5)) * 33 + (lane & 31)] = va[u][i];
            const int c = lane & 7;
#pragma unroll
            for (int j = 0; j < 4; ++j) { const int n = (lane >> 3) + 8 * j; const LAS float* s = scr + (8 * c) * 33 + n;
                const float sc = cur[u].fp8s;
                int w0 = __builtin_amdgcn_cvt_pk_fp8_f32(s[0 * 33] * sc, s[1 * 33] * sc, 0, false); w0 = __builtin_amdgcn_cvt_pk_fp8_f32(s[2 * 33] * sc, s[3 * 33] * sc, w0, true);
                int w1 = __builtin_amdgcn_cvt_pk_fp8_f32(s[4 * 33] * sc, s[5 * 33] * sc, 0, false); w1 = __builtin_amdgcn_cvt_pk_fp8_f32(s[6 * 33] * sc, s[7 * 33] * sc, w1, true);
                u32x2 o8; o8.x = (unsigned)w0; o8.y = (unsigned)w1;
                __builtin_nontemporal_store(o8, (u32x2*)((unsigned char*)cur[u].dst + (size_t)n * cur[u].K + 8 * c)); }
        }
#pragma unroll
        for (int u = 0; u < 2; ++u) {
#pragma unroll
            for (int i = 0; i < 32; ++i) va[u][i] = vb[u][i];
            if (hn[u]) cur[u] = nxt[u];
            hv[u] = hn[u]; }
    }
}
__device__ __forceinline__ void p0_prologue(const Ctx& C, LAS unsigned char* lds, int wave, int lane) {
    const int gw = C.vcu * NWAVES + wave, NGW = C.G * NWAVES;
    p0_convert(C, lds, wave, lane, -1, gw, 1024 + DEPTH * 256, NGW);
    for (int m = gw; m < NTOK + NB * MEMLEN; m += NGW) {
        const bool ism = m >= NTOK; const int r = ism ? m - NTOK : m;
        const f32x4* src = (const f32x4*)((ism ? C.mem : C.x) + (size_t)r * DM) + lane;
        f32x4 v[4];
#pragma unroll
        for (int j = 0; j < 4; ++j) v[j] = __builtin_nontemporal_load(src + 64 * j);
        unsigned* q8 = (unsigned*)((ism ? (unsigned char*)C.memb : C.xb8) + (size_t)r * DM) + lane;
        unsigned* ql = (unsigned*)((unsigned char*)C.xb + (size_t)r * DM) + lane;
#pragma unroll
        for (int j = 0; j < 4; ++j) { unsigned hi, lo; split_fp8(v[j], hi, lo); __hip_atomic_store(q8 + 64 * j, hi, __ATOMIC_RELAXED, __HIP_MEMORY_SCOPE_AGENT); if (!ism) __hip_atomic_store(ql + 64 * j, lo, __ATOMIC_RELAXED, __HIP_MEMORY_SCOPE_AGENT); }
    }
    if (blockIdx.x == 0) {
        const int tid = wave * 64 + lane;
        for (int i = tid; i < 8 * 128; i += NTHR) { const int h = i >> 7, d = i & 127; C.biastab[i] = C.rel_bias[(int)T5_BUCKET[d] * 8 + h]; }
        if (tid < 256) { float v0 = C.lb_logits[tid], v1 = C.lb_logits[256 + tid], v2 = C.lb_logits[512 + tid], v3 = C.lb_logits[768 + tid];
            const float mx = fmaxf(fmaxf(v0, v1), fmaxf(v2, v3)); v0 = __expf(v0 - mx); v1 = __expf(v1 - mx); v2 = __expf(v2 - mx); v3 = __expf(v3 - mx);
            const float inv = 1.f / (v0 + v1 + v2 + v3);
            C.lbtab[tid] = 0.f; C.lbtab[256 + tid] = v1 * inv; C.lbtab[512 + tid] = (v1 + v2) * inv; C.lbtab[768 + tid] = (v1 + v2 + v3) * inv; }
    }
}

struct DenseSched {
    static constexpr bool GATHER = false;
    const char* A0; const char* B0; int nM0, nN0, K0;
    const char* A1; const char* B1; int nM1, nN1;
    int G, c, one;
    __device__ __forceinline__ void lane_init(int, int, int, int) {}
    __device__ __forceinline__ bool next(int i, pg8::Unit& u) const {
        const int n0 = nM0 * nN0; const int L = one >= 0 ? n0 + one : i * G + c; if (L >= n0 + nM1 * nN1 || (one >= 0 && i > 0)) return false;
        int pm, pn; const char* A; const char* B; int aux;
        if (L < n0) { pg8::tile_order(L, nM0, nN0, pm, pn); A = A0; B = B0; aux = 0; }
        else { pg8::tile_order(L - n0, nM1, nN1, pm, pn); A = A1; B = B1; aux = 1; }
        u.A = A + (size_t)pm * 256 * K0; u.B = B + (size_t)pn * 256 * K0;
        u.a00 = 0u; u.a01 = 0u; u.a10 = 0u; u.a11 = 0u;
        u.row0 = pm * 256; u.col0 = pn * 256; u.aux = aux; return true;
    }
};
template <bool GATHER_> struct MoeSched {
    static constexpr bool GATHER = GATHER_;
    const char* A; const char* Bl; int K; size_t bstride;
    const int* list; const LAS int* tb;
    int g0, g1, gU, mode; int R0, C0, R1, C1;
    __device__ __forceinline__ void lane_init(int r0, int c0, int r1, int c1) { R0 = r0; C0 = c0; R1 = r1; C1 = c1; }
    __device__ __forceinline__ bool next(int i, pg8::Unit& u) const {
        int g;
        if (mode == 0) { g = g0 + i * g1; if (g >= gU) return false; }
        else {
            const int c = g0, E = g1;
            if (c < E) { if (i == 0) g = 1024 + c; else if (i <= 2) g = c + (i - 1) * E; else return false; }
            else { g = 2 * E + (c - E) + i * (256 - E); if (g >= gU) return false; }
        }
        const int tile = g >> 2, pn = g & 3;
        int e = 0;
#pragma unroll
        for (int j = 1; j < 16; ++j) e += (tile >= tb[j]) ? 1 : 0;
        e = __builtin_amdgcn_readfirstlane(e);
        u.B = Bl + (size_t)e * bstride + (size_t)pn * 256 * K;
        u.A = A;
        if (GATHER) {
            const int p0 = (tile - __builtin_amdgcn_readfirstlane(tb[e])) * 256, cnt = __builtin_amdgcn_readfirstlane(tb[17 + e]); const int* le = list + (size_t)e * LCAP;
            const int cm = cnt - 1;
            const int t00 = le[min(p0 + R0, cm)], t01 = le[min(p0 + R1, cm)], t10 = le[min(p0 + 128 + R0, cm)], t11 = le[min(p0 + 128 + R1, cm)];
            u.a00 = (unsigned)t00 * K + 2 * C0; u.a01 = (unsigned)t01 * K + 2 * C1; u.a10 = (unsigned)t10 * K + 2 * C0; u.a11 = (unsigned)t11 * K + 2 * C1;
        } else {
            u.A = A + (size_t)tile * 256 * K; u.a00 = 0u; u.a01 = 0u; u.a10 = 0u; u.a11 = 0u;
        }
        u.row0 = tile * 256; u.col0 = pn * 256; u.aux = e; return true;
    }
};
struct EpiProj {
    static constexpr bool PERM = true, PERM16 = true, FP8 = true; static constexpr int SCALE_W = 0x7A7A7A7A  , SCALE_A = 0x7C7C7C7C  ;
    unsigned char* O0; const LAS float* bias; unsigned char* O1;
    __device__ __forceinline__ void operator()(const f32x4 (&acc)[2][2][4][2], const pg8::Unit& u, int wr, int wc, int fr, int fq) const {
        unsigned char* base = u.aux ? O1 : O0; const int row0 = u.row0 + wr * 64 + fr, col0 = u.col0 + wc * 64 + 16 * fq;
        f32x4 bv[2][2];
#pragma unroll
        for (int bj = 0; bj < 2; ++bj)
#pragma unroll
            for (int n = 0; n < 2; ++n) bv[bj][n] = u.aux ? (f32x4){0.f, 0.f, 0.f, 0.f} : *(const LAS f32x4*)(bias + col0 + 8 * bj + 4 * n);
#pragma unroll
        for (int ai = 0; ai < 2; ++ai)
#pragma unroll
            for (int m = 0; m < 4; ++m) { unsigned char* rowp = base + (size_t)(row0 + ai * 128 + m * 16) * INW + col0;
                u32x4 w; w.x = pk_fp8x4((acc[ai][0][m][0] + bv[0][0]) * 8.f); w.y = pk_fp8x4((acc[ai][0][m][1] + bv[0][1]) * 8.f); w.z = pk_fp8x4((acc[ai][1][m][0] + bv[1][0]) * 8.f); w.w = pk_fp8x4((acc[ai][1][m][1] + bv[1][1]) * 8.f);
                *(u32x4*)rowp = w; }
    }
};
struct EpiOut {
    static constexpr bool PERM = true, PERM16 = true, FP8 = true; static constexpr int SCALE_W = 0x79797979  , SCALE_A = 0x7C7C7C7C  ;
    unsigned char* H;
    __device__ __forceinline__ void operator()(const f32x4 (&acc)[2][2][4][2], const pg8::Unit& u, int wr, int wc, int fr, int fq) const {
        const int row0 = u.row0 + wr * 64 + fr, col0 = u.col0 + wc * 64 + 16 * fq;
#pragma unroll
        for (int ai = 0; ai < 2; ++ai)
#pragma unroll
            for (int m = 0; m < 4; ++m) { const size_t off = (size_t)(row0 + ai * 128 + m * 16) * DM + col0;
                u32x4 w; w.x = pk_fp8x4(acc[ai][0][m][0] * 64.f); w.y = pk_fp8x4(acc[ai][0][m][1] * 64.f); w.z = pk_fp8x4(acc[ai][1][m][0] * 64.f); w.w = pk_fp8x4(acc[ai][1][m][1] * 64.f);
                *(u32x4*)(H + off) = w; }
    }
};
struct EpiG1 {
    static constexpr bool PERM = true, PERM16 = false, FP8 = true; static constexpr int SCALE_W = 0x7A7A7A7A  , SCALE_A = 0x7C7C7C7C  ;
    unsigned char* O;
    __device__ __forceinline__ void operator()(const f32x4 (&acc)[2][2][4][2], const pg8::Unit& u, int wr, int wc, int fr, int fq) const {
        const int row0 = u.row0 + wr * 64 + fr, col0 = (u.col0 >> 1) + wc * 32 + 8 * fq;
#pragma unroll
        for (int ai = 0; ai < 2; ++ai)
#pragma unroll
            for (int m = 0; m < 4; ++m) { unsigned char* rowp = O + (size_t)(row0 + ai * 128 + m * 16) * DE + col0;
                float hv[8];
#pragma unroll
                for (int n = 0; n < 2; ++n)
#pragma unroll
                    for (int j = 0; j < 4; ++j) { const float G = acc[ai][0][m][n][j], U = acc[ai][1][m][n][j]; hv[n * 4 + j] = G * U * frcp(1.f + __builtin_amdgcn_exp2f(-G)); }
                int w0 = __builtin_amdgcn_cvt_pk_fp8_f32(hv[0], hv[1], 0, false); w0 = __builtin_amdgcn_cvt_pk_fp8_f32(hv[2], hv[3], w0, true);
                int w1 = __builtin_amdgcn_cvt_pk_fp8_f32(hv[4], hv[5], 0, false); w1 = __builtin_amdgcn_cvt_pk_fp8_f32(hv[6], hv[7], w1, true);
                u32x2 w; w.x = (unsigned)w0; w.y = (unsigned)w1;
                *(u32x2*)rowp = w; }
    }
};
struct EpiG2 {
    static constexpr bool PERM = true, PERM16 = true, FP8 = true; static constexpr int SCALE_W = 0x79797979  , SCALE_A = 0x7C7C7C7C  ;
    unsigned char* O;
    __device__ __forceinline__ void operator()(const f32x4 (&acc)[2][2][4][2], const pg8::Unit& u, int wr, int wc, int fr, int fq) const {
        const int row0 = u.row0 + wr * 64 + fr, col0 = u.col0 + wc * 64 + 16 * fq;
#pragma unroll
        for (int ai = 0; ai < 2; ++ai)
#pragma unroll
            for (int m = 0; m < 4; ++m) { unsigned char* rowp = O + (size_t)(row0 + ai * 128 + m * 16) * DM + col0;
                u32x4 w; w.x = pk_fp8x4(acc[ai][0][m][0] * 16.f); w.y = pk_fp8x4(acc[ai][0][m][1] * 16.f); w.z = pk_fp8x4(acc[ai][1][m][0] * 16.f); w.w = pk_fp8x4(acc[ai][1][m][1] * 16.f);
                *(u32x4*)rowp = w; }
    }
};

constexpr int AT_KOFF = 0, AT_VOFF = 36864, AT_BOFF = 73728, AT_OOFF = 77824;
template <bool SWA>
__device__ __forceinline__ int attn_item(const Ctx& C, LAS unsigned char* lds, int l, int item, int tid, int wave, int lane, unsigned* qhead) {
    int nxt_it = -1;
    const int tk = lane & 15, g = lane >> 4;
    int b, nb = 0, kvh = 0, hm = 0, qb = 0;
    const unsigned char *Kg, *Vg; size_t kpitch;
    if (SWA) { b = item >> 6; nb = (item >> 1) & 31; kvh = item & 1;
        Kg = (const unsigned char*)C.proj + ((size_t)b * SEQ + (size_t)(nb - 1) * 128) * INW + C_SK + kvh * 64; Vg = Kg + (C_SV - C_SK); kpitch = INW; }
    else { b = item >> 5; hm = (item >> 3) & 3; qb = item & 7;
        Kg = (const unsigned char*)C.memkv + (size_t)b * MEMLEN * 2048 + l * 512 + hm * 64; Vg = Kg + 256; kpitch = 2048; }
#pragma unroll
    for (int i = 0; i < 4; ++i) { const int c = tid + 512 * i, key = c >> 3, part = c & 7;
        u32x2 k8 = {0u, 0u}, v8 = {0u, 0u};
        if (!SWA || nb > 0 || key >= 128) { k8 = *(const u32x2*)(Kg + (size_t)key * kpitch + part * 8); v8 = *(const u32x2*)(Vg + (size_t)key * kpitch + part * 8); }
        *(LAS u32x4*)(lds + AT_KOFF + key * 144 + part * 16) = fp8x8_to_bf16x8(k8); *(LAS u32x4*)(lds + AT_VOFF + key * 144 + part * 16) = fp8x8_to_bf16x8(v8); }
    if (SWA) ((LAS float*)(lds + AT_BOFF))[tid] = C.biastab[(kvh * 4 + (tid >> 7)) * 128 + (tid & 127)] * 1.44269504f;
    __syncthreads();
    int hq = 0; float sink = 0.f; size_t qrow_base; int qcol, ocol, i0w = 0;
    if (SWA) { hq = kvh * 4 + (wave >> 1); sink = C.sinks[l * 8 + hq]; i0w = (wave & 1) * 64; qrow_base = (size_t)b * SEQ + nb * 128 + i0w; qcol = C_SQ + hq * 64; ocol = hq * 64; }
    else { qrow_base = (size_t)b * SEQ + qb * 512 + wave * 64; qcol = C_MQ + hm * 64; ocol = 768 + hm * 64; }
    const LAS float* biasL = (const LAS float*)(lds + AT_BOFF) + (wave >> 1) * 128;
    const LAS unsigned char* kbase = lds + AT_KOFF + tk * 144 + g * 16;
    const LAS unsigned char* vbase = lds + AT_VOFF + (4 * g + (tk >> 2)) * 144 + (tk & 3) * 8;
    float bsr[SWA ? 10 : 1][4];
    if (SWA) { const int d0 = tk + 128 - 4 * g;
#pragma unroll
        for (int t = 0; t < 10; ++t)
#pragma unroll
            for (int r = 0; r < 4; ++r) bsr[SWA ? t : 0][r] = biasL[d0 - 16 * t - r]; }
#pragma unroll 1
    for (int rt = 0; rt < 4; ++rt) {
        if (rt == 3 && tid == 0) nxt_it = (int)__hip_atomic_fetch_add(qhead, 1u, __ATOMIC_RELAXED, __HIP_MEMORY_SCOPE_AGENT) + (int)gridDim.x;
        const size_t qrow = qrow_base + rt * 16;
        const unsigned char* qp = (const unsigned char*)C.proj + (qrow + tk) * INW + qcol + 8 * g;
        const bf16x8 q0 = __builtin_bit_cast(bf16x8, fp8x8_to_bf16x8(*(const u32x2*)qp)), q1 = __builtin_bit_cast(bf16x8, fp8x8_to_bf16x8(*(const u32x2*)(qp + 32)));
        constexpr int NT = SWA ? 10 : 16;
        const int t0 = SWA ? ((i0w >> 4) + rt) : 0;
        f32x4 st[NT];
#pragma unroll
        for (int t = 0; t < (SWA ? NT - 1 : NT); ++t) {
            const int tc = SWA ? min(t0 + t, 15) : t;
            const bf16x8 k0 = *(const LAS bf16x8*)(kbase + tc * 16 * 144), k1 = *(const LAS bf16x8*)(kbase + tc * 16 * 144 + 64);
            f32x4 a = {0.f, 0.f, 0.f, 0.f};
            a = __builtin_amdgcn_mfma_f32_16x16x32_bf16(k0, q0, a, 0, 0, 0);
            st[t] = __builtin_amdgcn_mfma_f32_16x16x32_bf16(k1, q1, a, 0, 0, 0);
        }
        constexpr float C2 = 0.125f * 1.44269504f * (1.f / 64.f);
        float mx2, sum = 0.f;
        if (SWA) {
            const float sink2 = sink * 1.44269504f;
            const int iq = i0w + rt * 16 + tk;
            const int d0 = iq + 128 - 16 * t0 - 4 * g;
            const unsigned lim = (nb > 0) ? 128u : (unsigned)min(128, iq + 1);
            float m4[4] = {sink2, sink2, sink2, sink2};
            if (nb > 0) {
#pragma unroll
                for (int t = 0; t < NT - 1; ++t)
#pragma unroll
                    for (int r = 0; r < 4; ++r) {
                        float xv = __builtin_fmaf(st[t][r], C2, bsr[SWA ? t : 0][r]);
                        if (t == 0) xv = (d0 - r < 128) ? xv : -INFINITY;
                        if (t == NT - 2) xv = (d0 - 16 * t - r >= 0) ? xv : -INFINITY;
                        st[t][r] = xv; m4[r] = fmaxf(m4[r], xv);
                    }
            } else {
#pragma unroll
                for (int t = 0; t < NT - 1; ++t)
#pragma unroll
                    for (int r = 0; r < 4; ++r) {
                        const unsigned dist = (unsigned)(d0 - 16 * t - r);
                        const float xv = (dist < lim) ? __builtin_fmaf(st[t][r], C2, bsr[SWA ? t : 0][r]) : -INFINITY;
                        st[t][r] = xv; m4[r] = fmaxf(m4[r], xv);
                    }
            }
            mx2 = fmaxf(fmaxf(m4[0], m4[1]), fmaxf(m4[2], m4[3]));
            mx2 = xmax16(mx2); mx2 = xmax32(mx2);
            float s4[4] = {0.f, 0.f, 0.f, 0.f};
#pragma unroll
            for (int t = 0; t < NT - 1; ++t)
#pragma unroll
                for (int r = 0; r < 4; ++r) { const float p = __builtin_amdgcn_exp2f(st[t][r] - mx2); st[t][r] = p; s4[r] += p; }
            st[NT - 1] = (f32x4){0.f, 0.f, 0.f, 0.f};
            sum = (s4[0] + s4[1]) + (s4[2] + s4[3]);
            sum = xsum16(sum); sum = xsum32(sum);
            sum += __builtin_amdgcn_exp2f(sink2 - mx2);
        } else {
            float m4[4] = {st[0][0], st[0][1], st[0][2], st[0][3]};
#pragma unroll
            for (int t = 1; t < NT; ++t)
#pragma unroll
                for (int r = 0; r < 4; ++r) m4[r] = fmaxf(m4[r], st[t][r]);
            float mr = fmaxf(fmaxf(m4[0], m4[1]), fmaxf(m4[2], m4[3]));
            mr = xmax16(mr); mr = xmax32(mr);
            const float nm = -mr * C2;
            float s4[4] = {0.f, 0.f, 0.f, 0.f};
#pragma unroll
            for (int t = 0; t < NT; ++t)
#pragma unroll
                for (int r = 0; r < 4; ++r) { const float p = __builtin_amdgcn_exp2f(__builtin_fmaf(st[t][r], C2, nm)); st[t][r] = p; s4[r] += p; }
            sum = (s4[0] + s4[1]) + (s4[2] + s4[3]);
            sum = xsum16(sum); sum = xsum32(sum);
        }
        const float inv = frcp(sum);
        f32x4 o[4];
#pragma unroll
        for (int n = 0; n < 4; ++n) o[n] = (f32x4){0.f, 0.f, 0.f, 0.f};
#pragma unroll
        for (int s = 0; s < NT / 2; ++s) {
            const f32x4 pa = st[2 * s] * inv, pb = st[2 * s + 1] * inv;
            const bf16x8 pfrag = mk8(pk2(pa[0], pa[1]), pk2(pa[2], pa[3]), pk2(pb[0], pb[1]), pk2(pb[2], pb[3]));
            const int ta = SWA ? min(t0 + 2 * s, 15) : 2 * s, tb2 = SWA ? min(t0 + 2 * s + 1, 15) : 2 * s + 1;
#pragma unroll
            for (int n = 0; n < 4; ++n) {
                const s16x4 lo = ld_tr(vbase + (16 * ta) * 144 + n * 32), hi = ld_tr(vbase + (16 * tb2) * 144 + n * 32);
                const bf16x8 vf = {lo[0], lo[1], lo[2], lo[3], hi[0], hi[1], hi[2], hi[3]};
                o[n] = __builtin_amdgcn_mfma_f32_16x16x32_bf16(pfrag, vf, o[n], 0, 0, 0);
            }
        }
        LAS unsigned char* ost = lds + AT_OOFF + wave * 2304;
#pragma unroll
        for (int r = 0; r < 4; ++r)
#pragma unroll
            for (int n = 0; n < 4; n += 2) { const unsigned w = (unsigned)__builtin_amdgcn_cvt_pk_fp8_f32(o[n][r], o[n + 1][r], 0, false);
                *(LAS unsigned char*)(ost + (4 * g + r) * 80 + 16 * n + tk) = (unsigned char)(w & 0xffu); *(LAS unsigned char*)(ost + (4 * g + r) * 80 + 16 * (n + 1) + tk) = (unsigned char)((w >> 8) & 0xffu); }
        { const int orow = lane >> 2, part = lane & 3;
            const u32x4 w = *(const LAS u32x4*)(ost + orow * 80 + part * 16);
            *(u32x4*)((unsigned char*)C.mix + (size_t)(qrow + orow) * MIXW + ocol + part * 16) = w; }
    }
    return nxt_it;
}

template <bool PB>
__device__ __forceinline__ int hgrn_item(const Ctx& C, LAS unsigned char* lds, int wv, int l, int witem, int lane, unsigned* qhead) {
    int nxt_it = -1;
    LAS unsigned char* scr = lds + wv * 4608;
    const int tk = lane & 15, g = lane >> 4;
    const int bh = witem / NSEG, seg = witem % NSEG, b = bh >> 2, h = bh & 3;
    const size_t rowbase = (size_t)b * SEQ + (size_t)seg * CPS * 16;
    unsigned nzf[4], nvi[4];
    { const unsigned char* pr = (const unsigned char*)C.proj + (rowbase + tk) * INW + h * 64 + 4 * g;
#pragma unroll
        for (int c = 0; c < 4; ++c) { nzf[c] = *(const unsigned*)(pr + C_HF + 16 * c); nvi[c] = *(const unsigned*)(pr + C_HI + 16 * c); } }
    float oml[4][4];
    {
        f32x4 lbv[4];
#pragma unroll
        for (int c = 0; c < 4; ++c) lbv[c] = *(const f32x4*)(C.lbtab + l * 256 + h * 64 + 16 * c + 4 * g);
        asm volatile("" : "+v"(lbv[0]), "+v"(lbv[1]), "+v"(lbv[2]), "+v"(lbv[3]));
#pragma unroll
        for (int c = 0; c < 4; ++c)
#pragma unroll
            for (int i = 0; i < 4; ++i) oml[c][i] = 1.f - lbv[c][i];
    }
    f32x4 S[4][4];
#pragma unroll
    for (int mt = 0; mt < 4; ++mt)
#pragma unroll
        for (int n = 0; n < 4; ++n) S[mt][n] = (f32x4){0.f, 0.f, 0.f, 0.f};
    float dseg[4][4];
#pragma unroll
    for (int c = 0; c < 4; ++c)
#pragma unroll
        for (int i = 0; i < 4; ++i) dseg[c][i] = 1.f;
    float nw[4][4];
    if (PB) {
#pragma unroll
        for (int c = 0; c < 4; ++c)
#pragma unroll
            for (int i = 0; i < 4; ++i) nw[c][i] = C.hnorm[l * 64 + 16 * c + 4 * g + i] * 0.125f;
    }
    if (PB) {
        if (lane == 0 && wv == 0) {
            unsigned* cnt = C.ctl + CW_HA + (l * 32 + bh) * 64; unsigned sp = 0;
            while (__hip_atomic_load(cnt, __ATOMIC_RELAXED, __HIP_MEMORY_SCOPE_AGENT) < (unsigned)(NSEG / NWAVES)) { __builtin_amdgcn_s_sleep(2); if (++sp > (1u << 24)) break; }
            __builtin_amdgcn_fence(__ATOMIC_ACQUIRE, "agent");
            asm volatile("s_waitcnt vmcnt(0)" ::: "memory");
        }
    }
    if (PB) {
        LAS float* pl = (LAS float*)lds;
        const int seg0 = seg - wv;
        __syncthreads();
        {
            const float* base = C.hst + (size_t)bh * NSEG * 80 * 64 + lane;
            const int q0 = wv * 8, dq0 = 64 + (wv >> 1) * 4;
            float Sx[8];
#pragma unroll
            for (int qq = 0; qq < 8; ++qq) Sx[qq] = 0.f;
#pragma unroll 1
            for (int j0 = 0; j0 < seg0; j0 += 8) {
                float dv[4][8], sv[8][8];
#pragma unroll
                for (int j = 0; j < 8; ++j) {
#pragma unroll
                    for (int r = 0; r < 4; ++r) dv[r][j] = base[((size_t)(j0 + j) * 80 + dq0 + r) * 64];
#pragma unroll
                    for (int qq = 0; qq < 8; ++qq) sv[qq][j] = base[((size_t)(j0 + j) * 80 + q0 + qq) * 64]; }
#pragma unroll
                for (int qq = 0; qq < 8; ++qq)
#pragma unroll
                    for (int j = 0; j < 8; ++j) Sx[qq] = Sx[qq] * dv[qq & 3][j] + sv[qq][j];
            }
            float dv[4][8], sv[8][8];
#pragma unroll
            for (int j = 0; j < 8; ++j) {
#pragma unroll
                for (int r = 0; r < 4; ++r) dv[r][j] = base[((size_t)(seg0 + j) * 80 + dq0 + r) * 64];
#pragma unroll
                for (int qq = 0; qq < 8; ++qq) sv[qq][j] = base[((size_t)(seg0 + j) * 80 + q0 + qq) * 64]; }
#pragma unroll
            for (int qq = 0; qq < 8; ++qq)
#pragma unroll
                for (int j = 0; j < 8; ++j) { pl[(j * 64 + q0 + qq) * 64 + lane] = Sx[qq]; Sx[qq] = Sx[qq] * dv[qq & 3][j] + sv[qq][j]; }
        }
        __syncthreads();
#pragma unroll
        for (int mt = 0; mt < 4; ++mt)
#pragma unroll
            for (int n = 0; n < 4; ++n)
#pragma unroll
                for (int r = 0; r < 4; ++r) S[mt][n][r] = pl[(wv * 64 + (mt * 4 + n) * 4 + r) * 64 + lane];
        __syncthreads();
    }
    LAS unsigned char* sk = scr; LAS unsigned char* sv = scr + 2304;
    const LAS unsigned char* trk = sk + (4 * g + (tk >> 2)) * 144 + (tk & 3) * 8;
    const LAS unsigned char* trv = sv + (4 * g + (tk >> 2)) * 144 + (tk & 3) * 8;
#pragma unroll 1
    for (int ch = 0; ch < CPS; ++ch) {
        if (ch == CPS - 1 && lane == 0 && wv == 0) nxt_it = (int)__hip_atomic_fetch_add(qhead, 1u, __ATOMIC_RELAXED, __HIP_MEMORY_SCOPE_AGENT) + (int)gridDim.x;
        const size_t row = rowbase + ch * 16 + tk;
        unsigned zf_[4], vi_[4], zq_[4], gt_[4];
#pragma unroll
        for (int c = 0; c < 4; ++c) { zf_[c] = nzf[c]; vi_[c] = nvi[c]; }
        if (PB) { const unsigned char* pr = (const unsigned char*)C.proj + row * INW + h * 64 + 4 * g;
#pragma unroll
            for (int c = 0; c < 4; ++c) { zq_[c] = *(const unsigned*)(pr + C_HQ + 16 * c); gt_[c] = *(const unsigned*)(pr + C_HG + 16 * c); } }
        { const unsigned char* pr = (const unsigned char*)C.proj + (rowbase + (ch < CPS - 1 ? ch + 1 : ch) * 16 + tk) * INW + h * 64 + 4 * g;
#pragma unroll
            for (int c = 0; c < 4; ++c) { nzf[c] = *(const unsigned*)(pr + C_HF + 16 * c); nvi[c] = *(const unsigned*)(pr + C_HI + 16 * c); } }
        float kk[4][4], bcs[4][4], dreg[4][4];
#pragma unroll
        for (int c = 0; c < 4; ++c) { const f32x4 zf4 = dec_fp8x4(zf_[c]) * (0.125f * 1.44269504f);
#pragma unroll
            for (int i = 0; i < 4; ++i) {
                const float sneg = frcp(1.f + __builtin_amdgcn_exp2f(zf4[i]));
                kk[c][i] = oml[c][i] * sneg;
                bcs[c][i] = __builtin_fmaf(-oml[c][i], sneg, 1.f);
            }
            row_scanmul16x4(bcs[c][0], bcs[c][1], bcs[c][2], bcs[c][3]);
        }
#pragma unroll
        for (int c = 0; c < 4; ++c)
#pragma unroll
            for (int i = 0; i < 4; ++i) dreg[c][i] = DPPF(bcs[c][i], 0x15F);
        unsigned kop_[4][2];
#pragma unroll
        for (int c = 0; c < 4; ++c) {
            const float e0 = kk[c][0] * frcp(bcs[c][0]), e1 = kk[c][1] * frcp(bcs[c][1]), e2 = kk[c][2] * frcp(bcs[c][2]), e3 = kk[c][3] * frcp(bcs[c][3]);
            kop_[c][0] = pk2(e0, e1); kop_[c][1] = pk2(e2, e3);
            u32x2 w; w.x = kop_[c][0]; w.y = kop_[c][1];
            *(LAS u32x2*)(sk + tk * 144 + (16 * c + 4 * g) * 2) = w;
            { const f32x4 vv = dec_fp8x4(vi_[c]); u32x2 wv;     wv.x = pk2(vv.x, vv.y); wv.y = pk2(vv.z, vv.w); *(LAS u32x2*)(sv + tk * 144 + (16 * c + 4 * g) * 2) = wv; }
        }
        s16x4 kT[4], vT[4];
#pragma unroll
        for (int m = 0; m < 4; ++m) { kT[m] = ld_tr(trk + m * 32); vT[m] = ld_tr(trv + m * 32); }
        f32x4 o[4];
        if (PB) {
            unsigned qop_[4][2];
#pragma unroll
            for (int c = 0; c < 4; ++c) {
                float qv[4]; const f32x4 zq8 = dec_fp8x4(zq_[c]);
#pragma unroll
                for (int i = 0; i < 4; ++i)
                    qv[i] = (zq8[i] * 0.015625f) * frcp(1.f + __builtin_amdgcn_exp2f(zq8[i] * (-0.125f * 1.44269504f))) * bcs[c][i];
                qop_[c][0] = pk2(qv[0], qv[1]); qop_[c][1] = pk2(qv[2], qv[3]);
            }
            const bf16x8 qa = mk8(qop_[0][0], qop_[0][1], qop_[1][0], qop_[1][1]), qb2 = mk8(qop_[2][0], qop_[2][1], qop_[3][0], qop_[3][1]);
            const bf16x8 ka = mk8(kop_[0][0], kop_[0][1], kop_[1][0], kop_[1][1]), kb2 = mk8(kop_[2][0], kop_[2][1], kop_[3][0], kop_[3][1]);
            f32x4 sT = {0.f, 0.f, 0.f, 0.f};
            sT = __builtin_amdgcn_mfma_f32_16x16x32_bf16(ka, qa, sT, 0, 0, 0);
            sT = __builtin_amdgcn_mfma_f32_16x16x32_bf16(kb2, qb2, sT, 0, 0, 0);
#pragma unroll
            for (int r = 0; r < 4; ++r) if (4 * g + r > tk) sT[r] = 0.f;
            const s16x4 sT4 = mk4(pk2(sT[0], sT[1]), pk2(sT[2], sT[3]));
#pragma unroll
            for (int n = 0; n < 4; ++n) {
                f32x4 a = {0.f, 0.f, 0.f, 0.f};
                a = __builtin_amdgcn_mfma_f32_16x16x16bf16_1k(vT[n], sT4, a, 0, 0, 0);
                const bf16x8 s0 = mk8(pk2(S[0][n][0], S[0][n][1]), pk2(S[0][n][2], S[0][n][3]), pk2(S[1][n][0], S[1][n][1]), pk2(S[1][n][2], S[1][n][3]));
                const bf16x8 s1 = mk8(pk2(S[2][n][0], S[2][n][1]), pk2(S[2][n][2], S[2][n][3]), pk2(S[3][n][0], S[3][n][1]), pk2(S[3][n][2], S[3][n][3]));
                f32x4 a2 = {0.f, 0.f, 0.f, 0.f};
                a2 = __builtin_amdgcn_mfma_f32_16x16x32_bf16(s0, qa, a2, 0, 0, 0);
                a2 = __builtin_amdgcn_mfma_f32_16x16x32_bf16(s1, qb2, a2, 0, 0, 0);
                o[n] = a + a2;
            }
        }
#pragma unroll
        for (int mt = 0; mt < 4; ++mt)
#pragma unroll
            for (int n = 0; n < 4; ++n) {
                f32x4 a = __builtin_amdgcn_mfma_f32_16x16x16bf16_1k(kT[mt], vT[n], S[mt][n], 0, 0, 0);
#pragma unroll
                for (int r = 0; r < 4; ++r) a[r] *= dreg[mt][r];
                S[mt][n] = a;
            }
        if (PB) {
            float ss = 0.f;
#pragma unroll
            for (int n = 0; n < 4; ++n)
#pragma unroll
                for (int r = 0; r < 4; ++r) ss += o[n][r] * o[n][r];
            ss = xsum16(ss); ss = xsum32(ss);
            const float rinv = __builtin_amdgcn_rsqf(ss * (1.f / 4096.f) + RMS_EPS);
            unsigned char* op = (unsigned char*)C.mix + row * MIXW + 512 + h * 64 + 4 * g;
#pragma unroll
            for (int n = 0; n < 4; ++n) {
                float ov[4]; const f32x4 gz8 = dec_fp8x4(gt_[n]);
#pragma unroll
                for (int r = 0; r < 4; ++r)
                    ov[r] = __builtin_amdgcn_fmed3f(o[n][r] * rinv * nw[n][r] * (gz8[r] * frcp(1.f + __builtin_amdgcn_exp2f(gz8[r] * (-0.125f * 1.44269504f)))), -448.f, 448.f);
                *(unsigned*)(op + 16 * n) = pk_fp8x4((f32x4){ov[0], ov[1], ov[2], ov[3]});
            }
        } else {
#pragma unroll
            for (int c = 0; c < 4; ++c)
#pragma unroll
                for (int i = 0; i < 4; ++i) dseg[c][i] *= dreg[c][i];
        }
    }
    if (!PB) {
        float* sl = C.hst + ((size_t)witem * 80) * 64 + lane;
#pragma unroll
        for (int mt = 0; mt < 4; ++mt)
#pragma unroll
            for (int n = 0; n < 4; ++n)
#pragma unroll
                for (int r = 0; r < 4; ++r) __hip_atomic_store(sl + ((mt * 4 + n) * 4 + r) * 64, S[mt][n][r], __ATOMIC_RELAXED, __HIP_MEMORY_SCOPE_AGENT);
#pragma unroll
        for (int c = 0; c < 4; ++c)
#pragma unroll
            for (int i = 0; i < 4; ++i) __hip_atomic_store(sl + (64 + c * 4 + i) * 64, dseg[c][i], __ATOMIC_RELAXED, __HIP_MEMORY_SCOPE_AGENT);
        asm volatile("s_waitcnt vmcnt(0)" ::: "memory");
        __syncthreads();
        if (lane == 0 && wv == 0) __hip_atomic_fetch_add(C.ctl + CW_HA + (l * 32 + bh) * 64, 1u, __ATOMIC_RELAXED, __HIP_MEMORY_SCOPE_AGENT);
    }
    return nxt_it;
}

__device__ __forceinline__ void mixer_phase(const Ctx& C, LAS unsigned char* lds, int l, int tid, int wave, int lane) {
    constexpr int NH = 32 * NSEG / NWAVES;
    constexpr int N_MEM = NB * 4 * 8, N_SWA = NB * 32 * 2;
    unsigned* head = C.ctl + CW_QUEUE + l * 64;
    volatile LAS int* slot = (volatile LAS int*)(lds + LDSCTL_OFF + 256);
    const int NCVL = (l + 1 < DEPTH) ? P0_NCV : (P0_NLD - 1024) / P0_TPI;
    const int NMK = (l == 0) ? 64 : 0;
    int pre = (int)blockIdx.x;
    int par = 0;
    for (;;) {
        if (tid == 0) slot[par] = (pre >= 0) ? pre : (int)__hip_atomic_fetch_add(head, 1u, __ATOMIC_RELAXED, __HIP_MEMORY_SCOPE_AGENT) + C.G;
        __syncthreads();
        int it = __builtin_amdgcn_readfirstlane(slot[par]); par ^= 1;
        if (it >= NMK + 2 * NH + N_MEM + N_SWA + NCVL) break;
        int lane_i = lane; asm volatile("" : "+v"(lane_i));
        if (it < NMK) {
            DenseSched S; S.A0 = nullptr; S.B0 = nullptr; S.nM0 = 0; S.nN0 = 0; S.K0 = DM; S.A1 = (const char*)C.memb; S.B1 = (const char*)C.Wmem; S.nM1 = (NB * MEMLEN) / 256; S.nN1 = 2048 / 256; S.G = C.G; S.c = 0; S.one = it;
            EpiProj E{(unsigned char*)C.proj, (const LAS float*)(lds + pg8::NXT_SLOT_OFF), (unsigned char*)C.memkv};
            pg8::gemm_phase<EpiProj, DenseSched, true>(lds, wave * 64 + lane_i, DM, S, E);
            asm volatile("s_waitcnt vmcnt(0)" ::: "memory");
            __syncthreads();
            if (tid == 0) { __builtin_amdgcn_fence(__ATOMIC_RELEASE, "agent"); asm volatile("s_waitcnt vmcnt(0)" ::: "memory"); __hip_atomic_fetch_add(C.ctl + CW_MKV, 1u, __ATOMIC_RELAXED, __HIP_MEMORY_SCOPE_AGENT); }
            pre = -1; continue;
        }
        it -= NMK;
        if (it < NH) { pre = hgrn_item<false>(C, lds, wave, l, it * NWAVES + wave, lane_i, head); continue; } it -= NH;
        if (it < N_SWA / 2) { pre = attn_item<true>(C, lds, l, it, wave * 64 + lane_i, wave, lane_i, head); continue; } it -= N_SWA / 2;
        if (it < NH) { pre = hgrn_item<true>(C, lds, wave, l, it * NWAVES + wave, lane_i, head); continue; } it -= NH;
        if (it < 3 * (NCVL >> 1)) {
            const int grp = it / 3, sub = it - 3 * grp;
            if (sub != 0) {
                int nx = -1; if (tid == 0) nx = (int)__hip_atomic_fetch_add(head, 1u, __ATOMIC_RELAXED, __HIP_MEMORY_SCOPE_AGENT) + C.G;
                const int cv = grp * 2 + sub - 1;
                p0_convert(C, lds, wave, lane_i, l, cv * P0_TPI + wave, (cv + 1) * P0_TPI, NWAVES);
                pre = nx; continue;
            }
            it = grp;
        } else it -= NCVL;
        if (it < N_SWA / 2) { pre = attn_item<true>(C, lds, l, it + N_SWA / 2, wave * 64 + lane_i, wave, lane_i, head); continue; } it -= N_SWA / 2;
        if (l == 0 && tid == 0) {
            unsigned sp = 0; while (__hip_atomic_load(C.ctl + CW_MKV, __ATOMIC_RELAXED, __HIP_MEMORY_SCOPE_AGENT) < 64u) { __builtin_amdgcn_s_sleep(2); if (++sp > (1u << 24)) break; }
            __builtin_amdgcn_fence(__ATOMIC_ACQUIRE, "agent"); asm volatile("s_waitcnt vmcnt(0)" ::: "memory");
        }
        pre = attn_item<false>(C, lds, l, it, wave * 64 + lane_i, wave, lane_i, head);
    }
}

__device__ __forceinline__ float reduce_scatter16(const float (&p)[16], int lane) {
    const bool h5 = (lane & 32) != 0, h4 = (lane & 16) != 0, h3 = (lane & 8) != 0, h2 = (lane & 4) != 0;
    float q8[8], q4[4], q2[2];
#pragma unroll
    for (int i = 0; i < 8; ++i) { const float snd = h5 ? p[i] : p[i + 8], kp = h5 ? p[i + 8] : p[i]; q8[i] = kp + __shfl_xor(snd, 32); }
#pragma unroll
    for (int i = 0; i < 4; ++i) { const float snd = h4 ? q8[i] : q8[i + 4], kp = h4 ? q8[i + 4] : q8[i]; q4[i] = kp + __shfl_xor(snd, 16); }
#pragma unroll
    for (int i = 0; i < 2; ++i) { const float snd = h3 ? q4[i] : q4[i + 2], kp = h3 ? q4[i + 2] : q4[i]; q2[i] = kp + DPPF(snd, 0x128); }
    float q1; { const float snd = h2 ? q2[0] : q2[1], kp = h2 ? q2[1] : q2[0]; q1 = kp + __shfl_xor(snd, 4); }
    q1 += DPPF(q1, 0x4E); q1 += DPPF(q1, 0xB1);
    return q1;
}
__device__ __forceinline__ float reduce_scatter4(const float (&p)[4]) {
    const u32x2 r0 = __builtin_amdgcn_permlane32_swap(__float_as_uint(p[0]), __float_as_uint(p[2]), false, false), r1 = __builtin_amdgcn_permlane32_swap(__float_as_uint(p[1]), __float_as_uint(p[3]), false, false);
    const float a = __uint_as_float(r0.x) + __uint_as_float(r0.y), b = __uint_as_float(r1.x) + __uint_as_float(r1.y);
    const u32x2 r2 = __builtin_amdgcn_permlane16_swap(__float_as_uint(a), __float_as_uint(b), false, false);
    float q1 = __uint_as_float(r2.x) + __uint_as_float(r2.y);
    q1 += DPPF(q1, 0xB1); q1 += DPPF(q1, 0x4E); q1 += DPPF(q1, 0x141); q1 += DPPF(q1, 0x140);
    return q1;
}
__device__ __forceinline__ int rs4_index() {
    const u32x2 r0 = __builtin_amdgcn_permlane32_swap(0u, 2u, false, false), r1 = __builtin_amdgcn_permlane32_swap(1u, 3u, false, false);
    const u32x2 r2 = __builtin_amdgcn_permlane16_swap(r0.x, r1.x, false, false);
    return (int)r2.x;
}
__device__ __forceinline__ float reduce_scatter8(const float (&p)[8], int lane) {
    const bool h5 = (lane & 32) != 0, h4 = (lane & 16) != 0, h3 = (lane & 8) != 0;
    float q4[4], q2[2];
#pragma unroll
    for (int i = 0; i < 4; ++i) { const float snd = h5 ? p[i] : p[i + 4], kp = h5 ? p[i + 4] : p[i]; q4[i] = kp + __shfl_xor(snd, 32); }
#pragma unroll
    for (int i = 0; i < 2; ++i) { const float snd = h4 ? q4[i] : q4[i + 2], kp = h4 ? q4[i + 2] : q4[i]; q2[i] = kp + __shfl_xor(snd, 16); }
    float q1; { const float snd = h3 ? q2[0] : q2[1], kp = h3 ? q2[1] : q2[0]; q1 = kp + DPPF(snd, 0x128); }
    q1 += DPPF(q1, 0xB1); q1 += DPPF(q1, 0x4E); q1 += DPPF(q1, 0x141);
    return q1;
}
__device__ __forceinline__ void route_rows16(const LAS float* lg, const float (&rb)[16], LAS unsigned* dec16, int lane) {
    const int r = lane & 15;
    float sel[16], sc[16];
#pragma unroll
    for (int q = 0; q < 4; ++q) { const f32x4 v = *(const LAS f32x4*)(lg + r * 16 + 4 * q);
        sc[4 * q] = frcp(1.f + __expf(-v.x)); sc[4 * q + 1] = frcp(1.f + __expf(-v.y)); sc[4 * q + 2] = frcp(1.f + __expf(-v.z)); sc[4 * q + 3] = frcp(1.f + __expf(-v.w)); }
#pragma unroll
    for (int e = 0; e < 16; ++e) sel[e] = sc[e] + rb[e];
    float bestv = -INFINITY, w1 = 0.f, w2 = 0.f; int e1 = 0, e2 = 1;
#pragma unroll
    for (int gi = 0; gi < 4; ++gi) {
        float m1 = sel[4 * gi], s1 = sc[4 * gi]; int i1 = 0;
#pragma unroll
        for (int i = 1; i < 4; ++i) if (sel[4 * gi + i] > m1) { m1 = sel[4 * gi + i]; s1 = sc[4 * gi + i]; i1 = i; }
        float m2 = -INFINITY, s2v = 0.f; int i2 = 0;
#pragma unroll
        for (int i = 0; i < 4; ++i) if (i != i1 && sel[4 * gi + i] > m2) { m2 = sel[4 * gi + i]; s2v = sc[4 * gi + i]; i2 = i; }
        const float gs = m1 + m2;
        if (gs > bestv) { bestv = gs; e1 = 4 * gi + i1; e2 = 4 * gi + i2; w1 = s1; w2 = s2v; }
    }
    const float wn = 1.f / (w1 + w2);
    if (lane < 16) { u32x4 d; d.x = (unsigned)e1; d.y = (unsigned)e2; d.z = __float_as_uint(w1 * wn); d.w = __float_as_uint(w2 * wn); *(LAS u32x4*)(dec16 + r * 4) = d; }
}
__device__ __forceinline__ void ln_row(const unsigned (&h)[4], const u32x2 (&x)[4], const f32x4 (&gv)[4], const f32x4 (&bv)[4], f32x4 (&v)[4]) {
    float s = 0.f, s2 = 0.f;
#pragma unroll
    for (int j = 0; j < 4; ++j) { v[j] = dec_fp8x4(x[j].x) * (0.125f * ALPHA) + dec_fp8x4(x[j].y) * (0.0078125f * ALPHA) + dec_fp8x4(h[j]) * 0.015625f;
        s += (v[j].x + v[j].y) + (v[j].z + v[j].w); s2 += (v[j].x * v[j].x + v[j].y * v[j].y) + (v[j].z * v[j].z + v[j].w * v[j].w); }
    const float mean = wave_sum(s) * (1.f / DM), ex2 = wave_sum(s2) * (1.f / DM);
    const float rstd = __builtin_amdgcn_rsqf(fmaxf(ex2 - mean * mean, 0.f) + LN_EPS);
    const float rstd8 = rstd * 8.f;
#pragma unroll
    for (int j = 0; j < 4; ++j) { const f32x4 rg = gv[j] * rstd8; v[j] = v[j] * rg + (bv[j] - rg * mean); }
}
__device__ __forceinline__ void p4_stage_router(const Ctx& C, LAS unsigned char* lds, int tid) {
    LAS float* wr = (LAS float*)lds; constexpr int WRP = DM + 4;
    float wv_[DM * NE / NTHR];
#pragma unroll
    for (int k = 0; k < DM * NE / NTHR; ++k) wv_[k] = C.w_router[tid + NTHR * k];
#pragma unroll
    for (int k = 0; k < DM * NE / NTHR; ++k) { const int i = tid + NTHR * k, d = i >> 4, e = i & 15; wr[e * WRP + d] = wv_[k] * 0.125f; }
}
__device__ __forceinline__ void p4_ln_route(const Ctx& C, LAS unsigned char* lds, int l, int tid, int wave, int lane, bool staged) {
    LAS float* wr = (LAS float*)lds;
    constexpr int WRP = DM + 4;
    LAS unsigned* dec = (LAS unsigned*)(lds + 66048);
    LAS unsigned* posb = (LAS unsigned*)(lds + 66048 + 2048);
    LAS float* lgw = (LAS float*)(lds + 66048 + 4096) + wave * 256;
    float wv_[DM * NE / NTHR];
    if (!staged) {
#pragma unroll
        for (int k = 0; k < DM * NE / NTHR; ++k) wv_[k] = C.w_router[tid + NTHR * k];
    }
    f32x4 gv[4], bv[4];
#pragma unroll
    for (int j = 0; j < 4; ++j) { gv[j] = *((const f32x4*)(C.ln1g + l * DM) + lane + 64 * j); bv[j] = *((const f32x4*)(C.ln1b + l * DM) + lane + 64 * j) * 8.f; }
    unsigned* cntl = C.ctl + CW_CNT + (l + C.rep * DEPTH) * 16 * 64;
    const unsigned char* hp8 = (const unsigned char*)C.hpre; unsigned char* xlo = (unsigned char*)C.xb;
#define P4_LOAD4(H, X, R0) do { _Pragma("unroll") for (int r_ = 0; r_ < 4; ++r_) { const size_t rr_ = (R0) + r_; _Pragma("unroll") for (int j = 0; j < 4; ++j) { \
            H[r_][j] = ((const unsigned*)(hp8 + rr_ * DM) + lane)[64 * j]; X[r_][j].x = ((const unsigned*)(C.xb8 + rr_ * DM) + lane)[64 * j]; X[r_][j].y = ((const unsigned*)(xlo + rr_ * DM) + lane)[64 * j]; } } } while (0)
    unsigned hA[4][4]; u32x2 xA[4][4];
    if (C.vcu < NTOK / 128) P4_LOAD4(hA, xA, (size_t)C.vcu * 128 + wave * 16);
    if (!staged) {
#pragma unroll
        for (int k = 0; k < DM * NE / NTHR; ++k) { const int i = tid + NTHR * k, d = i >> 4, e = i & 15; wr[e * WRP + d] = wv_[k] * 0.125f; }
    }
    __syncthreads();
    for (int blk = C.vcu; blk < NTOK / 128; blk += C.G) {
        const size_t rowb = (size_t)blk * 128 + wave * 16;
        const int rs4 = rs4_index();
        if (blk != C.vcu) P4_LOAD4(hA, xA, rowb);
#pragma unroll 1
        for (int st = 0; st < 4; ++st) {
            const size_t row = rowb + 4 * st;
            unsigned hN[4][4]; u32x2 xN[4][4];
            if (st < 3) P4_LOAD4(hN, xN, row + 4);
            f32x4 v[4][4];
#pragma unroll
            for (int r = 0; r < 4; ++r) {
                ln_row(hA[r], xA[r], gv, bv, v[r]);
                unsigned* xl = (unsigned*)(xlo + (row + r) * DM) + lane; unsigned* x8 = (unsigned*)(C.xb8 + (row + r) * DM) + lane;
#pragma unroll
                for (int j = 0; j < 4; ++j) { unsigned hi, lo; split_fp8_pre8(v[r][j], hi, lo); __hip_atomic_store(x8 + 64 * j, hi, __ATOMIC_RELAXED, __HIP_MEMORY_SCOPE_AGENT); __hip_atomic_store(xl + 64 * j, lo, __ATOMIC_RELAXED, __HIP_MEMORY_SCOPE_AGENT); }
            }
#pragma unroll
            for (int eh = 0; eh < 4; ++eh) {
                float p[4][4];
#pragma unroll
                for (int e8 = 0; e8 < 4; ++e8) {
                    f32x4 w[4];
#pragma unroll
                    for (int j = 0; j < 4; ++j) w[j] = *((const LAS f32x4*)(wr + (4 * eh + e8) * WRP) + lane + 64 * j);
#pragma unroll
                    for (int r = 0; r < 4; ++r) { f32x2 a = {0.f, 0.f};
#pragma unroll
                        for (int j = 0; j < 4; ++j) { a = __builtin_elementwise_fma((f32x2){v[r][j].x, v[r][j].y}, (f32x2){w[j].x, w[j].y}, a); a = __builtin_elementwise_fma((f32x2){v[r][j].z, v[r][j].w}, (f32x2){w[j].z, w[j].w}, a); }
                        p[r][e8] = a.x + a.y; }
                }
#pragma unroll
                for (int r = 0; r < 4; ++r) { const float q = reduce_scatter4(p[r]);
                    if ((lane & 15) == 0) lgw[(4 * st + r) * 16 + 4 * eh + rs4] = q; }
                __builtin_amdgcn_sched_barrier(0);
            }
#pragma unroll
            for (int r = 0; r < 4; ++r)
#pragma unroll
                for (int j = 0; j < 4; ++j) { hA[r][j] = hN[r][j]; xA[r][j] = xN[r][j]; }
        }
#undef P4_LOAD4
        float rb[16];
#pragma unroll
        for (int e = 0; e < 16; ++e) rb[e] = C.rbias[e];
        route_rows16(lgw, rb, dec + wave * 16 * 4, lane);
        __syncthreads();
        if (wave == 0) {
            unsigned ea[4], rk[4]; unsigned tot = 0;
#pragma unroll
            for (int i = 0; i < 4; ++i) { const int a = lane + 64 * i; ea[i] = dec[(a >> 1) * 4 + (a & 1)]; rk[i] = 0; }
#pragma unroll
            for (int e = 0; e < 16; ++e) {
                unsigned run = 0;
#pragma unroll
                for (int i = 0; i < 4; ++i) { const unsigned long long m = __ballot(ea[i] == (unsigned)e);
                    const unsigned below = __builtin_amdgcn_mbcnt_hi((unsigned)(m >> 32), __builtin_amdgcn_mbcnt_lo((unsigned)m, 0u));
                    if (ea[i] == (unsigned)e) rk[i] = run + below;
                    run += (unsigned)__popcll(m); }
                if (lane == e) tot = run;
            }
            unsigned base = 0;
            if (lane < 16) base = tot ? atomicAdd(cntl + 64 * lane, tot) : 0u;
#pragma unroll
            for (int i = 0; i < 4; ++i) { const unsigned bs = __shfl(base, (int)ea[i]); const unsigned pos = bs + rk[i]; const int a = lane + 64 * i;
                posb[a] = pos; C.list[(size_t)ea[i] * LCAP + pos] = blk * 128 + (a >> 1); }
        }
        __syncthreads();
        if (tid < 128) { u32x4 rec; rec.x = (dec[tid * 4] << 16) | posb[tid * 2]; rec.y = (dec[tid * 4 + 1] << 16) | posb[tid * 2 + 1]; rec.z = dec[tid * 4 + 2]; rec.w = dec[tid * 4 + 3];
            C.tokrec[(size_t)blk * 128 + tid] = rec; }
        __syncthreads();
    }
}

__device__ __forceinline__ void moe_prefix(const Ctx& C, LAS int* tb, int l, int tid) {
    if (tid < 16) tb[17 + tid] = (int)__hip_atomic_load(C.ctl + CW_CNT + l * 16 * 64 + 64 * tid, __ATOMIC_RELAXED, __HIP_MEMORY_SCOPE_AGENT);
    if (tid == 0) {
        int acc = 0;
#pragma unroll
        for (int e = 0; e < 16; ++e) { const int c = tb[17 + e]; tb[e] = acc; acc += (c + 255) >> 8; }
        tb[16] = acc;
    }
    __syncthreads();
}

__device__ __forceinline__ void p7_combine(const Ctx& C, LAS unsigned char* lds, int l, int tid, int wave, int lane, bool have_tb) {
    LAS int* tb = (LAS int*)(lds + LDSCTL_OFF + 64);
    const int r00 = (C.vcu * NWAVES + wave) * 16;
    u32x4 rec0 = C.tokrec[min(r00, NTOK - 16) + (lane & 15)];
    f32x4 gv[4], bv[4];
#pragma unroll
    for (int j = 0; j < 4; ++j) { gv[j] = *((const f32x4*)(C.ln2g + l * DM) + lane + 64 * j); bv[j] = *((const f32x4*)(C.ln2b + l * DM) + lane + 64 * j); }
    if (!have_tb) moe_prefix(C, tb, l, tid);
    const bool lastl = (l == DEPTH - 1);
    for (int r0 = r00; r0 < NTOK; r0 += C.G * NWAVES * 16) {
        u32x4 rec = rec0; if (r0 != r00) rec = C.tokrec[r0 + (lane & 15)];
        const unsigned sa_l = (unsigned)tb[rec.x >> 16] * 256u + (rec.x & 0xffffu), sb_l = (unsigned)tb[rec.y >> 16] * 256u + (rec.y & 0xffffu);
#pragma unroll 1
        for (int bq = 0; bq < 2; ++bq) {
            u32x2 xv[8][4]; unsigned av[8][4], bw[8][4]; float wa[8], wb[8];
#pragma unroll
            for (int k = 0; k < 8; ++k) { const int idx = bq * 8 + k;
                const size_t sa = (size_t)__builtin_amdgcn_readlane(sa_l, idx), sb = (size_t)__builtin_amdgcn_readlane(sb_l, idx);
                wa[k] = __uint_as_float(__builtin_amdgcn_readlane(rec.z, idx)) * 0.0625f; wb[k] = __uint_as_float(__builtin_amdgcn_readlane(rec.w, idx)) * 0.0625f;
                const unsigned* xph = (const unsigned*)(C.xb8 + (size_t)(r0 + idx) * DM) + lane; const unsigned* xpl = (const unsigned*)((const unsigned char*)C.xb + (size_t)(r0 + idx) * DM) + lane; const unsigned* ya = (const unsigned*)((const unsigned char*)C.ys + sa * DM) + lane; const unsigned* yb = (const unsigned*)((const unsigned char*)C.ys + sb * DM) + lane;
#pragma unroll
                for (int j = 0; j < 4; ++j) { xv[k][j].x = xph[64 * j]; xv[k][j].y = xpl[64 * j]; av[k][j] = ya[64 * j]; bw[k][j] = yb[64 * j]; } }
#pragma unroll
            for (int k = 0; k < 8; ++k) { const int row = r0 + bq * 8 + k;
                f32x4 v[4]; float s = 0.f, s2 = 0.f;
#pragma unroll
                for (int j = 0; j < 4; ++j) { const u32x2 x2 = xv[k][j];
                    const f32x2 al = __builtin_amdgcn_cvt_pk_f32_fp8((int)av[k][j], false), ah = __builtin_amdgcn_cvt_pk_f32_fp8((int)av[k][j], true);
                    const f32x2 bl = __builtin_amdgcn_cvt_pk_f32_fp8((int)bw[k][j], false), bh = __builtin_amdgcn_cvt_pk_f32_fp8((int)bw[k][j], true);
                    const f32x4 xr = dec_fp8x4(x2.x) * (0.125f * ALPHA) + dec_fp8x4(x2.y) * (0.0078125f * ALPHA);
                    v[j].x = xr.x + (al.x * wa[k] + bl.x * wb[k]); v[j].y = xr.y + (al.y * wa[k] + bl.y * wb[k]);
                    v[j].z = xr.z + (ah.x * wa[k] + bh.x * wb[k]); v[j].w = xr.w + (ah.y * wa[k] + bh.y * wb[k]);
                    s += (v[j].x + v[j].y) + (v[j].z + v[j].w); s2 += (v[j].x * v[j].x + v[j].y * v[j].y) + (v[j].z * v[j].z + v[j].w * v[j].w); }
                const float mean = wave_sum(s) * (1.f / DM), ex2 = wave_sum(s2) * (1.f / DM);
                const float rstd = __builtin_amdgcn_rsqf(fmaxf(ex2 - mean * mean, 0.f) + LN_EPS);
#pragma unroll
                for (int j = 0; j < 4; ++j) v[j] = v[j] - mean;
                if (lastl) { f32x4* xo = (f32x4*)(C.xcur + (size_t)row * DM) + lane;
#pragma unroll
                    for (int j = 0; j < 4; ++j) xo[64 * j] = v[j] * rstd * gv[j] + bv[j]; }
                else { unsigned* xlo = (unsigned*)((unsigned char*)C.xb + (size_t)row * DM) + lane; unsigned* x8o = (unsigned*)(C.xb8 + (size_t)row * DM) + lane;
#pragma unroll
                    for (int j = 0; j < 4; ++j) { const f32x4 y = v[j] * rstd * gv[j] + bv[j]; unsigned hi, lo; split_fp8(y, hi, lo); __hip_atomic_store(x8o + 64 * j, hi, __ATOMIC_RELAXED, __HIP_MEMORY_SCOPE_AGENT); __hip_atomic_store(xlo + 64 * j, lo, __ATOMIC_RELAXED, __HIP_MEMORY_SCOPE_AGENT); } }
            }
        }
    }
}

template <class T> __device__ __forceinline__ T* as_g(T* p) { return (T*)(GAS T*)p; }
typedef const __attribute__((address_space(4))) Args* KArgs;
__device__ __forceinline__ Ctx make_ctx(KArgs ap) {
    asm volatile("" : "+s"(ap));
    Ctx C;
    C.x = as_g(ap->in[0]); C.mem = as_g(ap->in[1]); C.w_in = as_g(ap->in[2]); C.b_in = as_g(ap->in[3]); C.w_mem_kv = as_g(ap->in[4]); C.sinks = as_g(ap->in[5]); C.rel_bias = as_g(ap->in[6]); C.lb_logits = as_g(ap->in[7]);
    C.hnorm = as_g(ap->in[8]); C.w_out = as_g(ap->in[9]); C.ln1g = as_g(ap->in[10]); C.ln1b = as_g(ap->in[11]); C.w_router = as_g(ap->in[12]); C.rbias = as_g(ap->in[13]); C.w_gate = as_g(ap->in[14]); C.w_up = as_g(ap->in[15]);
    C.w_down = as_g(ap->in[16]); C.ln2g = as_g(ap->in[17]); C.ln2b = as_g(ap->in[18]);
    unsigned char* ws = as_g(ap->ws);
    C.xcur = as_g(ap->out); C.ws = ws; C.ctl = (unsigned*)(ws + WS_CTL);
    C.Win = (bf16*)(ws + WS_WIN); C.Wout = (bf16*)(ws + WS_WOUT); C.Wmem = (bf16*)(ws + WS_WMEM); C.W1 = (bf16*)(ws + WS_W1); C.W2 = (bf16*)(ws + WS_W2);
    C.xb = (bf16*)(ws + WS_XB); C.proj = (bf16*)(ws + WS_BIG); C.hpre = (bf16*)(ws + WS_BIG); C.ys = (bf16*)(ws + WS_BIG);
    C.mix = (bf16*)(ws + WS_MIX); C.hmid = (bf16*)(ws + WS_MIX); C.memkv = (bf16*)(ws + WS_MEMKV); C.memb = (bf16*)(ws + WS_MEMB);
    C.biastab = (float*)(ws + WS_TAB); C.lbtab = (float*)(ws + WS_TAB + 4096); C.list = (int*)(ws + WS_LIST); C.tokrec = (u32x4*)(ws + WS_TOKREC); C.hst = (float*)(ws + WS_HST); C.xb8 = ws + WS_XB8;
    C.rep = ap->rep; C.G = gridDim.x; { const int bx = blockIdx.x; C.vcu = (C.G % 8 == 0) ? (bx % 8) * (C.G / 8) + bx / 8 : bx; }
    return C;
}
constexpr int PH_PER_LAYER = 7, N_PHASES = 1 + DEPTH * PH_PER_LAYER;
__global__ void __launch_bounds__(NTHR, 2) trunk_fwd(Args args) {
    extern __shared__ __attribute__((aligned(16))) unsigned char lds_raw[];
    LAS unsigned char* lds = (LAS unsigned char*)lds_raw;
    volatile LAS unsigned* MISC = (volatile LAS unsigned*)(lds + MISC_OFF);
    const int tid0 = threadIdx.x; const int wave0 = __builtin_amdgcn_readfirstlane(tid0 >> 6);
    for (int u = tid0; u < (LDS_BYTES - LDSCTL_OFF) / 4; u += NTHR) ((LAS unsigned*)(lds + LDSCTL_OFF))[u] = 0u;
    __syncthreads();
    KArgs ap = (KArgs)__builtin_amdgcn_kernarg_segment_ptr();
    XcdBarrier bar; bar.bar = (unsigned*)(as_g(args.ws) + WS_CTL) + CW_BAR; bar.x = 0; bar.st = nullptr;
    if (args.use_bar) bar = xcd_barrier_post((unsigned*)(as_g(args.ws) + WS_CTL) + CW_BAR, MISC + 8);
    const int lo = args.ph_lo, hi = args.ph_hi;
#define IN(k) (lo <= (k) && (k) < hi)
#define PHASE_IDS unsigned ones_ = ~0u; asm volatile("" : "+s"(ones_)); int lane = (int)__builtin_amdgcn_mbcnt_hi(ones_, __builtin_amdgcn_mbcnt_lo(ones_, 0u)); asm volatile("" : "+v"(lane)); int wave = wave0; asm volatile("" : "+s"(wave)); const int tid = wave * 64 + lane; (void)tid
#define SEAM(k) do { if (IN(k) && IN((k) + 1)) { XcdBarrier b2_ = bar; unsigned z_ = 0u; asm volatile("" : "+s"(z_)); b2_.bar = bar.bar + z_; xcd_barrier(b2_); } } while (0)

    if (IN(0)) { PHASE_IDS; const Ctx C = make_ctx(ap); p0_prologue(C, lds, wave, lane); }
    SEAM(0);
#pragma unroll 1
    for (int l = 0; l < DEPTH; ++l) {
        const int pb = 1 + l * PH_PER_LAYER;
        if (IN(pb + 0)) {
            PHASE_IDS; const Ctx C = make_ctx(ap);
            DenseSched S; S.A0 = (const char*)C.xb8; S.B0 = (const char*)C.Win + (size_t)l * INW * DM; S.nM0 = NTOK / 256; S.nN0 = INW / 256; S.K0 = DM  ;
            S.A1 = (const char*)C.memb; S.B1 = (const char*)C.Wmem; S.nM1 = 0; S.nN1 = 2048 / 256; S.G = C.G; S.c = (int)blockIdx.x; S.one = -1;
            LAS float* biasl = (LAS float*)(lds + pg8::NXT_SLOT_OFF);
            *(LAS f32x4*)(biasl + 4 * tid) = *(const f32x4*)(C.b_in + l * INW + 4 * tid);
            __syncthreads();
            EpiProj E{(unsigned char*)C.proj, biasl, (unsigned char*)C.memkv};
            pg8::gemm_phase<EpiProj, DenseSched, true>(lds, tid, DM, S, E);
        }
        SEAM(pb + 0);
        if (IN(pb + 1)) { PHASE_IDS; const Ctx C = make_ctx(ap); mixer_phase(C, lds, l, tid, wave, lane); }
        SEAM(pb + 1);
        if (IN(pb + 2)) {
            PHASE_IDS; const Ctx C = make_ctx(ap);
            DenseSched S; S.A0 = (const char*)C.mix; S.B0 = (const char*)C.Wout + (size_t)l * DM * MIXW; S.nM0 = NTOK / 256; S.nN0 = DM / 256; S.K0 = MIXW  ;
            S.A1 = nullptr; S.B1 = nullptr; S.nM1 = 0; S.nN1 = 0; S.G = C.G; S.c = (int)blockIdx.x; S.one = -1;
            EpiOut E{(unsigned char*)C.hpre};
            pg8::gemm_phase<EpiOut, DenseSched, true>(lds, tid, MIXW, S, E);
        }
        SEAM(pb + 2);
        if (IN(pb + 3)) { PHASE_IDS; const Ctx C = make_ctx(ap); p4_ln_route(C, lds, l, tid, wave, lane, false); }
        SEAM(pb + 3);
        if (IN(pb + 4)) {
            PHASE_IDS; const Ctx C = make_ctx(ap);
            LAS int* tb = (LAS int*)(lds + LDSCTL_OFF + 64);
            moe_prefix(C, tb, l, tid);
            const int U = tb[16] * 4;
            MoeSched<true> S; S.A = (const char*)C.xb8; S.Bl = (const char*)C.W1 + (size_t)l * NE * 1024 * DM; S.K = DM  ; S.bstride = (size_t)1024 * DM; S.list = C.list; S.tb = tb;
            S.mode = 0; S.g0 = C.vcu; S.g1 = C.G; S.gU = U < 1024 ? U : 1024;
            EpiG1 E{(unsigned char*)C.hmid};
            pg8::gemm_phase<EpiG1, MoeSched<true>, true>(lds, tid, DM, S, E);
        }
        SEAM(pb + 4);
        if (IN(pb + 5)) {
            PHASE_IDS; const Ctx C = make_ctx(ap);
            LAS int* tb = (LAS int*)(lds + LDSCTL_OFF + 64);
            if (!IN(pb + 4)) moe_prefix(C, tb, l, tid);
            const int U = tb[16] * 4, Etail = U > 1024 ? U - 1024 : 0;
            if (C.vcu < Etail) {
                MoeSched<true> S; S.A = (const char*)C.xb8; S.Bl = (const char*)C.W1 + (size_t)l * NE * 1024 * DM; S.K = DM  ; S.bstride = (size_t)1024 * DM; S.list = C.list; S.tb = tb;
                S.mode = 0; S.g0 = 1024 + C.vcu; S.g1 = 1 << 20; S.gU = 1024 + C.vcu + 1;
                EpiG1 E{(unsigned char*)C.hmid};
                pg8::gemm_phase<EpiG1, MoeSched<true>, true>(lds, tid, DM, S, E);
                asm volatile("s_waitcnt vmcnt(0)" ::: "memory");
                __syncthreads();
                if (tid == 0) {
                    unsigned* cnt = C.ctl + CW_TILE + (l * 16 + (C.vcu >> 2)) * 64; unsigned sp = 0;
                    __builtin_amdgcn_fence(__ATOMIC_RELEASE, "agent");
                    asm volatile("s_waitcnt vmcnt(0)" ::: "memory");
                    __hip_atomic_fetch_add(cnt, 1u, __ATOMIC_RELAXED, __HIP_MEMORY_SCOPE_AGENT);
                    while (__hip_atomic_load(cnt, __ATOMIC_RELAXED, __HIP_MEMORY_SCOPE_AGENT) < 4u) { __builtin_amdgcn_s_sleep(2); if (++sp > (1u << 24)) break; }
                    __builtin_amdgcn_fence(__ATOMIC_ACQUIRE, "agent");
                    asm volatile("s_waitcnt vmcnt(0)" ::: "memory");
                }
                __syncthreads();
            }
            MoeSched<false> S; S.A = (const char*)C.hmid; S.Bl = (const char*)C.W2 + (size_t)l * NE * DM * DE; S.K = DE  ; S.bstride = (size_t)DM * DE; S.list = C.list; S.tb = tb;
            S.mode = 1; S.g0 = C.vcu; S.g1 = Etail; S.gU = U < 1024 ? U : 1024;
            EpiG2 E{(unsigned char*)C.ys};
            pg8::gemm_phase<EpiG2, MoeSched<false>, true>(lds, tid, DE, S, E);
        }
        SEAM(pb + 5);
        if (IN(pb + 6)) { PHASE_IDS; const Ctx C = make_ctx(ap); p7_combine(C, lds, l, tid, wave, lane, IN(pb + 4)); }
        SEAM(pb + 6);
    }
#undef IN
#undef SEAM
}

#ifndef ONE_LAUNCH
#define ONE_LAUNCH 1
#endif
extern "C" void kernel_launch(void* const* d_in, const int* in_sizes, int n_in, void* d_out, int out_size, void* d_ws, size_t ws_size, hipStream_t stream) {
    static int grid = 0;
    if (grid == 0) {
        if (n_in != 19 || in_sizes[0] != NTOK * DM || out_size != NTOK * DM || ws_size < WS_END) {
            fprintf(stderr, "kernel_launch: unexpected shapes (n_in %d, in0 %d, out %d, ws %zu < %zu); nothing launched\n", n_in, n_in > 0 ? in_sizes[0] : -1, out_size, ws_size, (size_t)WS_END); grid = -1; return; }
        int dev = 0, cus = 0, per_cu = 0;
        if (hipGetDevice(&dev) != hipSuccess || hipDeviceGetAttribute(&cus, hipDeviceAttributeMultiprocessorCount, dev) != hipSuccess) { grid = -1; return; }
        if (hipFuncSetAttribute((const void*)trunk_fwd, hipFuncAttributeMaxDynamicSharedMemorySize, LDS_BYTES) != hipSuccess) { fprintf(stderr, "kernel_launch: hipFuncSetAttribute failed\n"); grid = -1; return; }
        if (hipOccupancyMaxActiveBlocksPerMultiprocessor(&per_cu, (const void*)trunk_fwd, NTHR, LDS_BYTES) != hipSuccess || per_cu < 1) { fprintf(stderr, "kernel_launch: occupancy query says %d\n", per_cu); }
        (void)hipGetLastError();
        grid = cus;
        fprintf(stderr, "kernel_launch: grid %d, occupancy/CU %d, ws %zu\n", grid, per_cu, ws_size);
    }
    if (grid < 0) return;
    (void)hipMemsetAsync((char*)d_ws + WS_CTL, 0, CTL_ZERO_BYTES, stream);
    Args a{};
    for (int i = 0; i < 19; ++i) a.in[i] = (const float*)d_in[i];
    a.out = (float*)d_out; a.ws = (unsigned char*)d_ws;
#if ONE_LAUNCH
    a.ph_lo = 0; a.ph_hi = N_PHASES; a.use_bar = 1;
    void* kargs[] = {&a};
    hipError_t e = hipLaunchCooperativeKernel((const void*)trunk_fwd, dim3(grid), dim3(NTHR), kargs, LDS_BYTES, stream);
    if (e != hipSuccess) fprintf(stderr, "kernel_launch: cooperative launch failed: %s\n", hipGetErrorString(e));
#else
    for (int p = 0; p < N_PHASES; ++p) {
        a.ph_lo = p; a.ph_hi = p + 1; a.use_bar = 0;
        hipLaunchKernelGGL(trunk_fwd, dim3(grid), dim3(NTHR), LDS_BYTES, stream, a);
    }
#endif
}
```
